# Optimizing an MI355X kernel written in HIP

```python
import jax, jax.numpy as jnp
from jax import lax
import numpy as np

D_MODEL = 1024
BATCH = 8
SEQ = 4096
DEPTH = 4

GRID_W = 64
CTX_LEN = 256
N_MIXERS = 4
ALPHA = (2 * DEPTH) ** 0.25
BETA = (8 * DEPTH) ** -0.25
LN_EPS = 1e-5
RMS_EPS = 1e-6
NEG_INF = -1e30
ROPE_THETA = 10000.0
Q_BLOCK = 128
F32 = jnp.float32

HGRN_HEADS = 8
HGRN_DK = D_MODEL // HGRN_HEADS
HGRN_DV = D_MODEL // HGRN_HEADS
GLA_CHUNK = 64

SWA_Q_HEADS = 16
SWA_KV_HEADS = 4
SWA_HEAD_DIM = D_MODEL // SWA_Q_HEADS
SWA_WINDOW = 128

NA_HEADS = 16
NA_HEAD_DIM = D_MODEL // NA_HEADS
NA_WIN_ROWS = 8
NA_WIN_COLS = 16

GQA_Q_HEADS = 8
GQA_KV_HEADS = 2
GQA_HEAD_DIM = D_MODEL // GQA_Q_HEADS

PEER_HEADS = 8
PEER_NKEYS = 128
PEER_N = PEER_NKEYS * PEER_NKEYS
PEER_DQ = 256
PEER_TOPK = 16
PEER_CHUNK = 128

kernel_name = 'hybrid_diffusion_hgrn2_swa_natten_gqa_peer'


def layer_norm(x, g, b):
    xf = x.astype(F32)
    mu = jnp.mean(xf, axis=-1, keepdims=True)
    var = jnp.mean(jnp.square(xf - mu), axis=-1, keepdims=True)
    return ((xf - mu) * lax.rsqrt(var + LN_EPS) * g + b).astype(x.dtype)


def rms_norm(x, g):
    xf = x.astype(F32)
    return (xf * lax.rsqrt(jnp.mean(jnp.square(xf), axis=-1, keepdims=True) + RMS_EPS) * g).astype(x.dtype)


def axial_rope(x):
    n_tok, dh = x.shape[1], x.shape[-1]
    t = jnp.arange(n_tok)
    pos = jnp.stack([t // GRID_W, t % GRID_W]).astype(F32)
    d_axis = dh // 2
    inv = ROPE_THETA ** (-jnp.arange(0, d_axis, 2, dtype=F32) / d_axis)
    ang = pos[:, :, None] * inv
    cos = jnp.cos(ang)[:, :, None, :].astype(x.dtype)
    sin = jnp.sin(ang)[:, :, None, :].astype(x.dtype)
    parts = []
    for a, xa in enumerate(jnp.split(x, 2, axis=-1)):
        x1, x2 = jnp.split(xa, 2, axis=-1)
        parts.append(jnp.concatenate([x1 * cos[a] - x2 * sin[a], x2 * cos[a] + x1 * sin[a]], axis=-1))
    return jnp.concatenate(parts, axis=-1)


def qkv_heads(h, w_in, hq, hkv, dh):
    z = h @ w_in
    bsz, n_tok, _ = z.shape
    q = z[..., :hq * dh].reshape(bsz, n_tok, hq, dh)
    k = z[..., hq * dh:(hq + hkv) * dh].reshape(bsz, n_tok, hkv, dh)
    v = z[..., (hq + hkv) * dh:].reshape(bsz, n_tok, hkv, dh)
    return q, k, v


def attend(q, k, v, bias=None, sink=None):
    bsz, lq, hq, dh = q.shape
    hkv = k.shape[2]
    grp = hq // hkv
    s = jnp.einsum('bqhgd,bkhd->bhgqk', q.reshape(bsz, lq, hkv, grp, dh), k).astype(F32) * (dh ** -0.5)
    if bias is not None:
        s = s + bias
    if sink is None:
        p = jax.nn.softmax(s, axis=-1)
    else:
        sk = jnp.broadcast_to(sink.astype(F32).reshape(1, hkv, grp, 1, 1), s.shape[:-1] + (1,))
        p = jax.nn.softmax(jnp.concatenate([s, sk], axis=-1), axis=-1)[..., :-1]
    o = jnp.einsum('bhgqk,bkhd->bqhgd', p.astype(v.dtype), v)
    return o.reshape(bsz, lq, hq, dh)


def unblock(o):
    nb, bsz, blk, h, dh = o.shape
    return o.transpose(1, 0, 2, 3, 4).reshape(bsz, nb * blk, h * dh)


def gla_chunkwise(q, k, v, logf, s0):
    bsz, h, n_tok, _ = q.shape
    n_chunks = n_tok // GLA_CHUNK
    tri = jnp.tril(jnp.ones((GLA_CHUNK, GLA_CHUNK), bool))

    def chunks(a):
        return a.reshape(bsz, h, n_chunks, GLA_CHUNK, a.shape[-1]).transpose(2, 0, 1, 3, 4)

    def step(state, inp):
        qb, kb, vb, gb = inp
        b = jnp.cumsum(gb, axis=2)
        rel = jnp.where(tri[:, :, None], b[:, :, :, None, :] - b[:, :, None, :, :], -jnp.inf)
        att = jnp.einsum('bhtk,bhsk,bhtsk->bhts', qb, kb, jnp.exp(rel))
        o = jnp.einsum('bhts,bhsv->bhtv', att, vb) + jnp.einsum('bhtk,bhkv->bhtv', qb * jnp.exp(b), state)
        b_end = b[:, :, -1:, :]
        state = jnp.exp(b_end[:, :, 0, :, None]) * state + jnp.einsum('bhsk,bhsv->bhkv', kb * jnp.exp(b_end - b), vb)
        return state, o

    state, o = lax.scan(step, s0, (chunks(q), chunks(k), chunks(v), chunks(logf)))
    return o.transpose(1, 2, 0, 3, 4).reshape(bsz, h, n_tok, -1), state


def hgrn2_mixer(hx, hc, w_in, lb, norm_g, w_out, with_ctx):
    def gates(h):
        bsz, n_tok, _ = h.shape
        q, i, f_fw, f_bw, g = jnp.split(h @ w_in, 5, axis=-1)
        heads = lambda a: a.reshape(bsz, n_tok, HGRN_HEADS, -1).transpose(0, 2, 1, 3).astype(F32)

        def decay(fz):
            f = lb + (1.0 - lb) * jax.nn.sigmoid(fz.astype(F32))
            return heads(1.0 - f), heads(jnp.log(f))
        return heads(jax.nn.silu(q)), heads(i), decay(f_fw), decay(f_bw), g

    def readout(o, g):
        bsz, _, n_tok, _ = o.shape
        o = rms_norm(o.transpose(0, 2, 1, 3), norm_g).reshape(bsz, n_tok, D_MODEL)
        return (o.astype(g.dtype) * jax.nn.silu(g)) @ w_out

    flip = lambda a: jnp.flip(a, axis=2)
    qc, vc, (kcf, lcf), (kcb, lcb), gc = gates(hc)
    s0 = jnp.zeros((hc.shape[0], HGRN_HEADS, HGRN_DK, HGRN_DV), F32)
    oc_f, sc_f = gla_chunkwise(qc, kcf, vc, lcf, s0)
    oc_b, sc_b = gla_chunkwise(flip(qc), flip(kcb), flip(vc), flip(lcb), s0)
    qx, vx, (kxf, lxf), (kxb, lxb), gx = gates(hx)
    ox_f, _ = gla_chunkwise(qx, kxf, vx, lxf, sc_f)
    ox_b, _ = gla_chunkwise(flip(qx), flip(kxb), flip(vx), flip(lxb), sc_b)
    yx = readout(ox_f + flip(ox_b), gx)
    yc = readout(oc_f + flip(oc_b), gc) if with_ctx else None
    return yx, yc


def swa_mixer(hx, hc, w_in, sink, w_out, with_ctx):
    bsz, s_len, _ = hx.shape
    qx, kx, vx = qkv_heads(hx, w_in, SWA_Q_HEADS, SWA_KV_HEADS, SWA_HEAD_DIM)
    qc, kc, vc = qkv_heads(hc, w_in, SWA_Q_HEADS, SWA_KV_HEADS, SWA_HEAD_DIM)
    qx, kx = axial_rope(qx), axial_rope(kx)
    pad = ((0, 0), (SWA_WINDOW, SWA_WINDOW), (0, 0), (0, 0))
    kp, vp = jnp.pad(kx, pad), jnp.pad(vx, pad)
    span = Q_BLOCK + 2 * SWA_WINDOW
    ctx_bias = jnp.zeros((Q_BLOCK, kc.shape[1]), F32)

    def block(n):
        start = n * Q_BLOCK
        q = lax.dynamic_slice_in_dim(qx, start, Q_BLOCK, axis=1)
        k = lax.dynamic_slice_in_dim(kp, start, span, axis=1)
        v = lax.dynamic_slice_in_dim(vp, start, span, axis=1)
        qpos = start + jnp.arange(Q_BLOCK)
        kpos = start - SWA_WINDOW + jnp.arange(span)
        ok = (jnp.abs(qpos[:, None] - kpos[None, :]) <= SWA_WINDOW) & (kpos[None, :] >= 0) & (kpos[None, :] < s_len)
        bias = jnp.concatenate([jnp.where(ok, 0.0, NEG_INF), ctx_bias], axis=-1)
        return attend(q, jnp.concatenate([k, kc], axis=1), jnp.concatenate([v, vc], axis=1), bias, sink)

    yx = unblock(lax.map(block, jnp.arange(s_len // Q_BLOCK))) @ w_out
    yc = attend(qc, kc, vc, sink=sink).reshape(bsz, hc.shape[1], D_MODEL) @ w_out if with_ctx else None
    return yx, yc


def na_mixer(hx, hc, w_in, rpb, w_out, with_ctx):
    bsz, s_len, _ = hx.shape
    rows = s_len // GRID_W
    wr = min(NA_WIN_ROWS, rows)
    qx, kx, vx = qkv_heads(hx, w_in, NA_HEADS, NA_HEADS, NA_HEAD_DIM)
    qc, kc, vc = qkv_heads(hc, w_in, NA_HEADS, NA_HEADS, NA_HEAD_DIM)
    col = jnp.arange(GRID_W)
    cstart = jnp.clip(col - NA_WIN_COLS // 2, 0, GRID_W - NA_WIN_COLS)
    col_ok = (col[None, :] >= cstart[:, None]) & (col[None, :] < cstart[:, None] + NA_WIN_COLS)
    dcol = jnp.clip(col[None, :] - col[:, None] + NA_WIN_COLS - 1, 0, 2 * NA_WIN_COLS - 2)
    ctx_bias = jnp.zeros((NA_HEADS, GRID_W, kc.shape[1]), F32)

    def row_block(r):
        rstart = jnp.clip(r - wr // 2, 0, rows - wr)
        q = lax.dynamic_slice_in_dim(qx, r * GRID_W, GRID_W, axis=1)
        k = lax.dynamic_slice_in_dim(kx, rstart * GRID_W, wr * GRID_W, axis=1)
        v = lax.dynamic_slice_in_dim(vx, rstart * GRID_W, wr * GRID_W, axis=1)
        drow = rstart + jnp.arange(wr) - r + NA_WIN_ROWS - 1
        rel = rpb[:, drow[None, :, None], dcol[:, None, :]].astype(F32)
        bias = jnp.where(col_ok[:, None, :], rel, NEG_INF).reshape(NA_HEADS, GRID_W, wr * GRID_W)
        bias = jnp.concatenate([bias, ctx_bias], axis=-1)[None, :, None]
        return attend(q, jnp.concatenate([k, kc], axis=1), jnp.concatenate([v, vc], axis=1), bias)

    yx = unblock(lax.map(row_block, jnp.arange(rows))) @ w_out
    yc = attend(qc, kc, vc).reshape(bsz, hc.shape[1], D_MODEL) @ w_out if with_ctx else None
    return yx, yc


def gqa_mixer(hx, hc, w_in, q_norm, k_norm, w_out, with_ctx):
    bsz, s_len, _ = hx.shape
    qx, kx, vx = qkv_heads(hx, w_in, GQA_Q_HEADS, GQA_KV_HEADS, GQA_HEAD_DIM)
    qc, kc, vc = qkv_heads(hc, w_in, GQA_Q_HEADS, GQA_KV_HEADS, GQA_HEAD_DIM)
    qx, kx = axial_rope(rms_norm(qx, q_norm)), axial_rope(rms_norm(kx, k_norm))
    qc, kc = rms_norm(qc, q_norm), rms_norm(kc, k_norm)
    k_all = jnp.concatenate([kx, kc], axis=1)
    v_all = jnp.concatenate([vx, vc], axis=1)

    def block(n):
        return attend(lax.dynamic_slice_in_dim(qx, n * Q_BLOCK, Q_BLOCK, axis=1), k_all, v_all)

    yx = unblock(lax.map(block, jnp.arange(s_len // Q_BLOCK))) @ w_out
    yc = attend(qc, kc, vc).reshape(bsz, hc.shape[1], D_MODEL) @ w_out if with_ctx else None
    return yx, yc


def peer_ffn(tokens, wq, sub_keys, u, v):
    n_tok, d = tokens.shape

    def chunk(h):
        t = h.shape[0]
        q = (h @ wq).reshape(t, PEER_HEADS, 2, PEER_DQ // 2)
        s = jnp.einsum('thpd,hpnd->thpn', q, sub_keys).astype(F32)
        sv, si = lax.top_k(s, PEER_TOPK)
        cand_s = (sv[:, :, 0, :, None] + sv[:, :, 1, None, :]).reshape(t, PEER_HEADS, -1)
        cand_i = (si[:, :, 0, :, None] * PEER_NKEYS + si[:, :, 1, None, :]).reshape(t, PEER_HEADS, -1)
        best_s, best = lax.top_k(cand_s, PEER_TOPK)
        idx = jnp.take_along_axis(cand_i, best, axis=-1)
        gate = jax.nn.softmax(best_s, axis=-1)
        act = jax.nn.gelu(jnp.einsum('td,thkd->thk', h, u[idx]).astype(F32))
        return jnp.einsum('thk,thkd->td', (gate * act).astype(v.dtype), v[idx])

    out = lax.map(chunk, tokens.reshape(n_tok // PEER_CHUNK, PEER_CHUNK, d))
    return out.reshape(n_tok, d)


def setup_inputs(seed: int = 0) -> dict:
    key = jax.random.key(seed)
    ks = iter(jax.random.split(key, 32))
    nrm = lambda shape, scale: jax.random.normal(next(ks), shape, F32) * scale
    occ = [len(range(m, DEPTH, N_MIXERS)) for m in range(N_MIXERS)]
    d = D_MODEL
    out_scale = d ** -0.5 * BETA
    return {
        'x': nrm((BATCH, SEQ, d), 1.0),
        'c': nrm((BATCH, d), 1.0),
        'ctx': nrm((BATCH, CTX_LEN, d), 1.0),
        'c_ctx': nrm((d,), 1.0),
        'mod_w': nrm((DEPTH, d, 6 * d), d ** -0.5),
        'mod_b': nrm((DEPTH, 6 * d), 0.02),
        'ln_g': 1.0 + nrm((DEPTH, 2, d), 0.02),
        'ln_b': nrm((DEPTH, 2, d), 0.02),
        'peer_wq': nrm((DEPTH, d, PEER_HEADS * PEER_DQ), d ** -0.5),
        'peer_keys': nrm((DEPTH, PEER_HEADS, 2, PEER_NKEYS, PEER_DQ // 2), (PEER_DQ // 2) ** -0.5),
        'peer_u': nrm((DEPTH, PEER_N, d), d ** -0.5),
        'peer_v': nrm((DEPTH, PEER_N, d), BETA),
        'hgrn_w_in': nrm((occ[0], d, 5 * d), d ** -0.5),
        'hgrn_lb_logits': nrm((DEPTH + 1, HGRN_HEADS * HGRN_DK), 0.1),
        'hgrn_norm_g': 1.0 + nrm((occ[0], HGRN_DV), 0.02),
        'hgrn_w_out': nrm((occ[0], d, d), out_scale),
        'swa_w_in': nrm((occ[1], d, (SWA_Q_HEADS + 2 * SWA_KV_HEADS) * SWA_HEAD_DIM), d ** -0.5),
        'swa_sink': nrm((occ[1], SWA_Q_HEADS), 0.1),
        'swa_w_out': nrm((occ[1], SWA_Q_HEADS * SWA_HEAD_DIM, d), out_scale),
        'na_w_in': nrm((occ[2], d, 3 * NA_HEADS * NA_HEAD_DIM), d ** -0.5),
        'na_rpb': nrm((occ[2], NA_HEADS, 2 * NA_WIN_ROWS - 1, 2 * NA_WIN_COLS - 1), 0.02),
        'na_w_out': nrm((occ[2], NA_HEADS * NA_HEAD_DIM, d), out_scale),
        'gqa_w_in': nrm((occ[3], d, (GQA_Q_HEADS + 2 * GQA_KV_HEADS) * GQA_HEAD_DIM), d ** -0.5),
        'gqa_q_norm': 1.0 + nrm((occ[3], GQA_HEAD_DIM), 0.02),
        'gqa_k_norm': 1.0 + nrm((occ[3], GQA_HEAD_DIM), 0.02),
        'gqa_w_out': nrm((occ[3], GQA_Q_HEADS * GQA_HEAD_DIM, d), out_scale),
    }


def reference(x, c, ctx, c_ctx, mod_w, mod_b, ln_g, ln_b, peer_wq, peer_keys, peer_u, peer_v,
              hgrn_w_in, hgrn_lb_logits, hgrn_norm_g, hgrn_w_out,
              swa_w_in, swa_sink, swa_w_out,
              na_w_in, na_rpb, na_w_out,
              gqa_w_in, gqa_q_norm, gqa_k_norm, gqa_w_out):
    lower_bounds = jnp.cumsum(jax.nn.softmax(hgrn_lb_logits.astype(F32), axis=0), axis=0)
    cond_x = jax.nn.silu(c)
    cond_c = jax.nn.silu(c_ctx)
    for i in range(DEPTH):
        kind, occ = i % N_MIXERS, i // N_MIXERS
        last = i == DEPTH - 1
        mx = jnp.split((cond_x @ mod_w[i] + mod_b[i])[:, None, :], 6, axis=-1)
        mc = jnp.split(cond_c @ mod_w[i] + mod_b[i], 6, axis=-1)
        hx = x * (1.0 + mx[1]) + mx[0]
        hc = ctx * (1.0 + mc[1]) + mc[0]
        if kind == 0:
            yx, yc = hgrn2_mixer(hx, hc, hgrn_w_in[occ], lower_bounds[i], hgrn_norm_g[occ], hgrn_w_out[occ], not last)
        elif kind == 1:
            yx, yc = swa_mixer(hx, hc, swa_w_in[occ], swa_sink[occ], swa_w_out[occ], not last)
        elif kind == 2:
            yx, yc = na_mixer(hx, hc, na_w_in[occ], na_rpb[occ], na_w_out[occ], not last)
        else:
            yx, yc = gqa_mixer(hx, hc, gqa_w_in[occ], gqa_q_norm[occ], gqa_k_norm[occ], gqa_w_out[occ], not last)
        x = layer_norm(ALPHA * x + mx[2] * yx, ln_g[i, 0], ln_b[i, 0])
        tokens = (x * (1.0 + mx[4]) + mx[3]).reshape(-1, D_MODEL)
        if not last:
            ctx = layer_norm(ALPHA * ctx + mc[2] * yc, ln_g[i, 0], ln_b[i, 0])
            tokens = jnp.concatenate([tokens, (ctx * (1.0 + mc[4]) + mc[3]).reshape(-1, D_MODEL)], axis=0)
        y = peer_ffn(tokens, peer_wq[i], peer_keys[i], peer_u[i], peer_v[i])
        n_lat = x.shape[0] * x.shape[1]
        x = layer_norm(ALPHA * x + mx[5] * y[:n_lat].reshape(x.shape), ln_g[i, 1], ln_b[i, 1])
        if not last:
            ctx = layer_norm(ALPHA * ctx + mc[5] * y[n_lat:].reshape(ctx.shape), ln_g[i, 1], ln_b[i, 1])
    return x
```

```cpp
#ifdef CPU_TEST
#include <cmath>
#include <cstdio>
#include <cstdlib>
#include <cstring>
#include <cstddef>
#define DEVFN static inline
#else
#include <hip/hip_runtime.h>
#include <cstdio>
#define DEVFN __device__ __forceinline__
#endif

#ifndef CFG_BATCH
#define CFG_BATCH 8
#endif
#ifndef CFG_SEQ
#define CFG_SEQ 4096
#endif
#ifndef CFG_CTX
#define CFG_CTX 256
#endif
constexpr int D = 1024, NBAT = CFG_BATCH, SEQ = CFG_SEQ, CL = CFG_CTX;
constexpr int NX = NBAT * SEQ, NC = NBAT * CL, NT = NX + NC;
constexpr int GW = 64, NROWS = SEQ / GW;
constexpr int DEPTH = 4, NMR = NBAT + 1;
constexpr float ALPHA = 1.6817928305074290f;
constexpr float LN_EPS = 1e-5f, RMS_EPS = 1e-6f;
constexpr float LN_THETA = 9.210340371976184f;
constexpr int PEER_N = 16384;

typedef unsigned short bf16_t;
DEVFN float bf2f(bf16_t b) { const unsigned u = ((unsigned)b) << 16; return __builtin_bit_cast(float, u); }
DEVFN bf16_t f2bf(float f) { unsigned u = __builtin_bit_cast(unsigned, f); u += 0x7fffu + ((u >> 16) & 1u); return (bf16_t)(u >> 16); }
DEVFN float sigmoidf_(float x) { return 1.f / (1.f + expf(-x)); }
DEVFN float siluf_(float x) { return x / (1.f + expf(-x)); }
DEVFN float geluf_(float x) { return 0.5f * x * (1.f + tanhf(0.7978845608028654f * (x + 0.044715f * x * x * x))); }
DEVFN int imin(int a, int b) { return a < b ? a : b; }
DEVFN int imax(int a, int b) { return a > b ? a : b; }
DEVFN int iclamp(int v, int lo, int hi) { return v < lo ? lo : (v > hi ? hi : v); }

struct Params {
    const float *x, *c, *ctx, *c_ctx, *mod_w, *mod_b, *ln_g, *ln_b, *peer_wq, *peer_keys, *peer_u, *peer_v;
    const float *hgrn_w_in, *hgrn_lb, *hgrn_norm_g, *hgrn_w_out, *swa_w_in, *swa_sink, *swa_w_out;
    const float *na_w_in, *na_rpb, *na_w_out, *gqa_w_in, *gqa_q_norm, *gqa_k_norm, *gqa_w_out;
    float* out; unsigned char* ws; int ph_lo, ph_hi, rep_k, rep_n; unsigned long long rep_mask;
};

constexpr size_t al256(size_t x) { return (x + 255) & ~(size_t)255; }
constexpr size_t WS_CTL = 0, CTL_BYTES = 1u << 20;
constexpr size_t WS_MODV = WS_CTL + CTL_BYTES;
constexpr size_t WS_LBV = WS_MODV + al256((size_t)DEPTH * NMR * 6144 * 4);
constexpr size_t WS_WIN0 = WS_LBV + 4096;
constexpr size_t WS_WIN1 = WS_WIN0 + (size_t)5120 * 1024 * 2;
constexpr size_t WS_WIN2 = WS_WIN1 + (size_t)1536 * 1024 * 2;
constexpr size_t WS_WIN3 = WS_WIN2 + (size_t)3072 * 1024 * 2;
constexpr size_t WS_WOUT = WS_WIN3 + (size_t)1536 * 1024 * 2;
constexpr size_t WS_WQ = WS_WOUT + (size_t)4 * 1024 * 1024 * 2;
constexpr size_t WS_XS = WS_WQ + (size_t)4 * 2048 * 1024 * 2;
constexpr size_t WS_HB = WS_XS + (size_t)NT * 1024 * 4;
constexpr size_t WS_ATT = WS_HB + (size_t)NT * 1024 * 2;
constexpr size_t WS_Y = WS_ATT + (size_t)NT * 1024 * 2;
constexpr size_t WS_Z = WS_Y + (size_t)NT * 1024 * 4;
constexpr size_t WS_END = WS_Z + (size_t)NT * 5120 * 2;
constexpr size_t WS_QP = WS_Z;
constexpr size_t WS_IDX = WS_QP + (size_t)NT * 2048 * 2;
constexpr size_t WS_GATE = WS_IDX + (size_t)NT * 128 * 4;
constexpr size_t WS_WA = WS_GATE + (size_t)NT * 128 * 4;
constexpr size_t WS_PART = WS_WA + (size_t)NT * 128 * 4;
constexpr size_t WS_SV = WS_PART;
constexpr size_t WS_SI = WS_SV + (size_t)NT * 256 * 4;
static_assert(WS_PART + (size_t)8 * NT * 128 * 4 <= WS_END, "PEER aliases fit in Z");
constexpr size_t WS_UV8 = WS_END;
constexpr size_t WS_UVS = WS_UV8 + (size_t)8 * PEER_N * 1024;
constexpr size_t WS_KEYS = WS_UVS + (size_t)8 * PEER_N * 4;
constexpr size_t WS_ROPE = WS_KEYS + (size_t)4 * 16 * 128 * 128 * 2;
constexpr size_t ROPE64_COS = 0, ROPE64_SIN = 64 * 16, ROPE128_COS = 2 * 64 * 16, ROPE128_SIN = 2 * 64 * 16 + 64 * 32;
constexpr size_t WS_HQH = al256(WS_ROPE + (size_t)(2 * 64 * 16 + 2 * 64 * 32) * 4);
constexpr size_t WS_HQL = WS_HQH + (size_t)NT * 1024;
constexpr size_t WS_HQS = WS_HQL + (size_t)NT * 1024;
constexpr size_t WS_END2 = WS_HQS + (size_t)NT * 8 * 4;
#ifndef CPU_TEST
namespace pg8 {
#define PG8_LAS __attribute__((address_space(3)))
typedef short bf16x8 __attribute__((ext_vector_type(8)));
typedef float f32x4 __attribute__((ext_vector_type(4)));
typedef unsigned u32x4 __attribute__((ext_vector_type(4)));
constexpr int BM = 256, BK = 64, HALF = 128, HTB = HALF * BK * 2  , STAGE_BYTES = 8 * HTB, NXCD = 8, WGM = 8;

__host__ __device__ __forceinline__ int lds_byte(int r, int c) { const int st = (r >> 4) * 2 + (c >> 5), rr = r & 15, cc = c & 31, ob = rr * 64 + cc * 2; return st * 1024 + (ob ^ (((ob >> 9) & 1) << 5)); }
__host__ __device__ __forceinline__ void stage_rc(int b, int& R, int& C) { const int st = b / 1024, sb = b % 1024, swz = sb ^ (((sb >> 9) & 1) << 5); R = (st >> 1) * 16 + swz / 64; C = (st & 1) * 32 + (swz % 64) / 2; }
__host__ __device__ __forceinline__ int perm32(int rho) { const int n = rho >> 4, i = rho & 15; return 8 * (i >> 2) + 4 * n + (i & 3); }

struct Unit { int pm, pn; };
struct Gemm { const bf16_t* A; const bf16_t* Bt; int M, N, K; };

struct StaticOrder {
    int nM, nN, nwg, G, c;
    __host__ __device__ void init(int M, int N, int G_, int c_) { nM = M / BM; nN = N / BM; nwg = nM * nN; G = G_; c = c_; }
    __host__ __device__ bool next(int i, Unit& u) const {
        const long L = (long)i * G + c; if (L >= nwg) return false;
        int wgid = (int)L; { const int q = nwg / NXCD, r = nwg % NXCD, xcd = wgid % NXCD, off = wgid / NXCD; wgid = (xcd < r ? xcd * (q + 1) : r * (q + 1) + (xcd - r) * q) + off; }
        const int nig = WGM * nN, gid = wgid / nig, fm = gid * WGM, gsz = (nM - fm) < WGM ? (nM - fm) : WGM;
        u.pm = fm + ((wgid % nig) % gsz); u.pn = (wgid % nig) / gsz; return true;
    }
    __device__ __forceinline__ void a_ready(const Unit&) const {}
    __device__ __forceinline__ void done(const Unit&) const {}
};

__device__ __forceinline__ unsigned cvt_pk_bf16(float lo, float hi) { unsigned r; asm volatile("v_cvt_pk_bf16_f32 %0, %1, %2" : "=v"(r) : "v"(lo), "v"(hi)); return r; }
struct EpiF32 {
    static constexpr bool PERM = false, AFTER_DRAIN = false;
    float* C; int ldc;
    __device__ __forceinline__ void operator()(const f32x4 (&acc)[2][2][4][2], const Unit& u, int wr, int wc, int fr, int fq) const {
        const int row0 = u.pm * BM + wr * 64 + fr, col0 = u.pn * BM + wc * 32 + 4 * fq;
#pragma unroll
        for (int ai = 0; ai < 2; ++ai)
#pragma unroll
            for (int m = 0; m < 4; ++m) { float* rowp = C + (size_t)(row0 + ai * HALF + m * 16) * ldc + col0;
#pragma unroll
                for (int bj = 0; bj < 2; ++bj)
#pragma unroll
                    for (int n = 0; n < 2; ++n) *(f32x4*)(rowp + bj * HALF + n * 16) = acc[ai][bj][m][n]; }
    }
};
struct EpiBf16 {
    static constexpr bool PERM = true, AFTER_DRAIN = false;
    bf16_t* O; int ldc;
    __device__ __forceinline__ void operator()(const f32x4 (&acc)[2][2][4][2], const Unit& u, int wr, int wc, int fr, int fq) const {
        const int row0 = u.pm * BM + wr * 64 + fr, col0 = u.pn * BM + wc * 32 + 8 * fq;
#pragma unroll
        for (int ai = 0; ai < 2; ++ai)
#pragma unroll
            for (int m = 0; m < 4; ++m) { bf16_t* rowp = O + (size_t)(row0 + ai * HALF + m * 16) * ldc + col0;
#pragma unroll
                for (int bj = 0; bj < 2; ++bj) { const f32x4 v0 = acc[ai][bj][m][0], v1 = acc[ai][bj][m][1];
                    u32x4 w; w.x = cvt_pk_bf16(v0[0], v0[1]); w.y = cvt_pk_bf16(v0[2], v0[3]); w.z = cvt_pk_bf16(v1[0], v1[1]); w.w = cvt_pk_bf16(v1[2], v1[3]);
                    *(u32x4*)(rowp + bj * HALF) = w; } }
    }
};

struct EpiSwa {
    static constexpr bool PERM = true, AFTER_DRAIN = false;
    bf16_t* O; int ldc; const float* rope_cos; const float* rope_sin; int nx_rows, seq, gw;
    __device__ __forceinline__ void operator()(const f32x4 (&acc)[2][2][4][2], const Unit& u, int wr, int wc, int fr, int fq) const {
        const int row0 = u.pm * BM + wr * 64 + fr, col0 = u.pn * BM + wc * 32 + 8 * fq;
        const bool roped = u.pn < 5;
        const int axis = wc & 1, fi0 = 8 * (fq & 1); const bool second = (fq & 2) != 0;
#pragma unroll
        for (int ai = 0; ai < 2; ++ai)
#pragma unroll
            for (int m = 0; m < 4; ++m) {
                const int row = row0 + ai * HALF + m * 16;
                bf16_t* rowp = O + (size_t)row * ldc + col0;
                f32x4 c0 = {1.f, 1.f, 1.f, 1.f}, c1 = c0, s0 = {0.f, 0.f, 0.f, 0.f}, s1 = s0;
                if (roped && row < nx_rows) { const int sp = row % seq, pos = axis == 0 ? sp / gw : sp % gw;
                    c0 = *(const f32x4*)(rope_cos + pos * 16 + fi0); c1 = *(const f32x4*)(rope_cos + pos * 16 + fi0 + 4); s0 = *(const f32x4*)(rope_sin + pos * 16 + fi0); s1 = *(const f32x4*)(rope_sin + pos * 16 + fi0 + 4);
                    if (!second) { s0 = -s0; s1 = -s1; } }
#pragma unroll
                for (int bj = 0; bj < 2; ++bj) { f32x4 v0 = acc[ai][bj][m][0], v1 = acc[ai][bj][m][1];
                    f32x4 p0, p1;
#pragma unroll
                    for (int j = 0; j < 4; ++j) {
                        auto r0 = __builtin_amdgcn_permlane32_swap(__float_as_uint(v0[j]), __float_as_uint(v0[j]), false, false); p0[j] = __uint_as_float(second ? r0[0] : r0[1]);
                        auto r1 = __builtin_amdgcn_permlane32_swap(__float_as_uint(v1[j]), __float_as_uint(v1[j]), false, false); p1[j] = __uint_as_float(second ? r1[0] : r1[1]); }
                    v0 = v0 * c0 + p0 * s0; v1 = v1 * c1 + p1 * s1;
                    u32x4 w; w.x = cvt_pk_bf16(v0[0], v0[1]); w.y = cvt_pk_bf16(v0[2], v0[3]); w.z = cvt_pk_bf16(v1[0], v1[1]); w.w = cvt_pk_bf16(v1[2], v1[3]);
                    *(u32x4*)(rowp + bj * HALF) = w; }
            }
    }
};
typedef _Float16 f16x2 __attribute__((ext_vector_type(2)));
typedef float f32x2e __attribute__((ext_vector_type(2)));
struct EpiHgrn {
    static constexpr bool PERM = true, AFTER_DRAIN = false;
    bf16_t* O; int ldc; const float* lbv;
    __device__ __forceinline__ void operator()(const f32x4 (&acc)[2][2][4][2], const Unit& u, int wr, int wc, int fr, int fq) const {
        const int row0 = u.pm * BM + wr * 64 + fr, col0 = u.pn * BM + wc * 32 + 8 * fq, kind = u.pn >> 2;
#pragma unroll
        for (int bj = 0; bj < 2; ++bj) {
            float lb[8];
            if (kind == 2 || kind == 3) { const f32x4 l0 = *(const f32x4*)(lbv + ((col0 + bj * HALF) & 1023)), l1 = *(const f32x4*)(lbv + ((col0 + bj * HALF) & 1023) + 4);
#pragma unroll
                for (int j = 0; j < 4; ++j) { lb[j] = l0[j]; lb[4 + j] = l1[j]; } }
#pragma unroll
            for (int ai = 0; ai < 2; ++ai)
#pragma unroll
                for (int m = 0; m < 4; ++m) {
                    bf16_t* rowp = O + (size_t)(row0 + ai * HALF + m * 16) * ldc + col0 + bj * HALF;
                    float v[8];
#pragma unroll
                    for (int j = 0; j < 4; ++j) { v[j] = acc[ai][bj][m][0][j]; v[4 + j] = acc[ai][bj][m][1][j]; }
                    u32x4 w;
                    if (kind == 2 || kind == 3) {
#pragma unroll
                        for (int j = 0; j < 4; ++j) { const float f0 = lb[2 * j] + (1.f - lb[2 * j]) * __builtin_amdgcn_rcpf(1.f + __expf(-v[2 * j])), f1 = lb[2 * j + 1] + (1.f - lb[2 * j + 1]) * __builtin_amdgcn_rcpf(1.f + __expf(-v[2 * j + 1]));
                            const f32x2e lf = {__logf(f0), __logf(f1)}; w[j] = __builtin_bit_cast(unsigned, __builtin_convertvector(lf, f16x2)); }
                    } else {
                        if (kind == 0) {
#pragma unroll
                            for (int j = 0; j < 8; ++j) v[j] = v[j] * __builtin_amdgcn_rcpf(1.f + __expf(-v[j]));
                        }
                        w.x = cvt_pk_bf16(v[0], v[1]); w.y = cvt_pk_bf16(v[2], v[3]); w.z = cvt_pk_bf16(v[4], v[5]); w.w = cvt_pk_bf16(v[6], v[7]);
                    }
                    *(u32x4*)rowp = w;
                }
        }
    }
};

template <class Epi, class Sched, bool ALIGN_EPI = false, bool SP2 = false>
__device__ __forceinline__ void gemm_phase(PG8_LAS unsigned char* lds, const Gemm g, const Sched& S, const Epi& E) {
    const int tid = threadIdx.x, wid = __builtin_amdgcn_readfirstlane(tid >> 6), lane = tid & 63, wr = wid >> 2, wc = wid & 3, fr = lane & 15, fq = lane >> 4;
    const int K = g.K, nt = K / BK;
    unsigned voffA[2], voffB[2];
#pragma unroll
    for (int i = 0; i < 2; ++i) { int R, C; stage_rc(tid * 16 + i * 8192, R, C); const int Rb = Epi::PERM ? ((R & ~31) + perm32(R & 31)) : R;
        voffA[i] = (unsigned)(R * K + C) * 2u; voffB[i] = (unsigned)(Rb * K + C) * 2u; }
    const size_t kstep = (size_t)(BK * 2);
    const size_t hstep = (size_t)HALF * K * 2;
    const size_t tstep = 2 * hstep;
    const unsigned ldsw = (unsigned)wid * 1024u;
    const int aoff = lds_byte(wr * 64 + fr, fq * 8), boff = lds_byte(wc * 32 + fr, fq * 8);
#define PG8_SA(b, h) (((b) * 2 + (h)) * HTB)
#define PG8_SB(b, h) ((4 + (b) * 2 + (h)) * HTB)
#define PG8_STAGE(bufoff, gbase, voff) do { _Pragma("unroll") for (int _i = 0; _i < 2; ++_i) \
        __builtin_amdgcn_global_load_lds((const unsigned*)((const char*)(gbase) + (voff)[_i]), (PG8_LAS unsigned*)(lds + (bufoff) + ldsw + _i * 8192), 16, 0, 0); } while (0)
#define PG8_LDA(dst, b, h) do { _Pragma("unroll") for (int m = 0; m < 4; ++m) _Pragma("unroll") for (int k = 0; k < 2; ++k) dst[m][k] = *(const PG8_LAS bf16x8*)(lds + PG8_SA(b, h) + aoff + m * 2048 + k * 1024); } while (0)
#define PG8_LDB(dst, b, h) do { _Pragma("unroll") for (int n = 0; n < 2; ++n) _Pragma("unroll") for (int k = 0; k < 2; ++k) dst[n][k] = *(const PG8_LAS bf16x8*)(lds + PG8_SB(b, h) + boff + n * 2048 + k * 1024); } while (0)
#define PG8_MMA(ai, bj, At, Bt) do { __builtin_amdgcn_s_setprio(1); _Pragma("unroll") for (int m = 0; m < 4; ++m) _Pragma("unroll") for (int n = 0; n < 2; ++n) _Pragma("unroll") for (int k = 0; k < 2; ++k) \
        acc[ai][bj][m][n] = __builtin_amdgcn_mfma_f32_16x16x32_bf16(Bt[n][k], At[m][k], acc[ai][bj][m][n], 0, 0, 0); __builtin_amdgcn_s_setprio(0); } while (0)
#define PG8_WAIT_V(n) asm volatile("s_waitcnt vmcnt(" #n ")" ::: "memory")
#define PG8_WAIT_L(n) asm volatile("s_waitcnt lgkmcnt(" #n ")" ::: "memory")
#define PG8_BAR __builtin_amdgcn_s_barrier()
#define PG8_SCHED __builtin_amdgcn_sched_barrier(0)
    Unit cur, nxt; int ui = 0;
    if (!S.next(0, cur)) return;
    f32x4 acc[2][2][4][2];
#pragma unroll
    for (int a = 0; a < 2; ++a)
#pragma unroll
        for (int b = 0; b < 2; ++b)
#pragma unroll
            for (int m = 0; m < 4; ++m)
#pragma unroll
                for (int n = 0; n < 2; ++n) acc[a][b][m][n] = (f32x4){0.f, 0.f, 0.f, 0.f};
    bf16x8 At[4][2], B0[2][2], B1[2][2];
    const char* cA = (const char*)g.A + (size_t)cur.pm * tstep; const char* cB = (const char*)g.Bt + (size_t)cur.pn * tstep;
    S.a_ready(cur);
    if constexpr (SP2) {
        PG8_STAGE(PG8_SB(0, 0), cB, voffB); PG8_STAGE(PG8_SB(0, 1), cB + hstep, voffB); PG8_STAGE(PG8_SA(0, 0), cA, voffA); PG8_STAGE(PG8_SA(0, 1), cA + hstep, voffA);
        if (wr == 1) PG8_BAR;
        PG8_WAIT_V(2); PG8_BAR;
        PG8_STAGE(PG8_SB(1, 0), cB + kstep, voffB); PG8_STAGE(PG8_SA(1, 0), cA + kstep, voffA); PG8_STAGE(PG8_SB(1, 1), cB + hstep + kstep, voffB);
        PG8_WAIT_V(6); PG8_BAR;
    } else {
        PG8_STAGE(PG8_SB(0, 0), cB, voffB); PG8_STAGE(PG8_SA(0, 0), cA, voffA); PG8_STAGE(PG8_SB(0, 1), cB + hstep, voffB); PG8_STAGE(PG8_SA(0, 1), cA + hstep, voffA);
        if (wr == 1) PG8_BAR;
        PG8_WAIT_V(4); PG8_BAR;
        PG8_STAGE(PG8_SB(1, 0), cB + kstep, voffB); PG8_STAGE(PG8_SA(1, 0), cA + kstep, voffA); PG8_STAGE(PG8_SB(1, 1), cB + hstep + kstep, voffB);
        PG8_WAIT_V(6); PG8_BAR;
    }
    for (;;) {
        const bool has_next = S.next(ui + 1, nxt);
        const char* nA = has_next ? (const char*)g.A + (size_t)nxt.pm * tstep : cA; const char* nB = has_next ? (const char*)g.Bt + (size_t)nxt.pn * tstep : cB;
        for (int t = 0; t < nt; t += 2) {
            const bool last = (t == nt - 2);
            const char* a1 = cA + (size_t)(t + 1) * kstep;
            const char* a2 = last ? nA : cA + (size_t)(t + 2) * kstep; const char* b2 = last ? nB : cB + (size_t)(t + 2) * kstep;
            const char* a3 = a2 + kstep; const char* b3 = b2 + kstep;
            if (last && has_next) S.a_ready(nxt);
            if constexpr (SP2) {
            PG8_LDB(B0, 0, 0); PG8_LDB(B1, 0, 1); PG8_SCHED; PG8_LDA(At, 0, 0); PG8_STAGE(PG8_SA(1, 1), a1 + hstep, voffA);
            PG8_WAIT_V(8); PG8_WAIT_L(0); PG8_BAR; PG8_MMA(0, 0, At, B0); PG8_MMA(0, 1, At, B1); PG8_BAR; PG8_SCHED;
            PG8_LDA(At, 0, 1); PG8_STAGE(PG8_SB(0, 0), b2, voffB); PG8_STAGE(PG8_SB(0, 1), b2 + hstep, voffB); PG8_STAGE(PG8_SA(0, 0), a2, voffA);
            PG8_WAIT_V(8); PG8_WAIT_L(0); PG8_BAR; PG8_MMA(1, 0, At, B0); PG8_MMA(1, 1, At, B1); PG8_BAR; PG8_SCHED;
            PG8_LDB(B0, 1, 0); PG8_LDB(B1, 1, 1); PG8_SCHED; PG8_LDA(At, 1, 0); PG8_STAGE(PG8_SA(0, 1), a2 + hstep, voffA);
            PG8_WAIT_V(8); PG8_WAIT_L(0); PG8_BAR; PG8_MMA(0, 0, At, B0); PG8_MMA(0, 1, At, B1); PG8_BAR; PG8_SCHED;
            PG8_LDA(At, 1, 1); PG8_STAGE(PG8_SB(1, 0), b3, voffB); PG8_STAGE(PG8_SB(1, 1), b3 + hstep, voffB); PG8_STAGE(PG8_SA(1, 0), a3, voffA);
            PG8_WAIT_V(8); PG8_WAIT_L(0); PG8_BAR; PG8_MMA(1, 0, At, B0); PG8_MMA(1, 1, At, B1); PG8_BAR; PG8_SCHED;
            } else {
            PG8_LDB(B0, 0, 0); PG8_SCHED; PG8_LDA(At, 0, 0); PG8_STAGE(PG8_SA(1, 1), a1 + hstep, voffA);
            PG8_WAIT_L(8); PG8_BAR; PG8_WAIT_L(0); PG8_MMA(0, 0, At, B0); PG8_BAR; PG8_SCHED;
            PG8_LDB(B1, 0, 1); PG8_STAGE(PG8_SB(0, 0), b2, voffB);
            PG8_BAR; PG8_WAIT_L(0); PG8_MMA(0, 1, At, B1); PG8_BAR;
            PG8_LDA(At, 0, 1); PG8_STAGE(PG8_SA(0, 0), a2, voffA);
            PG8_BAR; PG8_WAIT_L(0); PG8_MMA(1, 0, At, B0); PG8_BAR; PG8_SCHED;
            PG8_STAGE(PG8_SB(0, 1), b2 + hstep, voffB);
            PG8_WAIT_V(6); PG8_BAR; PG8_MMA(1, 1, At, B1); PG8_BAR;
            PG8_LDB(B0, 1, 0); PG8_SCHED; PG8_LDA(At, 1, 0); PG8_STAGE(PG8_SA(0, 1), a2 + hstep, voffA);
            PG8_WAIT_L(8); PG8_BAR; PG8_WAIT_L(0); PG8_MMA(0, 0, At, B0); PG8_BAR; PG8_SCHED;
            PG8_LDB(B1, 1, 1); PG8_STAGE(PG8_SB(1, 0), b3, voffB);
            PG8_BAR; PG8_WAIT_L(0); PG8_MMA(0, 1, At, B1); PG8_BAR;
            PG8_LDA(At, 1, 1); PG8_STAGE(PG8_SA(1, 0), a3, voffA);
            PG8_BAR; PG8_WAIT_L(0); PG8_MMA(1, 0, At, B0); PG8_BAR; PG8_SCHED;
            PG8_STAGE(PG8_SB(1, 1), b3 + hstep, voffB);
            PG8_WAIT_V(6); PG8_BAR; PG8_MMA(1, 1, At, B1); PG8_BAR;
            }
        }
        if constexpr (ALIGN_EPI) { if (wr == 0) PG8_BAR; }
        if constexpr (!Epi::AFTER_DRAIN) { E(acc, cur, wr, wc, fr, fq); S.done(cur); }
        if (!has_next) break;
#pragma unroll
        for (int a = 0; a < 2; ++a)
#pragma unroll
            for (int b = 0; b < 2; ++b)
#pragma unroll
                for (int m = 0; m < 4; ++m)
#pragma unroll
                    for (int n = 0; n < 2; ++n) acc[a][b][m][n] = (f32x4){0.f, 0.f, 0.f, 0.f};
        cur = nxt; cA = nA; cB = nB; ++ui;
        if constexpr (ALIGN_EPI) { if (wr == 1) PG8_BAR; }
    }
    PG8_WAIT_V(0);
    if constexpr (!ALIGN_EPI) { if (wr == 0) PG8_BAR; }
    PG8_BAR;
    if constexpr (Epi::AFTER_DRAIN) { E.fused(acc, cur, wr, wc, fr, fq, lds, wid, lane); S.done(cur); }
#undef PG8_SA
#undef PG8_SB
#undef PG8_STAGE
#undef PG8_LDA
#undef PG8_LDB
#undef PG8_MMA
#undef PG8_WAIT_V
#undef PG8_WAIT_L
#undef PG8_BAR
#undef PG8_SCHED
}
}

#include <cstdio>
#include <ctime>
#include <cstdlib>
#include <cstring>
#include <cmath>
#include <vector>
#include <algorithm>
#define CK(x) do { hipError_t e_ = (x); if (e_ != hipSuccess) { fprintf(stderr, "HIP %s:%d %s\n", __FILE__, __LINE__, hipGetErrorString(e_)); exit(2); } } while (0)
typedef unsigned short u16;

#endif
#ifndef CPU_TEST
#define XB_TMO      128
#define XB_XCNT(j)  (256  + 64 * (j))
#define XB_XSUB(j)  (1280 + 64 * (j))
#define XB_XGEN(j)  (2304 + 64 * (j))
#define XB_TOP      3328
#define XB_TOPGEN   3392
#define XCD_BAR_WORDS 3456
#define XB_SPIN_CAP (1u << 22)
#define LAS __attribute__((address_space(3)))

__device__ __forceinline__ unsigned xb_ld(unsigned* p)              { return __hip_atomic_load(p, __ATOMIC_RELAXED, __HIP_MEMORY_SCOPE_AGENT); }
__device__ __forceinline__ unsigned xb_add(unsigned* p, unsigned v) { return __hip_atomic_fetch_add(p, v, __ATOMIC_RELAXED, __HIP_MEMORY_SCOPE_AGENT); }
__device__ __forceinline__ unsigned xb_xcc_id() { return (unsigned)__builtin_amdgcn_s_getreg((3 << 11) | 20) & 0xFu; }
#define XB_SPIN(cond, bar) do { unsigned _sp = 0; while (cond) { __builtin_amdgcn_s_sleep(1); \
    if ((++_sp & 255u) == 0u) { if (xb_ld(&(bar)[XB_TMO])) break; if (_sp > XB_SPIN_CAP) { atomicAdd(&(bar)[XB_TMO], 1u); break; } } } } while (0)

struct XcdBarrier {
    unsigned* bar; unsigned x;
    volatile LAS unsigned* st;
};

__device__ __forceinline__ XcdBarrier xcd_barrier_post(unsigned* bar, volatile LAS unsigned* st) {
    XcdBarrier b; b.bar = bar; b.x = xb_xcc_id(); b.st = st;
    if (threadIdx.x == 0) (void)xb_add(&bar[XB_XCNT(b.x)], 1u);
    return b;
}
__device__ __forceinline__ void xcd_barrier_complete(unsigned* bar, unsigned x, unsigned& nloc, unsigned& nx) {
    const unsigned G = gridDim.x * gridDim.y * gridDim.z;
    unsigned sum, cnt, mine, sp = 0u;
    for (;;) {
        sum = 0u; cnt = 0u; mine = 0u;
#pragma unroll
        for (unsigned j = 0; j < 16; ++j) { const unsigned c = xb_ld(&bar[XB_XCNT(j)]); sum += c; cnt += (c > 0u) ? 1u : 0u; mine = (j == x) ? c : mine; }
        if (sum == G) break;
        __builtin_amdgcn_s_sleep(1);
        if ((++sp & 255u) == 0u) { if (xb_ld(&bar[XB_TMO])) break; if (sp > XB_SPIN_CAP) { atomicAdd(&bar[XB_TMO], 1u); break; } }
    }
    nloc = mine > 0u ? mine : 1u; nx = cnt > 0u ? cnt : 1u;
}

__device__ __forceinline__ void xcd_barrier(const XcdBarrier& b) {
    asm volatile("s_waitcnt vmcnt(0)" ::: "memory");
    __syncthreads();
    if (threadIdx.x == 0) {
        unsigned* bar = b.bar;
        __builtin_amdgcn_s_waitcnt(0);
        unsigned nloc = b.st[0], nx = b.st[1];
        if (nloc == 0u) { xcd_barrier_complete(bar, b.x, nloc, nx); b.st[0] = nloc; b.st[1] = nx; }
        const unsigned old = xb_add(&bar[XB_XSUB(b.x)], 1u);
        const unsigned gen = old / nloc;
        if (old + 1u == (gen + 1u) * nloc) {
            __builtin_amdgcn_fence(__ATOMIC_RELEASE, "agent");
            asm volatile("s_waitcnt vmcnt(0)" ::: "memory");
            const unsigned og = xb_add(&bar[XB_TOP], 1u);
            const unsigned tg = og / nx;
            if (og + 1u == (tg + 1u) * nx) xb_add(&bar[XB_TOPGEN], 1u);
            else XB_SPIN(xb_ld(&bar[XB_TOPGEN]) == tg, bar);
            __builtin_amdgcn_fence(__ATOMIC_ACQUIRE, "agent");
            xb_add(&bar[XB_XGEN(b.x)], 1u);
            asm volatile("s_waitcnt vmcnt(0)" ::: "memory");
        } else {
            XB_SPIN(xb_ld(&bar[XB_XGEN(b.x)]) == gen, bar);
            __builtin_amdgcn_fence(__ATOMIC_ACQUIRE, "agent");
            asm volatile("s_waitcnt vmcnt(0)" ::: "memory");
        }
    }
    __syncthreads();
}

#endif
#ifndef CPU_TEST
namespace att128 {
using bf16 = bf16_t;
constexpr int   D = 128, NW = 8, QBLK = 32, KVBLK = 64;
constexpr float SCALE = 0.088388347648318440f;
constexpr float THR = 8.f;
constexpr int SDEPTH = 2;
constexpr int LDQ = 1536, LDK = 1536, LDO = 1024;
constexpr size_t SHM_V = KVBLK * D * 2, SHM_K = KVBLK * D * 2, SHM_ATTN = 2 * SHM_V + 2 * SHM_K + NW * 64 * 4;
using bf16x8 = __attribute__((ext_vector_type(8))) short;
using s16x4  = __attribute__((ext_vector_type(4))) short;
using f32x16 = __attribute__((ext_vector_type(16))) float;
using f32x8  = __attribute__((ext_vector_type(8))) float;
using u32x4  = __attribute__((ext_vector_type(4))) unsigned;
#define KSWZ(row, colB) ((row) * 256 + ((colB) ^ (((row) & 7) << 4)))
#define SBAR() __builtin_amdgcn_sched_barrier(0)
__device__ __forceinline__ int crow(int r, int hi) { return (r & 3) + 8 * (r >> 2) + 4 * hi; }
__device__ __forceinline__ unsigned cvtpk(float lo, float hi) {
  unsigned r; asm volatile("v_cvt_pk_bf16_f32 %0, %1, %2" : "=v"(r) : "v"(lo), "v"(hi)); return r;
}
template <typename TIn> struct Stage;
template <> struct Stage<bf16>  { using T = bf16x8;
  __device__ static __forceinline__ T ld8(const bf16* p) { return *reinterpret_cast<const bf16x8*>(p); }
  __device__ static __forceinline__ bf16x8 tobf(T x) { return x; } };
template <> struct Stage<float> { using T = f32x8;
  __device__ static __forceinline__ T ld8(const float* p) { return *reinterpret_cast<const f32x8*>(p); }
  __device__ static __forceinline__ bf16x8 tobf(T x) {
    u32x4 w = {cvtpk(x[0], x[1]), cvtpk(x[2], x[3]), cvtpk(x[4], x[5]), cvtpk(x[6], x[7])}; return *reinterpret_cast<bf16x8*>(&w); } };

__device__ __forceinline__ void partialSM(f32x16& p0, f32x16& p1, float& m_reg, float& mn, float& alpha) {
  constexpr float C = SCALE * 1.4426950408889634f;
  float pmax = p0[0]; for (int r = 1; r < 16; ++r) pmax = fmaxf(pmax, p0[r]); for (int r = 0; r < 16; ++r) pmax = fmaxf(pmax, p1[r]);
  { auto rr = __builtin_amdgcn_permlane32_swap(__float_as_uint(pmax), __float_as_uint(pmax), false, false);
    pmax = fmaxf(__uint_as_float(rr[0]), __uint_as_float(rr[1])); }
  if (__builtin_expect(__all(pmax - m_reg <= THR / SCALE), 1)) { mn = m_reg; alpha = 1.f; }
  else { mn = fmaxf(m_reg, pmax); alpha = __builtin_amdgcn_exp2f((m_reg - mn) * C); m_reg = mn; }
  float mnC = -mn * C;
  for (int r = 0; r < 16; ++r) p0[r] = fmaf(p0[r], C, mnC); for (int r = 0; r < 16; ++r) p1[r] = fmaf(p1[r], C, mnC);
  for (int r = 0; r < 16; ++r) p0[r] = __builtin_amdgcn_exp2f(p0[r]);
}
__device__ __forceinline__ void finishSM(f32x16& p0, f32x16& p1, float alpha, float& l_reg, bf16x8& pa0, bf16x8& pa1, bf16x8& pa2, bf16x8& pa3) {
  for (int r = 0; r < 16; ++r) p1[r] = __builtin_amdgcn_exp2f(p1[r]);
  float ps = 0; for (int r = 0; r < 16; ++r) ps += p0[r]; for (int r = 0; r < 16; ++r) ps += p1[r];
  { auto rr = __builtin_amdgcn_permlane32_swap(__float_as_uint(ps), __float_as_uint(ps), false, false);
    ps = __uint_as_float(rr[0]) + __uint_as_float(rr[1]); }
  l_reg = l_reg * alpha + ps;
#define PK4(P, BASE, OUT) do { unsigned a0 = cvtpk(P[BASE + 0], P[BASE + 1]), a1 = cvtpk(P[BASE + 2], P[BASE + 3]);   \
    unsigned b0 = cvtpk(P[BASE + 4], P[BASE + 5]), b1 = cvtpk(P[BASE + 6], P[BASE + 7]);                              \
    auto r0 = __builtin_amdgcn_permlane32_swap(a0, b0, false, false); auto r1 = __builtin_amdgcn_permlane32_swap(a1, b1, false, false); \
    u32x4 w = {r0[0], r1[0], r0[1], r1[1]}; OUT = *reinterpret_cast<bf16x8*>(&w); } while (0)
  PK4(p0, 0, pa0); PK4(p0, 8, pa1); PK4(p1, 0, pa2); PK4(p1, 8, pa3);
#undef PK4
}
__device__ __forceinline__ void qkt(f32x16& p0, f32x16& p1, const bf16* Ks, const bf16x8* qr, int r32, int hi) {
  p0 = f32x16{}; p1 = f32x16{};
  for (int d0 = 0; d0 < 8; ++d0) { int cb = (d0 * 16 + hi * 8) * 2;
    bf16x8 b0 = *reinterpret_cast<const bf16x8*>((const char*)Ks + KSWZ(r32, cb));
    bf16x8 b1 = *reinterpret_cast<const bf16x8*>((const char*)Ks + KSWZ(32 + r32, cb));
    p0 = __builtin_amdgcn_mfma_f32_32x32x16_bf16(b0, qr[d0], p0, 0, 0, 0);
    p1 = __builtin_amdgcn_mfma_f32_32x32x16_bf16(b1, qr[d0], p1, 0, 0, 0); }
}
__device__ __forceinline__ int v_st(int k, int c) { const int kk = (k & ~0xC) | ((k & 4) << 1) | ((k & 8) >> 1); return ((kk >> 3) * 4 + (c >> 5)) * 512 + ((kk & 7) * 32 + (c & 31)) * 2; }
__device__ __forceinline__ int v_rd_base(int lane) { return ((lane & 3) << 3) | (((lane >> 2) & 3) << 6) | (((lane >> 4) & 1) << 5) | (((lane >> 5) & 1) << 8); }
constexpr int v_rd_off(int d0, int ks, int half) { return d0 * 512 + ks * 4096 + half * 2048; }
template <int OFF> __device__ __forceinline__ s16x4 tr_read(int vb) {
  s16x4 r; asm volatile("ds_read_b64_tr_b16 %0, %1 offset:%2" : "=&v"(r) : "v"(vb), "i"(OFF) : "memory"); return r;
}
template <int D0> __device__ __forceinline__ void pv_one(f32x16& od, int vb, bf16x8 pa0, bf16x8 pa1, bf16x8 pa2, bf16x8 pa3) {
  const s16x4 l0 = tr_read<v_rd_off(D0, 0, 0)>(vb), h0 = tr_read<v_rd_off(D0, 0, 1)>(vb), l1 = tr_read<v_rd_off(D0, 1, 0)>(vb), h1 = tr_read<v_rd_off(D0, 1, 1)>(vb);
  const s16x4 l2 = tr_read<v_rd_off(D0, 2, 0)>(vb), h2 = tr_read<v_rd_off(D0, 2, 1)>(vb), l3 = tr_read<v_rd_off(D0, 3, 0)>(vb), h3 = tr_read<v_rd_off(D0, 3, 1)>(vb);
  asm volatile("s_waitcnt lgkmcnt(0)" ::: "memory"); SBAR();
#define PK(L, H) (bf16x8){L[0], L[1], L[2], L[3], H[0], H[1], H[2], H[3]}
  od = __builtin_amdgcn_mfma_f32_32x32x16_bf16(pa0, PK(l0, h0), od, 0, 0, 0);
  od = __builtin_amdgcn_mfma_f32_32x32x16_bf16(pa1, PK(l1, h1), od, 0, 0, 0);
  od = __builtin_amdgcn_mfma_f32_32x32x16_bf16(pa2, PK(l2, h2), od, 0, 0, 0);
  od = __builtin_amdgcn_mfma_f32_32x32x16_bf16(pa3, PK(l3, h3), od, 0, 0, 0);
#undef PK
}
__device__ __forceinline__ void pv_d0(f32x16* o, int vb, bf16x8 pa0, bf16x8 pa1, bf16x8 pa2, bf16x8 pa3) {
  pv_one<0>(o[0], vb, pa0, pa1, pa2, pa3); pv_one<1>(o[1], vb, pa0, pa1, pa2, pa3); pv_one<2>(o[2], vb, pa0, pa1, pa2, pa3); pv_one<3>(o[3], vb, pa0, pa1, pa2, pa3);
}

template <typename TQ>
__device__ __forceinline__ void attn_dense_body(const TQ* __restrict__ Qb, const bf16* __restrict__ Kh, const bf16* __restrict__ Vh, const bf16* __restrict__ Kc, const bf16* __restrict__ Vc,
                                                bf16* __restrict__ Ob, int seq, char* lds) {
  using St = Stage<bf16>; using SQ = Stage<TQ>;
  const int tid = threadIdx.x, wid = tid >> 6, lane = tid & 63, r32 = lane & 31, hi = lane >> 5;
  bf16* V_lds = (bf16*)lds; bf16* K_lds = (bf16*)(lds + 2 * SHM_V);
  float* ws = (float*)(lds + 2 * SHM_V + 2 * SHM_K) + wid * 64; float* li_l = ws; float* al_l = ws + 32;
  float m_reg = -1e30f, l_reg = 0; f32x16 o[4] = {}; bf16x8 qr[8];
  const TQ* Qw = Qb + (long)(wid * QBLK + r32) * LDQ + hi * 8;
#pragma unroll
  for (int d0 = 0; d0 < 8; ++d0) qr[d0] = SQ::tobf(SQ::ld8(Qw + d0 * 16));
  const int sr = tid >> 4, sc = (tid & 15) * 8, vst0 = v_st(sr, sc), vst1 = v_st(32 + sr, sc);
  const int vb0 = (int)(uintptr_t)V_lds + v_rd_base(lane);
  struct { typename St::T vs0, vs1, ks0, ks1; } sr_[SDEPTH];
#define SLOAD(i, k0) do { const int k0_ = (k0); const bf16* Vt_ = k0_ < SEQ ? Vh + (long)k0_ * LDK : Vc + (long)(k0_ - SEQ) * LDK; const bf16* Kt_ = k0_ < SEQ ? Kh + (long)k0_ * LDK : Kc + (long)(k0_ - SEQ) * LDK; \
    sr_[i].vs0 = St::ld8(&Vt_[(long)(sr) * LDK + sc]); sr_[i].vs1 = St::ld8(&Vt_[(long)(32 + sr) * LDK + sc]); \
    sr_[i].ks0 = St::ld8(&Kt_[(long)(sr) * LDK + sc]); sr_[i].ks1 = St::ld8(&Kt_[(long)(32 + sr) * LDK + sc]); } while (0)
#define SWRITE(b, i) do { *(bf16x8*)((char*)V_lds + (b) * SHM_V + vst0) = St::tobf(sr_[i].vs0);          \
    *(bf16x8*)((char*)V_lds + (b) * SHM_V + vst1) = St::tobf(sr_[i].vs1); int kc = sc * 2;               \
    *(bf16x8*)((char*)K_lds + (b) * SHM_K + KSWZ(sr, kc)) = St::tobf(sr_[i].ks0);                       \
    *(bf16x8*)((char*)K_lds + (b) * SHM_K + KSWZ(32 + sr, kc)) = St::tobf(sr_[i].ks1); } while (0)
#define SWAIT() do { if constexpr (SDEPTH == 2) asm volatile("s_waitcnt vmcnt(4)" ::: "memory"); else asm volatile("s_waitcnt vmcnt(0)" ::: "memory"); } while (0)
#define RESC(a) do { if (__any((a) < 1.f)) { if (hi == 0) al_l[r32] = (a); asm volatile("s_waitcnt lgkmcnt(0)" ::: "memory"); \
    for (int d = 0; d < 4; ++d) for (int r = 0; r < 16; ++r) o[d][r] *= al_l[crow(r, hi)]; } } while (0)
  f32x16 pA0, pA1, pB0, pB1; float mnA, mnB, alA, alB; bf16x8 pa0, pa1, pa2, pa3; const int NT = seq / KVBLK;
  constexpr int SE = 0, SO = SDEPTH - 1;
  SLOAD(SE, 0); asm volatile("s_waitcnt vmcnt(0)" ::: "memory"); SWRITE(0, SE); __syncthreads();
  qkt(pA0, pA1, K_lds, qr, r32, hi); partialSM(pA0, pA1, m_reg, mnA, alA);
  SLOAD(SO, KVBLK); if constexpr (SDEPTH == 2) { if (2 < NT) SLOAD(SE, 2 * KVBLK); }
  SWAIT(); SWRITE(1, SO); __syncthreads();
  for (int j = 1; j + 1 < NT; j += 2) {
    SBAR(); qkt(pB0, pB1, (bf16*)((char*)K_lds + SHM_K), qr, r32, hi);
    finishSM(pA0, pA1, alA, l_reg, pa0, pa1, pa2, pa3); SBAR();
    SLOAD(SO, (j + SDEPTH) * KVBLK); SBAR();
    pv_d0(o, vb0, pa0, pa1, pa2, pa3); partialSM(pB0, pB1, m_reg, mnB, alB);
    __syncthreads(); SWAIT(); SWRITE(0, SE);
    RESC(alB); __syncthreads();
    SBAR(); qkt(pA0, pA1, K_lds, qr, r32, hi);
    finishSM(pB0, pB1, alB, l_reg, pa0, pa1, pa2, pa3); SBAR();
    if (SDEPTH == 1 || j + 3 < NT) SLOAD(SE, (j + 1 + SDEPTH) * KVBLK); SBAR();
    pv_d0(o, vb0 + (int)SHM_V, pa0, pa1, pa2, pa3); partialSM(pA0, pA1, m_reg, mnA, alA);
    __syncthreads(); SWAIT(); SWRITE(1, SO);
    RESC(alA); __syncthreads();
  }
  SBAR(); qkt(pB0, pB1, (bf16*)((char*)K_lds + SHM_K), qr, r32, hi);
  finishSM(pA0, pA1, alA, l_reg, pa0, pa1, pa2, pa3); SBAR();
  pv_d0(o, vb0, pa0, pa1, pa2, pa3); partialSM(pB0, pB1, m_reg, mnB, alB);
  __syncthreads(); RESC(alB);
  finishSM(pB0, pB1, alB, l_reg, pa0, pa1, pa2, pa3); SBAR();
  pv_d0(o, vb0 + (int)SHM_V, pa0, pa1, pa2, pa3);
  if (hi == 0) li_l[r32] = l_reg; asm volatile("s_waitcnt lgkmcnt(0)" ::: "memory");
  float rli[16];
#pragma unroll
  for (int r = 0; r < 16; ++r) rli[r] = __builtin_amdgcn_rcpf(li_l[crow(r, hi)]);
  bf16* Ow = Ob + (long)(wid * QBLK) * LDO;
#pragma unroll
  for (int r = 0; r < 16; ++r) { int orow = crow(r, hi);
    for (int d0 = 0; d0 < 4; ++d0) Ow[(long)orow * LDO + d0 * 32 + r32] = f2bf(o[d0][r] * rli[r]); }
#undef SLOAD
#undef SWRITE
#undef SWAIT
#undef RESC
}

}
#endif
#ifdef CPU_TEST
constexpr int RL = 1;
DEVFN float row_sum(float v) { return v; }
#else
constexpr int RL = 64;
DEVFN float dppf(float v, const int ctrl) { return ctrl == 0xB1 ? __int_as_float(__builtin_amdgcn_mov_dpp(__float_as_int(v), 0xB1, 0xf, 0xf, true)) : ctrl == 0x4E ? __int_as_float(__builtin_amdgcn_mov_dpp(__float_as_int(v), 0x4E, 0xf, 0xf, true))
    : ctrl == 0x141 ? __int_as_float(__builtin_amdgcn_mov_dpp(__float_as_int(v), 0x141, 0xf, 0xf, true)) : __int_as_float(__builtin_amdgcn_mov_dpp(__float_as_int(v), 0x140, 0xf, 0xf, true)); }
DEVFN int dpp_xor1(int v) { return __builtin_amdgcn_mov_dpp(v, 0xB1, 0xf, 0xf, true); }
DEVFN int dpp_xor2(int v) { return __builtin_amdgcn_mov_dpp(v, 0x4E, 0xf, 0xf, true); }
DEVFN int dpp_xor4(int v) { return __builtin_amdgcn_mov_dpp(__builtin_amdgcn_mov_dpp(v, 0x141, 0xf, 0xf, true), 0x1B, 0xf, 0xf, true); }
DEVFN int dpp_xor8(int v) { return __builtin_amdgcn_mov_dpp(v, 0x128, 0xf, 0xf, true); }
DEVFN float rdl(float v, const int l) { return __int_as_float(__builtin_amdgcn_readlane(__float_as_int(v), l)); }
DEVFN float row_sum(float v) {
    v += dppf(v, 0xB1); v += dppf(v, 0x4E); v += dppf(v, 0x141); v += dppf(v, 0x140);
    { auto rr = __builtin_amdgcn_permlane16_swap(__float_as_uint(v), __float_as_uint(v), false, false); v = __uint_as_float(rr[0]) + __uint_as_float(rr[1]); }
    { auto rr = __builtin_amdgcn_permlane32_swap(__float_as_uint(v), __float_as_uint(v), false, false); v = __uint_as_float(rr[0]) + __uint_as_float(rr[1]); }
    return v;
}
DEVFN float wave_maxf(float v) {
    v = fmaxf(v, dppf(v, 0xB1)); v = fmaxf(v, dppf(v, 0x4E)); v = fmaxf(v, dppf(v, 0x141)); v = fmaxf(v, dppf(v, 0x140));
    { auto rr = __builtin_amdgcn_permlane16_swap(__float_as_uint(v), __float_as_uint(v), false, false); v = fmaxf(__uint_as_float(rr[0]), __uint_as_float(rr[1])); }
    { auto rr = __builtin_amdgcn_permlane32_swap(__float_as_uint(v), __float_as_uint(v), false, false); v = fmaxf(__uint_as_float(rr[0]), __uint_as_float(rr[1])); }
    return v;
}
#endif
#define WSP(T, off) ((T*)(p.ws + (off)))
DEVFN int modrow(int t) { return t < NX ? t / SEQ : NBAT; }

DEVFN void tr_w(const float* W, int N, bf16_t* Wt, size_t gtid, size_t gsize) {
    for (size_t i = gtid; i < (size_t)N * D; i += gsize) { const int k = (int)(i / N), n = (int)(i % N); Wt[(size_t)n * D + k] = f2bf(W[i]); }
}
DEVFN void ph_pro_a(const Params& p, size_t gtid, size_t gsize) {
    float* modv = WSP(float, WS_MODV);
    for (size_t i = gtid; i < (size_t)DEPTH * NMR * 6144; i += gsize) {
        const int l = (int)(i / (NMR * 6144)), r = (int)((i / 6144) % NMR), c = (int)(i % 6144);
        const float* cv = r < NBAT ? p.c + (size_t)r * D : p.c_ctx;
        const float* w = p.mod_w + (size_t)l * D * 6144 + c;
        float s = 0.f;
        for (int k = 0; k < D; ++k) s += siluf_(cv[k]) * w[(size_t)k * 6144];
        modv[i] = s + p.mod_b[l * 6144 + c];
    }
    float* lbv = WSP(float, WS_LBV);
    for (size_t c = gtid; c < (size_t)D; c += gsize) {
        float m = -1e30f;
        for (int j = 0; j < DEPTH + 1; ++j) m = fmaxf(m, p.hgrn_lb[j * D + c]);
        float sum = 0.f;
        for (int j = 0; j < DEPTH + 1; ++j) sum += expf(p.hgrn_lb[j * D + c] - m);
        lbv[c] = expf(p.hgrn_lb[c] - m) / sum;
    }
    tr_w(p.hgrn_w_in, 5120, WSP(bf16_t, WS_WIN0), gtid, gsize);
    tr_w(p.swa_w_in, 1536, WSP(bf16_t, WS_WIN1), gtid, gsize);
    tr_w(p.na_w_in, 3072, WSP(bf16_t, WS_WIN2), gtid, gsize);
    tr_w(p.gqa_w_in, 1536, WSP(bf16_t, WS_WIN3), gtid, gsize);
    tr_w(p.hgrn_w_out, 1024, WSP(bf16_t, WS_WOUT) + (size_t)0 * D * D, gtid, gsize);
    tr_w(p.swa_w_out, 1024, WSP(bf16_t, WS_WOUT) + (size_t)1 * D * D, gtid, gsize);
    tr_w(p.na_w_out, 1024, WSP(bf16_t, WS_WOUT) + (size_t)2 * D * D, gtid, gsize);
    tr_w(p.gqa_w_out, 1024, WSP(bf16_t, WS_WOUT) + (size_t)3 * D * D, gtid, gsize);
    for (int l = 0; l < DEPTH; ++l) tr_w(p.peer_wq + (size_t)l * D * 2048, 2048, WSP(bf16_t, WS_WQ) + (size_t)l * 2048 * D, gtid, gsize);
    float* xs = WSP(float, WS_XS);
    for (size_t i = gtid; i < (size_t)NT * D; i += gsize) xs[i] = i < (size_t)NX * D ? p.x[i] : p.ctx[i - (size_t)NX * D];
}
DEVFN void ph_h0(const Params& p, size_t gtid, size_t gsize) {
    const float* xs = WSP(float, WS_XS); const float* modv = WSP(float, WS_MODV); bf16_t* hb = WSP(bf16_t, WS_HB);
    for (size_t i = gtid; i < (size_t)NT * D; i += gsize) {
        const int t = (int)(i / D), c = (int)(i % D);
        const float* m = modv + (size_t)(0 * NMR + modrow(t)) * 6144;
        hb[i] = f2bf(xs[i] * (1.f + m[D + c]) + m[c]);
    }
}
#ifdef CPU_TEST
DEVFN void cpu_gemm(const bf16_t* A, const bf16_t* Bt, int M, int N, int K, bf16_t* ob, float* of, int ldc, size_t gtid, size_t gsize) {
    for (size_t i = gtid; i < (size_t)M * N; i += gsize) {
        const int m = (int)(i / N), n = (int)(i % N); float s = 0.f;
        for (int k = 0; k < K; ++k) s += bf2f(A[(size_t)m * K + k]) * bf2f(Bt[(size_t)n * K + k]);
        if (ob) ob[(size_t)m * ldc + n] = f2bf(s); else of[(size_t)m * ldc + n] = s;
    }
}
#endif

DEVFN void ph_swa_rope(const Params& p, size_t gtid, size_t gsize) {
    bf16_t* Z = WSP(bf16_t, WS_Z); constexpr int LDZ = 1536;
    for (size_t i = gtid; i < (size_t)NX * 20 * 32; i += gsize) {
        const int pi = (int)(i % 32), hh = (int)((i / 32) % 20), t = (int)(i / (32 * 20));
        const int s = t % SEQ, a = pi >> 4, fi = pi & 15;
        const float pos = a == 0 ? (float)(s / GW) : (float)(s % GW);
        const float inv = expf(-(float)(2 * fi) / 32.f * LN_THETA);
        const float ang = pos * inv, cs = cosf(ang), sn = sinf(ang);
        bf16_t* zp = Z + (size_t)t * LDZ + hh * 64 + a * 32 + fi;
        const float x1 = bf2f(zp[0]), x2 = bf2f(zp[16]);
        zp[0] = f2bf(x1 * cs - x2 * sn); zp[16] = f2bf(x2 * cs + x1 * sn);
    }
}
DEVFN void ph_gqa_prep(const Params& p, size_t gtid, size_t gsize) {
    bf16_t* Z = WSP(bf16_t, WS_Z); constexpr int LDZ = 1536;
    for (size_t i = gtid; i < (size_t)NT * 10; i += gsize) {
        const int hh = (int)(i % 10), t = (int)(i / 10);
        bf16_t* zp = Z + (size_t)t * LDZ + hh * 128;
        const float* g = hh < 8 ? p.gqa_q_norm : p.gqa_k_norm;
        float ss = 0.f;
        for (int d = 0; d < 128; ++d) { const float v = bf2f(zp[d]); ss += v * v; }
        const float r = 1.f / sqrtf(ss * (1.f / 128.f) + RMS_EPS);
        if (t < NX) {
            const int s = t % SEQ;
            for (int a = 0; a < 2; ++a) {
                const float pos = a == 0 ? (float)(s / GW) : (float)(s % GW);
                for (int fi = 0; fi < 32; ++fi) {
                    const int d1 = a * 64 + fi, d2 = d1 + 32;
                    const float inv = expf(-(float)(2 * fi) / 64.f * LN_THETA);
                    const float ang = pos * inv, cs = cosf(ang), sn = sinf(ang);
                    const float x1 = bf2f(zp[d1]) * r * g[d1], x2 = bf2f(zp[d2]) * r * g[d2];
                    zp[d1] = f2bf(x1 * cs - x2 * sn); zp[d2] = f2bf(x2 * cs + x1 * sn);
                }
            }
        } else {
            for (int d = 0; d < 128; ++d) zp[d] = f2bf(bf2f(zp[d]) * r * g[d]);
        }
    }
}

template <int DH, int DCH>
DEVFN void att_key(const float (&q)[DH], float (&acc)[DCH], float& m, float& l, const bf16_t* kp, const bf16_t* vp, float scale, float bias) {
    float s = 0.f;
#pragma unroll
    for (int d = 0; d < DH; ++d) s += q[d] * bf2f(kp[d]);
    s = s * scale + bias;
    const float mn = fmaxf(m, s), a = expf(m - mn), pw = expf(s - mn);
    l = l * a + pw;
#pragma unroll
    for (int d = 0; d < DCH; ++d) acc[d] = acc[d] * a + pw * bf2f(vp[d]);
    m = mn;
}
DEVFN void ph_swa_attn(const Params& p, size_t gtid, size_t gsize) {
    const bf16_t* Z = WSP(bf16_t, WS_Z); bf16_t* att = WSP(bf16_t, WS_ATT); constexpr int LDZ = 1536;
    for (size_t i = gtid; i < (size_t)NT * 16; i += gsize) {
        const int hq = (int)(i % 16), t = (int)(i / 16), kvh = hq / 4;
        float q[64], acc[64]; float m = -1e30f, l = 0.f;
#pragma unroll
        for (int d = 0; d < 64; ++d) { q[d] = bf2f(Z[(size_t)t * LDZ + hq * 64 + d]); acc[d] = 0.f; }
        int b;
        if (t < NX) {
            b = t / SEQ; const int s = t % SEQ, lo = imax(0, s - 128), hi = imin(SEQ - 1, s + 128);
            for (int kp = lo; kp <= hi; ++kp) { const bf16_t* zr = Z + (size_t)(b * SEQ + kp) * LDZ; att_key<64, 64>(q, acc, m, l, zr + 1024 + kvh * 64, zr + 1280 + kvh * 64, 0.125f, 0.f); }
        } else b = (t - NX) / CL;
        for (int j = 0; j < CL; ++j) { const bf16_t* zr = Z + (size_t)(NX + b * CL + j) * LDZ; att_key<64, 64>(q, acc, m, l, zr + 1024 + kvh * 64, zr + 1280 + kvh * 64, 0.125f, 0.f); }
        const float sk = p.swa_sink[hq], mn = fmaxf(m, sk), a = expf(m - mn); l = l * a + expf(sk - mn);
        const float sc = a / l;
#pragma unroll
        for (int d = 0; d < 64; ++d) att[(size_t)t * D + hq * 64 + d] = f2bf(acc[d] * sc);
    }
}
DEVFN void ph_na_attn(const Params& p, size_t gtid, size_t gsize) {
    const bf16_t* Z = WSP(bf16_t, WS_Z); bf16_t* att = WSP(bf16_t, WS_ATT); constexpr int LDZ = 3072;
    for (size_t i = gtid; i < (size_t)NT * 16; i += gsize) {
        const int hq = (int)(i % 16), t = (int)(i / 16);
        float q[64], acc[64]; float m = -1e30f, l = 0.f;
#pragma unroll
        for (int d = 0; d < 64; ++d) { q[d] = bf2f(Z[(size_t)t * LDZ + hq * 64 + d]); acc[d] = 0.f; }
        int b;
        if (t < NX) {
            b = t / SEQ; const int s = t % SEQ, r = s / GW, c = s % GW;
            const int rstart = iclamp(r - 4, 0, NROWS - 8), cstart = iclamp(c - 8, 0, GW - 16);
            for (int ii = 0; ii < 8; ++ii)
                for (int jj = 0; jj < 16; ++jj) {
                    const int kr = rstart + ii, kc = cstart + jj;
                    const bf16_t* zr = Z + (size_t)(b * SEQ + kr * GW + kc) * LDZ;
                    const float bias = p.na_rpb[(hq * 15 + (kr - r + 7)) * 31 + (kc - c + 15)];
                    att_key<64, 64>(q, acc, m, l, zr + 1024 + hq * 64, zr + 2048 + hq * 64, 0.125f, bias);
                }
        } else b = (t - NX) / CL;
        for (int j = 0; j < CL; ++j) { const bf16_t* zr = Z + (size_t)(NX + b * CL + j) * LDZ; att_key<64, 64>(q, acc, m, l, zr + 1024 + hq * 64, zr + 2048 + hq * 64, 0.125f, 0.f); }
        const float sc = 1.f / l;
#pragma unroll
        for (int d = 0; d < 64; ++d) att[(size_t)t * D + hq * 64 + d] = f2bf(acc[d] * sc);
    }
}
DEVFN void ph_gqa_attn(const Params& p, size_t gtid, size_t gsize) {
    const bf16_t* Z = WSP(bf16_t, WS_Z); bf16_t* att = WSP(bf16_t, WS_ATT); constexpr int LDZ = 1536;
    for (size_t i = gtid; i < (size_t)NX * 32; i += gsize) {
        const int ch = (int)(i % 4), hq = (int)((i / 4) % 8), t = (int)(i / 32), kvh = hq / 4, b = t / SEQ;
        float q[128], acc[32]; float m = -1e30f, l = 0.f;
#pragma unroll
        for (int d = 0; d < 128; ++d) q[d] = bf2f(Z[(size_t)t * LDZ + hq * 128 + d]);
#pragma unroll
        for (int d = 0; d < 32; ++d) acc[d] = 0.f;
        for (int kp = 0; kp < SEQ; ++kp) { const bf16_t* zr = Z + (size_t)(b * SEQ + kp) * LDZ; att_key<128, 32>(q, acc, m, l, zr + 1024 + kvh * 128, zr + 1280 + kvh * 128 + ch * 32, 0.08838834764831845f, 0.f); }
        for (int j = 0; j < CL; ++j) { const bf16_t* zr = Z + (size_t)(NX + b * CL + j) * LDZ; att_key<128, 32>(q, acc, m, l, zr + 1024 + kvh * 128, zr + 1280 + kvh * 128 + ch * 32, 0.08838834764831845f, 0.f); }
        const float sc = 1.f / l;
#pragma unroll
        for (int d = 0; d < 32; ++d) att[(size_t)t * D + hq * 128 + ch * 32 + d] = f2bf(acc[d] * sc);
    }
}

DEVFN void ph_hgrn_gates(const Params& p, size_t gtid, size_t gsize) {
    bf16_t* Z = WSP(bf16_t, WS_Z); const float* lbv = WSP(float, WS_LBV); constexpr int LDZ = 5120;
    for (size_t i = gtid; i < (size_t)NT * D; i += gsize) {
        const size_t t = i / D; const int c = (int)(i % D);
        bf16_t* zr = Z + t * LDZ;
        zr[c] = f2bf(siluf_(bf2f(zr[c])));
        const float lb = lbv[c];
        zr[2048 + c] = f2bf((1.f - lb) * sigmoidf_(-bf2f(zr[2048 + c])));
        zr[3072 + c] = f2bf((1.f - lb) * sigmoidf_(-bf2f(zr[3072 + c])));
    }
}
DEVFN void ph_hgrn_scan(const Params& p, size_t gtid, size_t gsize) {
    const bf16_t* Z = WSP(bf16_t, WS_Z); constexpr int LDZ = 5120;
    bf16_t* of = WSP(bf16_t, WS_Y); bf16_t* ob = of + (size_t)NT * D;
    for (size_t i = gtid; i < (size_t)NBAT * 8 * 2 * 128; i += gsize) {
        const int j = (int)(i % 128), dir = (int)((i / 128) % 2), h = (int)((i / 256) % 8), b = (int)(i / 2048);
        float S[128];
#pragma unroll
        for (int k = 0; k < 128; ++k) S[k] = 0.f;
        bf16_t* od = dir ? ob : of;
        for (int step = 0; step < CL + SEQ; ++step) {
            int t;
            if (step < CL) t = NX + b * CL + (dir ? CL - 1 - step : step);
            else { const int s = step - CL; t = b * SEQ + (dir ? SEQ - 1 - s : s); }
            const bf16_t* zr = Z + (size_t)t * LDZ;
            const float vj = bf2f(zr[1024 + h * 128 + j]);
            const bf16_t* kr = zr + (dir ? 3072 : 2048) + h * 128; const bf16_t* qr = zr + h * 128;
            float o = 0.f;
#pragma unroll
            for (int k = 0; k < 128; ++k) {
                const float kk = bf2f(kr[k]);
                S[k] = (1.f - kk) * S[k] + kk * vj;
                o += bf2f(qr[k]) * S[k];
            }
            od[(size_t)t * D + h * 128 + j] = f2bf(o);
        }
    }
}
DEVFN void ph_hgrn_readout(const Params& p, size_t gtid, size_t gsize) {
    const bf16_t* Z = WSP(bf16_t, WS_Z); constexpr int LDZ = 5120;
    const bf16_t* of = WSP(bf16_t, WS_Y); const bf16_t* ob = of + (size_t)NT * D; bf16_t* att = WSP(bf16_t, WS_ATT);
    const int lane = (int)(gtid % RL);
    for (size_t it = gtid / RL; it < (size_t)NT * 8; it += gsize / RL) {
        const int h = (int)(it % 8), t = (int)(it / 8);
        const size_t base = (size_t)t * D + h * 128;
        float ss = 0.f;
        for (int k = lane; k < 128; k += RL) { const float o = bf2f(of[base + k]) + bf2f(ob[base + k]); ss += o * o; }
        ss = row_sum(ss);
        const float r = 1.f / sqrtf(ss * (1.f / 128.f) + RMS_EPS);
        for (int k = lane; k < 128; k += RL) {
            const float o = bf2f(of[base + k]) + bf2f(ob[base + k]);
            const float g = bf2f(Z[(size_t)t * LDZ + 4096 + h * 128 + k]);
            att[base + k] = f2bf(o * r * p.hgrn_norm_g[k] * siluf_(g));
        }
    }
}

DEVFN void ph_ln(const Params& p, int l, int which, int M, size_t gtid, size_t gsize) {
    float* xs = WSP(float, WS_XS); const float* Y = WSP(float, WS_Y); const float* modv = WSP(float, WS_MODV); bf16_t* hb = WSP(bf16_t, WS_HB);
    const int lane = (int)(gtid % RL);
    const float* g = p.ln_g + (size_t)(l * 2 + which) * D; const float* bb = p.ln_b + (size_t)(l * 2 + which) * D;
    for (size_t t = gtid / RL; t < (size_t)M; t += gsize / RL) {
        const float* m = modv + (size_t)(l * NMR + modrow((int)t)) * 6144; const float* gate = m + (which == 0 ? 2 * D : 5 * D);
        float* xr = xs + t * D; const float* yr = Y + t * D;
        float mu = 0.f;
        for (int c = lane; c < D; c += RL) mu += ALPHA * xr[c] + gate[c] * yr[c];
        mu = row_sum(mu) * (1.f / D);
        float var = 0.f;
        for (int c = lane; c < D; c += RL) { const float d = ALPHA * xr[c] + gate[c] * yr[c] - mu; var += d * d; }
        var = row_sum(var) * (1.f / D);
        const float rstd = 1.f / sqrtf(var + LN_EPS);
        const float* m2 = modv + (size_t)((l + 1 < DEPTH ? l + 1 : l) * NMR + modrow((int)t)) * 6144;
        for (int c = lane; c < D; c += RL) {
            const float v = (ALPHA * xr[c] + gate[c] * yr[c] - mu) * rstd * g[c] + bb[c];
            xr[c] = v;
            if (which == 0) hb[t * D + c] = f2bf(v * (1.f + m[4 * D + c]) + m[3 * D + c]);
            else if (l + 1 < DEPTH) hb[t * D + c] = f2bf(v * (1.f + m2[D + c]) + m2[c]);
            else if (t < (size_t)NX) p.out[t * D + c] = v;
        }
    }
}

DEVFN void ph_peer_scores(const Params& p, int l, int M, size_t gtid, size_t gsize) {
    const bf16_t* qp = WSP(bf16_t, WS_QP); float* sv = WSP(float, WS_SV); int* si = WSP(int, WS_SI);
    for (size_t i = gtid; i < (size_t)M * 16; i += gsize) {
        const int hp = (int)(i / M), t = (int)(i % M);
        const bf16_t* qr = qp + (size_t)t * 2048 + hp * 128;
        const float* kb = p.peer_keys + ((size_t)l * 16 + hp) * 128 * 128;
        float tv[16]; int ti[16];
#pragma unroll
        for (int j = 0; j < 16; ++j) { tv[j] = -3.0e38f; ti[j] = 0; }
        for (int n = 0; n < 128; ++n) {
            float s = 0.f;
            for (int d = 0; d < 128; ++d) s += bf2f(qr[d]) * kb[n * 128 + d];
            int ni = n;
#pragma unroll
            for (int j = 0; j < 16; ++j) if (s > tv[j]) { const float ts = tv[j]; tv[j] = s; s = ts; const int tn = ti[j]; ti[j] = ni; ni = tn; }
        }
#pragma unroll
        for (int j = 0; j < 16; ++j) { sv[((size_t)t * 16 + hp) * 16 + j] = tv[j]; si[((size_t)t * 16 + hp) * 16 + j] = ti[j]; }
    }
}
DEVFN void ph_peer_combine(const Params& p, int M, size_t gtid, size_t gsize) {
    const float* sv = WSP(float, WS_SV); const int* si = WSP(int, WS_SI); int* idx = WSP(int, WS_IDX); float* gate = WSP(float, WS_GATE);
    for (size_t i = gtid; i < (size_t)M * 8; i += gsize) {
        const int h = (int)(i % 8), t = (int)(i / 8);
        const float* s0 = sv + ((size_t)t * 16 + h * 2) * 16; const float* s1 = s0 + 16;
        const int* i0 = si + ((size_t)t * 16 + h * 2) * 16; const int* i1 = i0 + 16;
        float tv[16]; int ti[16];
#pragma unroll
        for (int j = 0; j < 16; ++j) { tv[j] = -3.0e38f; ti[j] = 0; }
        for (int a = 0; a < 16; ++a)
            for (int b = 0; b < 16; ++b) {
                float s = s0[a] + s1[b]; int ni = i0[a] * 128 + i1[b];
#pragma unroll
                for (int j = 0; j < 16; ++j) if (s > tv[j]) { const float ts = tv[j]; tv[j] = s; s = ts; const int tn = ti[j]; ti[j] = ni; ni = tn; }
            }
        float sum = 0.f;
#pragma unroll
        for (int j = 0; j < 16; ++j) sum += expf(tv[j] - tv[0]);
#pragma unroll
        for (int j = 0; j < 16; ++j) { idx[(size_t)t * 128 + h * 16 + j] = ti[j]; gate[(size_t)t * 128 + h * 16 + j] = expf(tv[j] - tv[0]) / sum; }
    }
}
DEVFN void ph_peer_act(const Params& p, int l, int M, size_t gtid, size_t gsize) {
    const int* idx = WSP(int, WS_IDX); const float* gate = WSP(float, WS_GATE); float* wa = WSP(float, WS_WA); const bf16_t* hb = WSP(bf16_t, WS_HB);
    const float* U = p.peer_u + (size_t)l * PEER_N * D;
    const int lane = (int)(gtid % RL);
    for (size_t it = gtid / RL; it < (size_t)M * 128; it += gsize / RL) {
        const size_t t = it / 128; const float* ur = U + (size_t)idx[it] * D; const bf16_t* hr = hb + t * D;
        float s = 0.f;
        for (int c = lane; c < D; c += RL) s += bf2f(hr[c]) * ur[c];
        s = row_sum(s);
        if (lane == 0) wa[it] = gate[it] * geluf_(s);
    }
}
DEVFN void ph_peer_out(const Params& p, int l, int M, size_t gtid, size_t gsize) {
    const int* idx = WSP(int, WS_IDX); const float* wa = WSP(float, WS_WA); float* y = WSP(float, WS_Y);
    const float* V = p.peer_v + (size_t)l * PEER_N * D;
    for (size_t i = gtid; i < (size_t)M * D; i += gsize) {
        const size_t t = i / D; const int d = (int)(i % D);
        float s = 0.f;
        for (int j = 0; j < 128; ++j) s += wa[t * 128 + j] * V[(size_t)idx[t * 128 + j] * D + d];
        y[i] = s;
    }
}
#ifndef CPU_TEST
DEVFN void ph_gqa_attn_mfma(const Params& p, char* lds, int bid, int G) {
    const bf16_t* Z = WSP(const bf16_t, WS_Z); bf16_t* att = WSP(bf16_t, WS_ATT);
    constexpr int NQB = SEQ / 256, LDZ = 1536;
    const bool xaff = (G & 7) == 0;
    for (int v = xaff ? (bid >> 3) : bid; v < (xaff ? NBAT * 8 * NQB / 8 : NBAT * 8 * NQB); v += xaff ? (G >> 3) : G) {
        const int u = xaff ? ((v / (4 * NQB)) * 8 + (bid & 7)) * (4 * NQB) + v % (4 * NQB) : v;
        const int qb = u % NQB, hq4 = (u / NQB) & 3, pair = u / (4 * NQB), b = pair >> 1, kvh = pair & 1, hq = kvh * 4 + hq4;
        const bf16_t* Qb = Z + (size_t)(b * SEQ + qb * 256) * LDZ + hq * 128;
        const bf16_t* Kh = Z + (size_t)(b * SEQ) * LDZ + 1024 + kvh * 128; const bf16_t* Vh = Kh + 256;
        const bf16_t* Kc = Z + (size_t)(NX + b * CL) * LDZ + 1024 + kvh * 128; const bf16_t* Vc = Kc + 256;
        att128::attn_dense_body<bf16_t>(Qb, Kh, Vh, Kc, Vc, att + (size_t)(b * SEQ + qb * 256) * D + hq * 128, SEQ + CL, lds);
        __syncthreads();
    }
}
#endif
#ifndef CPU_TEST
typedef float f32x2_t __attribute__((ext_vector_type(2)));
typedef unsigned u32x2_t __attribute__((ext_vector_type(2)));
typedef unsigned u32x4_t __attribute__((ext_vector_type(4)));
typedef float f32x4_t __attribute__((ext_vector_type(4)));
DEVFN float wave_max(float v) {
#pragma unroll
    for (int o = 1; o < 64; o <<= 1) v = fmaxf(v, __shfl_xor(v, o));
    return v;
}
DEVFN void ph_cvt_uv_fp8(const Params& p, LAS unsigned char* lds, int tid, int bid, int G) {
    const int lane = tid & 63, wv = __builtin_amdgcn_readfirstlane(tid >> 6);
    unsigned char* dst = WSP(unsigned char, WS_UV8); float* scl = WSP(float, WS_UVS);
    LAS unsigned* img = (LAS unsigned*)(lds + wv * 1024);
    for (int r = wv * G + bid; r < 8 * PEER_N; r += G * 8) {
        const int tb = r / PEER_N, l = tb >> 1, which = tb & 1, e = r % PEER_N;
        const f32x4_t* src = (const f32x4_t*)((which ? p.peer_v : p.peer_u) + ((size_t)l * PEER_N + e) * D) + lane;
        f32x4_t a[4];
#pragma unroll
        for (int j = 0; j < 4; ++j) a[j] = src[64 * j];
        if (which) {
            float ss = 0.f;
#pragma unroll
            for (int j = 0; j < 4; ++j) ss += (a[j].x * a[j].x + a[j].y * a[j].y) + (a[j].z * a[j].z + a[j].w * a[j].w);
            ss = row_sum(ss);
            const float rms = sqrtf(ss * (1.f / D)), sc = rms > 0.f ? 2.f / rms : 0.f;
#pragma unroll
            for (int j = 0; j < 4; ++j) {
                unsigned w = 0u;
                w = __builtin_amdgcn_cvt_scalef32_pk_fp4_f32(w, a[j].x * sc, a[j].y * sc, 1.0f, 0);
                w = __builtin_amdgcn_cvt_scalef32_pk_fp4_f32(w, a[j].z * sc, a[j].w * sc, 1.0f, 1);
                ((LAS unsigned short*)img)[64 * j + lane] = (unsigned short)w;
            }
            const u32x4_t o = *(const LAS u32x4_t*)((LAS unsigned char*)img + (lane & 31) * 16);
            if (lane < 32) *(u32x4_t*)(dst + (size_t)tb * PEER_N * 1024 + (size_t)(lane >> 3) * PEER_N * 128 + (size_t)e * 128 + (lane & 7) * 16) = o;
            if (lane == 0) scl[((size_t)l * PEER_N + e) * 2 + 1] = rms * 0.5f;
        } else {
            float ss = 0.f;
#pragma unroll
            for (int j = 0; j < 4; ++j) ss += (a[j].x * a[j].x + a[j].y * a[j].y) + (a[j].z * a[j].z + a[j].w * a[j].w);
            ss = row_sum(ss);
            const float step = sqrtf(ss * (1.f / D)) * (2.6f / 8.f), istep = step > 0.f ? 1.f / step : 0.f;
#pragma unroll
            for (int j = 0; j < 4; ++j) {
                unsigned w = 0u;
#pragma unroll
                for (int kk = 0; kk < 4; ++kk) { const int n = (int)fminf(fmaxf(floorf(a[j][kk] * istep), -8.f), 7.f); w |= ((unsigned)n & 15u) << (4 * kk); }
                ((LAS unsigned short*)img)[64 * j + lane] = (unsigned short)w;
            }
            const u32x4_t o = *(const LAS u32x4_t*)((LAS unsigned char*)img + (lane & 31) * 16);
            if (lane < 32) *(u32x4_t*)(dst + (size_t)tb * PEER_N * 1024 + (size_t)(lane >> 3) * PEER_N * 128 + (size_t)e * 128 + (lane & 7) * 16) = o;
            if (lane == 0) scl[((size_t)l * PEER_N + e) * 2] = step * 0.5f;
        }
    }
}
DEVFN float dot16_fp8(const u32x4_t r, const float (&h)[16]) {
    float s0 = 0.f, s1 = 0.f;
#pragma unroll
    for (int i = 0; i < 4; ++i) { const f32x2_t lo = __builtin_amdgcn_cvt_pk_f32_fp8((int)r[i], false), hi = __builtin_amdgcn_cvt_pk_f32_fp8((int)r[i], true);
        s0 = fmaf(lo.x, h[4 * i], s0); s1 = fmaf(lo.y, h[4 * i + 1], s1); s0 = fmaf(hi.x, h[4 * i + 2], s0); s1 = fmaf(hi.y, h[4 * i + 3], s1); }
    return s0 + s1;
}
DEVFN void fma16_fp8(float (&y)[16], const u32x4_t r, const float w) {
#pragma unroll
    for (int i = 0; i < 4; ++i) { const f32x2_t lo = __builtin_amdgcn_cvt_pk_f32_fp8((int)r[i], false), hi = __builtin_amdgcn_cvt_pk_f32_fp8((int)r[i], true);
        y[4 * i] = fmaf(w, lo.x, y[4 * i]); y[4 * i + 1] = fmaf(w, lo.y, y[4 * i + 1]); y[4 * i + 2] = fmaf(w, hi.x, y[4 * i + 2]); y[4 * i + 3] = fmaf(w, hi.y, y[4 * i + 3]); }
}
DEVFN float treduce64(float (&p)[64], int lane) {
#pragma unroll
    for (int i = 0; i < 32; ++i) { auto r = __builtin_amdgcn_permlane32_swap(__float_as_uint(p[i]), __float_as_uint(p[i + 32]), false, false); p[i] = __uint_as_float(r[0]) + __uint_as_float(r[1]); }
#pragma unroll
    for (int i = 0; i < 16; ++i) { auto r = __builtin_amdgcn_permlane16_swap(__float_as_uint(p[i]), __float_as_uint(p[i + 16]), false, false); p[i] = __uint_as_float(r[0]) + __uint_as_float(r[1]); }
#pragma unroll
    for (int i = 0; i < 8; ++i) { const bool up = (lane & 8) != 0; const float keep = up ? p[i + 8] : p[i], send = up ? p[i] : p[i + 8]; p[i] = keep + __shfl_xor(send, 8); }
#pragma unroll
    for (int i = 0; i < 4; ++i) { const bool up = (lane & 4) != 0; const float keep = up ? p[i + 4] : p[i], send = up ? p[i] : p[i + 4]; p[i] = keep + __shfl_xor(send, 4); }
#pragma unroll
    for (int i = 0; i < 2; ++i) { const bool up = (lane & 2) != 0; const float keep = up ? p[i + 2] : p[i], send = up ? p[i] : p[i + 2]; p[i] = keep + __shfl_xor(send, 2); }
    { const bool up = (lane & 1) != 0; const float keep = up ? p[1] : p[0], send = up ? p[0] : p[1]; p[0] = keep + __shfl_xor(send, 1); }
    return p[0];
}
DEVFN float treduce32(float (&p)[32], int lane) {
#pragma unroll
    for (int i = 0; i < 16; ++i) { auto r = __builtin_amdgcn_permlane16_swap(__float_as_uint(p[i]), __float_as_uint(p[i + 16]), false, false); p[i] = __uint_as_float(r[0]) + __uint_as_float(r[1]); }
#pragma unroll
    for (int i = 0; i < 8; ++i) { const bool up = (lane & 8) != 0; const float keep = up ? p[i + 8] : p[i], send = up ? p[i] : p[i + 8]; p[i] = keep + __shfl_xor(send, 8); }
#pragma unroll
    for (int i = 0; i < 4; ++i) { const bool up = (lane & 4) != 0; const float keep = up ? p[i + 4] : p[i], send = up ? p[i] : p[i + 4]; p[i] = keep + __shfl_xor(send, 4); }
#pragma unroll
    for (int i = 0; i < 2; ++i) { const bool up = (lane & 2) != 0; const float keep = up ? p[i + 2] : p[i], send = up ? p[i] : p[i + 2]; p[i] = keep + __shfl_xor(send, 2); }
    { const bool up = (lane & 1) != 0; const float keep = up ? p[1] : p[0], send = up ? p[0] : p[1]; p[0] = keep + __shfl_xor(send, 1); }
    return p[0] + __shfl_xor(p[0], 32);
}
DEVFN void ph_peer_experts(const Params& p, int l, int M, int tid, int bid, int G) {
    const int lane = tid & 63;
    const unsigned char* U8 = WSP(const unsigned char, WS_UV8) + (size_t)(l * 2) * PEER_N * 1024; const unsigned char* V8 = U8 + (size_t)PEER_N * 1024;
    const float* SU = WSP(const float, WS_UVS) + (size_t)(l * 2) * PEER_N; const float* SV = SU + PEER_N;
    const int* idx = WSP(const int, WS_IDX); const float* gate = WSP(const float, WS_GATE);
    float* xs = WSP(float, WS_XS); bf16_t* hb = WSP(bf16_t, WS_HB); const float* modv = WSP(const float, WS_MODV);
    const float* lg0 = p.ln_g + (size_t)(l * 2 + 1) * D + lane * 16; const float* lb0 = p.ln_b + (size_t)(l * 2 + 1) * D + lane * 16;
    for (int t = __builtin_amdgcn_readfirstlane(tid >> 6) * G + bid; t < M; t += G * 8) {
        const float* lg = lg0; const float* lb = lb0;
        asm volatile("" : "+v"(lg), "+v"(lb));
        float h[16];
        { const u32x4_t* hp = (const u32x4_t*)(hb + (size_t)t * D + lane * 16); const u32x4_t h0 = hp[0], h1 = hp[1];
#pragma unroll
          for (int i = 0; i < 4; ++i) { h[2 * i] = __uint_as_float(h0[i] << 16); h[2 * i + 1] = __uint_as_float(h0[i] & 0xffff0000u); h[8 + 2 * i] = __uint_as_float(h1[i] << 16); h[8 + 2 * i + 1] = __uint_as_float(h1[i] & 0xffff0000u); } }
        int eidx[2]; float wgt[2];
#pragma unroll
        for (int half = 0; half < 2; ++half) {
            const int myidx = idx[(size_t)t * 128 + half * 64 + lane]; const float mygate = gate[(size_t)t * 128 + half * 64 + lane];
            const float su = SU[myidx], sv = SV[myidx];
            float dsel = 0.f;
#pragma unroll
            for (int sh = 0; sh < 2; ++sh) {
                float part[32];
#pragma unroll
                for (int g = 0; g < 2; ++g) {
                    u32x4_t r[16];
                    int mi = myidx; asm volatile("" : "+v"(mi));
#pragma unroll
                    for (int j = 0; j < 16; ++j) { const int e = __builtin_amdgcn_readlane(mi, sh * 32 + g * 16 + j); r[j] = *((const u32x4_t*)(U8 + (size_t)e * 1024) + lane); }
                    __builtin_amdgcn_sched_barrier(0);
#pragma unroll
                    for (int j = 0; j < 16; ++j) { part[g * 16 + j] = dot16_fp8(r[j], h); if (j & 1) __builtin_amdgcn_sched_barrier(0); }
                }
                const float rs = treduce32(part, lane);
                dsel = ((lane >> 5) == sh) ? rs : dsel;
            }
            const float dot = dsel * su;
            const float u3 = 1.5957691216057308f * (dot + 0.044715f * dot * dot * dot);
            eidx[half] = myidx; wgt[half] = mygate * sv * dot / (1.f + __expf(-u3));
        }
        __builtin_amdgcn_sched_barrier(0);
        float y[16];
#pragma unroll
        for (int i = 0; i < 16; ++i) y[i] = 0.f;
#pragma unroll
        for (int half = 0; half < 2; ++half) {
#pragma unroll
            for (int g = 0; g < 4; ++g) {
                u32x4_t r[16];
                int mi = eidx[half]; asm volatile("" : "+v"(mi));
#pragma unroll
                for (int j = 0; j < 16; ++j) { const int e = __builtin_amdgcn_readlane(mi, g * 16 + j); r[j] = *((const u32x4_t*)(V8 + (size_t)e * 1024) + lane); }
                __builtin_amdgcn_sched_barrier(0);
#pragma unroll
                for (int j = 0; j < 16; ++j) { const float we = __uint_as_float(__builtin_amdgcn_readlane(__float_as_uint(wgt[half]), g * 16 + j)); fma16_fp8(y, r[j], we); if (j & 1) __builtin_amdgcn_sched_barrier(0); }
            }
        }
        const int mr = modrow(t);
        const float* m = modv + (size_t)(l * NMR + mr) * 6144 + lane * 16;
        float* xr = xs + (size_t)t * D + lane * 16;
        float v[16]; float s = 0.f;
#pragma unroll
        for (int i = 0; i < 4; ++i) { const f32x4_t xv = ((const f32x4_t*)xr)[i], gv = ((const f32x4_t*)(m + 5 * D))[i];
#pragma unroll
            for (int k = 0; k < 4; ++k) { v[4 * i + k] = ALPHA * xv[k] + gv[k] * y[4 * i + k]; s += v[4 * i + k]; } }
        const float mu = row_sum(s) * (1.f / D);
        float q = 0.f;
#pragma unroll
        for (int i = 0; i < 16; ++i) { v[i] -= mu; q += v[i] * v[i]; }
        const float rstd = 1.f / sqrtf(row_sum(q) * (1.f / D) + LN_EPS);
#pragma unroll
        for (int i = 0; i < 4; ++i) { const f32x4_t gg = ((const f32x4_t*)lg)[i], bb = ((const f32x4_t*)lb)[i];
#pragma unroll
            for (int k = 0; k < 4; ++k) v[4 * i + k] = v[4 * i + k] * rstd * gg[k] + bb[k]; }
#pragma unroll
        for (int i = 0; i < 4; ++i) ((f32x4_t*)xr)[i] = (f32x4_t){v[4 * i], v[4 * i + 1], v[4 * i + 2], v[4 * i + 3]};
        if (l + 1 < DEPTH) {
            const float* m2 = modv + (size_t)((l + 1) * NMR + mr) * 6144 + lane * 16;
            u32x4_t o0, o1;
#pragma unroll
            for (int i = 0; i < 4; ++i) { const f32x4_t sh = ((const f32x4_t*)m2)[i], sc = ((const f32x4_t*)(m2 + D))[i];
                const unsigned a = (unsigned)f2bf(v[4 * i] * (1.f + sc[0]) + sh[0]) | ((unsigned)f2bf(v[4 * i + 1] * (1.f + sc[1]) + sh[1]) << 16);
                const unsigned b = (unsigned)f2bf(v[4 * i + 2] * (1.f + sc[2]) + sh[2]) | ((unsigned)f2bf(v[4 * i + 3] * (1.f + sc[3]) + sh[3]) << 16);
                if (i < 2) { o0[2 * i] = a; o0[2 * i + 1] = b; } else { o1[2 * (i - 2)] = a; o1[2 * (i - 2) + 1] = b; } }
            u32x4_t* hp = (u32x4_t*)(hb + (size_t)t * D + lane * 16); hp[0] = o0; hp[1] = o1;
        } else if (t < NX) {
            float* op = p.out + (size_t)t * D + lane * 16;
#pragma unroll
            for (int i = 0; i < 4; ++i) ((f32x4_t*)op)[i] = (f32x4_t){v[4 * i], v[4 * i + 1], v[4 * i + 2], v[4 * i + 3]};
        }
    }
}
#endif
#ifndef CPU_TEST
typedef short bf16x8_t __attribute__((ext_vector_type(8)));
typedef float f32x16_t __attribute__((ext_vector_type(16)));
DEVFN void ph_cvt_keys(const Params& p, size_t gtid, size_t gsize) {
    bf16_t* kb = WSP(bf16_t, WS_KEYS);
    for (size_t i = gtid; i < (size_t)4 * 16 * 128 * 128; i += gsize) kb[i] = f2bf(p.peer_keys[i]);
}
DEVFN void ce1(float& a, float& b) { const float hi = fmaxf(a, b), lo = fminf(a, b); a = hi; b = lo; }
DEVFN void ce2(float& a, int& ia, float& b, int& ib) { const bool sw = b > a; const float ta = sw ? b : a, tb = sw ? a : b; const int ja = sw ? ib : ia, jb = sw ? ia : ib; a = ta; b = tb; ia = ja; ib = jb; }
DEVFN void bsort16(float (&v)[16]) {
#pragma unroll
    for (int k = 2; k <= 16; k <<= 1)
#pragma unroll
        for (int j = k >> 1; j > 0; j >>= 1)
#pragma unroll
            for (int i = 0; i < 16; ++i) { const int l = i ^ j; if (l > i) { if ((i & k) == 0) ce1(v[i], v[l]); else ce1(v[l], v[i]); } }
}
DEVFN void bmerge16(float (&a)[16], const float (&b)[16]) {
#pragma unroll
    for (int i = 0; i < 16; ++i) a[i] = fmaxf(a[i], b[15 - i]);
#pragma unroll
    for (int j = 8; j > 0; j >>= 1)
#pragma unroll
        for (int i = 0; i < 16; ++i) { const int l = i ^ j; if (l > i) ce1(a[i], a[l]); }
}
DEVFN void bsort16p(float (&v)[16], int (&x)[16]) {
#pragma unroll
    for (int k = 2; k <= 16; k <<= 1)
#pragma unroll
        for (int j = k >> 1; j > 0; j >>= 1)
#pragma unroll
            for (int i = 0; i < 16; ++i) { const int l = i ^ j; if (l > i) { if ((i & k) == 0) ce2(v[i], x[i], v[l], x[l]); else ce2(v[l], x[l], v[i], x[i]); } }
}
DEVFN void bmerge16p(float (&a)[16], int (&ia)[16], const float (&b)[16], const int (&ib)[16]) {
#pragma unroll
    for (int i = 0; i < 16; ++i) { const bool sw = b[15 - i] > a[i]; a[i] = sw ? b[15 - i] : a[i]; ia[i] = sw ? ib[15 - i] : ia[i]; }
#pragma unroll
    for (int j = 8; j > 0; j >>= 1)
#pragma unroll
        for (int i = 0; i < 16; ++i) { const int l = i ^ j; if (l > i) ce2(a[i], ia[i], a[l], ia[l]); }
}
DEVFN void peer_top16(float (&top)[16], const bf16_t* qrow  , const bf16_t* kb  , int hi) {
    bf16x8_t qf[8];
#pragma unroll
    for (int ks = 0; ks < 8; ++ks) qf[ks] = *(const bf16x8_t*)(qrow + ks * 16);
    float grp[2][16];
#pragma unroll
    for (int nb = 0; nb < 4; ++nb) {
        f32x16_t acc = {};
#pragma unroll
        for (int ks = 0; ks < 8; ++ks) { const bf16x8_t kf = *(const bf16x8_t*)(kb + (size_t)nb * 32 * 128 + ks * 16); acc = __builtin_amdgcn_mfma_f32_32x32x16_bf16(kf, qf[ks], acc, 0, 0, 0); }
        float v[16];
#pragma unroll
        for (int r = 0; r < 16; ++r) { const unsigned n = (unsigned)(nb * 32 + (r & 3) + 8 * (r >> 2) + 4 * hi); v[r] = __uint_as_float((__float_as_uint(acc[r]) & ~127u) | n); }
        bsort16(v);
        if (nb == 0) {
#pragma unroll
            for (int r = 0; r < 16; ++r) grp[0][r] = v[r];
        } else if (nb == 1) bmerge16(grp[0], v);
        else if (nb == 2) {
#pragma unroll
            for (int r = 0; r < 16; ++r) grp[1][r] = v[r];
        } else { bmerge16(grp[1], v); bmerge16(grp[0], grp[1]); }
        __builtin_amdgcn_sched_barrier(0);
    }
    float oth[16];
#pragma unroll
    for (int r = 0; r < 16; ++r) { auto rr_ = __builtin_amdgcn_permlane32_swap(__float_as_uint(grp[0][r]), __float_as_uint(grp[0][r]), false, false); oth[r] = __uint_as_float(hi ? rr_[0] : rr_[1]); }
    bmerge16(grp[0], oth);
#pragma unroll
    for (int r = 0; r < 16; ++r) top[r] = grp[0][r];
}
DEVFN void ph_peer_route(const Params& p, int l, int M, LAS unsigned char* lds, int tid, int bid, int G) {
    const int lane = tid & 63, hi = lane >> 5, tl = lane & 31;
    const bf16_t* qp = WSP(const bf16_t, WS_QP); const bf16_t* keys = WSP(const bf16_t, WS_KEYS) + (size_t)l * 16 * 128 * 128;
    int* idx = WSP(int, WS_IDX); float* gate = WSP(float, WS_GATE);
    LAS unsigned char* tabl = lds + (tid * 36);
#pragma unroll 1
    for (int item = __builtin_amdgcn_readfirstlane(tid >> 6) * G + bid; item < (M / 32) * 8; item += G * 8) {
        int tile = item >> 3, h = item & 7;
        asm volatile("" : "+s"(tile), "+s"(h));
        const int t = tile * 32 + tl;
        {
            float ta[16], tb[16];
            peer_top16(ta, qp + (size_t)t * 2048 + (h * 2) * 128 + 8 * hi, keys + ((size_t)(h * 2) * 128 + tl) * 128 + 8 * hi, hi);
            __builtin_amdgcn_sched_barrier(0);
            peer_top16(tb, qp + (size_t)t * 2048 + (h * 2 + 1) * 128 + 8 * hi, keys + ((size_t)(h * 2 + 1) * 128 + tl) * 128 + 8 * hi, hi);
#pragma unroll
            for (int j = 0; j < 4; ++j) {
                ((LAS unsigned*)tabl)[j] = (__float_as_uint(ta[4 * j]) & 127u) | ((__float_as_uint(ta[4 * j + 1]) & 127u) << 8) | ((__float_as_uint(ta[4 * j + 2]) & 127u) << 16) | ((__float_as_uint(ta[4 * j + 3]) & 127u) << 24);
                ((LAS unsigned*)tabl)[4 + j] = (__float_as_uint(tb[4 * j]) & 127u) | ((__float_as_uint(tb[4 * j + 1]) & 127u) << 8) | ((__float_as_uint(tb[4 * j + 2]) & 127u) << 16) | ((__float_as_uint(tb[4 * j + 3]) & 127u) << 24);
            }
            float cs[4][16]; int n = 0;
#pragma unroll
            for (int a = 0; a < 16; ++a)
#pragma unroll
                for (int b = 0; b < 16; ++b)
                    if ((a + 1) * (b + 1) <= 16) {
                        const float sm = __uint_as_float(__float_as_uint(ta[a]) & ~127u) + __uint_as_float(__float_as_uint(tb[b]) & ~127u);
                        cs[n >> 4][n & 15] = __uint_as_float((__float_as_uint(sm) & ~255u) | (unsigned)(a * 16 + b)); ++n;
                    }
#pragma unroll
            for (int k = 50; k < 64; ++k) cs[k >> 4][k & 15] = -3.0e38f;
            bsort16(cs[0]); bsort16(cs[1]); bsort16(cs[2]); bsort16(cs[3]);
            bmerge16(cs[0], cs[1]); bmerge16(cs[2], cs[3]); bmerge16(cs[0], cs[2]);
            float e[16], sum = 0.f; const float mx = __uint_as_float(__float_as_uint(cs[0][0]) & ~255u);
#pragma unroll
            for (int j = 0; j < 16; ++j) { e[j] = __expf(__uint_as_float(__float_as_uint(cs[0][j]) & ~255u) - mx); sum += e[j]; }
            const float rs = 1.f / sum;
            if (hi == 0) {
                unsigned id[16];
#pragma unroll
                for (int j = 0; j < 16; ++j) { const unsigned ab = __float_as_uint(cs[0][j]) & 255u; id[j] = (unsigned)tabl[ab >> 4] * 128u + (unsigned)tabl[16 + (ab & 15u)]; }
                u32x4_t* op = (u32x4_t*)(idx + (size_t)t * 128 + h * 16);
#pragma unroll
                for (int j = 0; j < 4; ++j) op[j] = (u32x4_t){id[4 * j], id[4 * j + 1], id[4 * j + 2], id[4 * j + 3]};
            } else {
                f32x4_t* op = (f32x4_t*)(gate + (size_t)t * 128 + h * 16);
#pragma unroll
                for (int j = 0; j < 4; ++j) op[j] = (f32x4_t){e[4 * j] * rs, e[4 * j + 1] * rs, e[4 * j + 2] * rs, e[4 * j + 3] * rs};
            }
        }
    }
}
#endif
#ifndef CPU_TEST
typedef float f32x4v __attribute__((ext_vector_type(4)));
typedef short s16x4v __attribute__((ext_vector_type(4)));
constexpr int GS_QS = 0, GS_KS = 8704, GS_KE = 17408, GS_VT = 27648, GS_D = 37888, GS_GS = 38400, GS_END = 40448;
typedef __bf16 bf16x2_hw __attribute__((ext_vector_type(2)));
DEVFN unsigned pk_bf16(float lo, float hi) { const f32x2_t f = {lo, hi}; return __builtin_bit_cast(unsigned, __builtin_convertvector(f, bf16x2_hw)); }
DEVFN void ph_hgrn_scan_mfma(const Params& p, LAS unsigned char* lds, int tid, int bid) {
    if (bid >= NBAT * 16) return;
    const int dir = bid & 1, h = (bid >> 1) & 7, b = bid >> 4;
    const bf16_t* Z = WSP(const bf16_t, WS_Z); const float* lbv = WSP(const float, WS_LBV); constexpr int LDZ = 5120;
    bf16_t* od = WSP(bf16_t, WS_Y) + (dir ? (size_t)NT * D : 0);
    const int lane = tid & 63, w = tid >> 6, c16 = lane & 15, g = lane >> 4;
    const int pk = tid & 127, ptg = tid >> 7;
    const float lb = lbv[h * 128 + pk];
    constexpr int NCH = (CL + SEQ) / 32;
    f32x4v S[8];
#pragma unroll
    for (int i = 0; i < 8; ++i) S[i] = (f32x4v){0.f, 0.f, 0.f, 0.f};
    auto trow = [&](int s) -> size_t { return s < CL ? (size_t)(NX + b * CL + (dir ? CL - 1 - s : s)) : (size_t)(b * SEQ + (dir ? SEQ - 1 - (s - CL) : s - CL)); };
    unsigned short rq[8], rf[8], rv[8];
#pragma unroll
    for (int i = 0; i < 8; ++i) { const bf16_t* zr = Z + trow(8 * ptg + i) * LDZ + h * 128 + pk; rq[i] = zr[0]; rv[i] = zr[1024]; rf[i] = zr[dir ? 3072 : 2048]; }
#pragma unroll 1
    for (int c = 0; c < NCH; ++c) {
        float qv[8], kk[8], cum[8], vv[8]; float run = 0.f;
#pragma unroll
        for (int i = 0; i < 8; ++i) {
            const float f = lb + (1.f - lb) / (1.f + __expf(-bf2f(rf[i])));
            run += __logf(f); cum[i] = run; kk[i] = 1.f - f;
            const float q = bf2f(rq[i]); qv[i] = q / (1.f + __expf(-q)); vv[i] = bf2f(rv[i]);
        }
        if (c + 1 < NCH) {
#pragma unroll
            for (int i = 0; i < 8; ++i) { const bf16_t* zr = Z + trow((c + 1) * 32 + 8 * ptg + i) * LDZ + h * 128 + pk; rq[i] = zr[0]; rv[i] = zr[1024]; rf[i] = zr[dir ? 3072 : 2048]; }
        }
        ((LAS float*)(lds + GS_GS))[ptg * 128 + pk] = run;
        __syncthreads();
        float off = 0.f, bend = 0.f;
#pragma unroll
        for (int j = 0; j < 4; ++j) { const float gsum = ((LAS float*)(lds + GS_GS))[j * 128 + pk]; off += j < ptg ? gsum : 0.f; bend += gsum; }
        unsigned kew[4], vtw[4];
#pragma unroll
        for (int i = 0; i < 8; ++i) {
            const float B = off + cum[i], eB = __expf(B), eN = __expf(-B), eE = __expf(bend - B);
            const int t = 8 * ptg + i;
            *(LAS bf16_t*)(lds + GS_QS + t * 272 + pk * 2) = f2bf(qv[i] * eB);
            *(LAS bf16_t*)(lds + GS_KS + t * 272 + pk * 2) = f2bf(kk[i] * eN);
            const unsigned ke = f2bf(kk[i] * eE), vt = f2bf(vv[i]);
            if (i & 1) { kew[i >> 1] |= ke << 16; vtw[i >> 1] |= vt << 16; } else { kew[i >> 1] = ke; vtw[i >> 1] = vt; }
        }
        *(LAS u32x4_t*)(lds + GS_KE + pk * 80 + ptg * 16) = (u32x4_t){kew[0], kew[1], kew[2], kew[3]};
        *(LAS u32x4_t*)(lds + GS_VT + pk * 80 + ptg * 16) = (u32x4_t){vtw[0], vtw[1], vtw[2], vtw[3]};
        if (ptg == 0) ((LAS float*)(lds + GS_D))[pk] = __expf(bend);
        __syncthreads();
        f32x4v X00 = {0.f, 0.f, 0.f, 0.f}, X01 = X00, X11 = X00;
#pragma unroll
        for (int ks = 0; ks < 4; ++ks) {
            const bf16x8_t a0 = *(const LAS bf16x8_t*)(lds + GS_KS + c16 * 272 + ks * 64 + g * 16), a1 = *(const LAS bf16x8_t*)(lds + GS_KS + (16 + c16) * 272 + ks * 64 + g * 16);
            const bf16x8_t b0 = *(const LAS bf16x8_t*)(lds + GS_QS + c16 * 272 + ks * 64 + g * 16), b1 = *(const LAS bf16x8_t*)(lds + GS_QS + (16 + c16) * 272 + ks * 64 + g * 16);
            X00 = __builtin_amdgcn_mfma_f32_16x16x32_bf16(a0, b0, X00, 0, 0, 0);
            X01 = __builtin_amdgcn_mfma_f32_16x16x32_bf16(a0, b1, X01, 0, 0, 0);
            X11 = __builtin_amdgcn_mfma_f32_16x16x32_bf16(a1, b1, X11, 0, 0, 0);
        }
#pragma unroll
        for (int r = 0; r < 4; ++r) { const bool keep = (4 * g + r) <= c16; X00[r] = keep ? X00[r] : 0.f; X11[r] = keep ? X11[r] : 0.f; }
        const u32x4_t p0w = (u32x4_t){pk_bf16(X00[0], X00[1]), pk_bf16(X00[2], X00[3]), 0u, 0u};
        const u32x4_t p1w = (u32x4_t){pk_bf16(X01[0], X01[1]), pk_bf16(X01[2], X01[3]), pk_bf16(X11[0], X11[1]), pk_bf16(X11[2], X11[3])};
        const int vrow = (16 * w + c16) * 80;
        const s16x4v vlo = *(const LAS s16x4v*)(lds + GS_VT + vrow + g * 8), vhi = *(const LAS s16x4v*)(lds + GS_VT + vrow + 32 + g * 8);
        const bf16x8_t vperm = (bf16x8_t){vlo[0], vlo[1], vlo[2], vlo[3], vhi[0], vhi[1], vhi[2], vhi[3]};
        f32x4v o0 = {0.f, 0.f, 0.f, 0.f}, o1 = o0;
        o0 = __builtin_amdgcn_mfma_f32_16x16x32_bf16(__builtin_bit_cast(bf16x8_t, p0w), vperm, o0, 0, 0, 0);
        o1 = __builtin_amdgcn_mfma_f32_16x16x32_bf16(__builtin_bit_cast(bf16x8_t, p1w), vperm, o1, 0, 0, 0);
#pragma unroll
        for (int ks = 0; ks < 4; ++ks) {
            const u32x4_t sw = (u32x4_t){pk_bf16(S[2 * ks][0], S[2 * ks][1]), pk_bf16(S[2 * ks][2], S[2 * ks][3]), pk_bf16(S[2 * ks + 1][0], S[2 * ks + 1][1]), pk_bf16(S[2 * ks + 1][2], S[2 * ks + 1][3])};
            const bf16x8_t sb = __builtin_bit_cast(bf16x8_t, sw);
            const s16x4v q0l = *(const LAS s16x4v*)(lds + GS_QS + c16 * 272 + ks * 64 + g * 8), q0h = *(const LAS s16x4v*)(lds + GS_QS + c16 * 272 + ks * 64 + 32 + g * 8);
            const s16x4v q1l = *(const LAS s16x4v*)(lds + GS_QS + (16 + c16) * 272 + ks * 64 + g * 8), q1h = *(const LAS s16x4v*)(lds + GS_QS + (16 + c16) * 272 + ks * 64 + 32 + g * 8);
            o0 = __builtin_amdgcn_mfma_f32_16x16x32_bf16((bf16x8_t){q0l[0], q0l[1], q0l[2], q0l[3], q0h[0], q0h[1], q0h[2], q0h[3]}, sb, o0, 0, 0, 0);
            o1 = __builtin_amdgcn_mfma_f32_16x16x32_bf16((bf16x8_t){q1l[0], q1l[1], q1l[2], q1l[3], q1h[0], q1h[1], q1h[2], q1h[3]}, sb, o1, 0, 0, 0);
        }
#pragma unroll
        for (int r = 0; r < 4; ++r) {
            od[trow(c * 32 + 4 * g + r) * D + h * 128 + 16 * w + c16] = f2bf(o0[r]);
            od[trow(c * 32 + 16 + 4 * g + r) * D + h * 128 + 16 * w + c16] = f2bf(o1[r]);
        }
        const bf16x8_t vb = *(const LAS bf16x8_t*)(lds + GS_VT + vrow + g * 16);
#pragma unroll
        for (int kt = 0; kt < 8; ++kt) {
            const f32x4v dv = *(const LAS f32x4v*)(lds + GS_D + (16 * kt + 4 * g) * 4);
            const bf16x8_t ka = *(const LAS bf16x8_t*)(lds + GS_KE + (16 * kt + c16) * 80 + g * 16);
            S[kt] = __builtin_amdgcn_mfma_f32_16x16x32_bf16(ka, vb, S[kt] * dv, 0, 0, 0);
        }
        __syncthreads();
    }
}
#endif
#ifndef CPU_TEST
constexpr int AW_K = 0, AW_V = 4608, AW_BYTES = 9728;
struct AttW { f32x16_t o0, o1; float m, l; };
DEVFN void attw_load(u32x4_t (&kreg)[4], u32x4_t (&vreg)[4], const bf16_t* kp, const bf16_t* vp) {
#pragma unroll
    for (int i = 0; i < 4; ++i) { kreg[i] = ((const u32x4_t*)kp)[i]; vreg[i] = ((const u32x4_t*)vp)[i]; }
}
template <class F>
DEVFN void attw_tile(AttW& a, const bf16x8_t (&qf)[4], const u32x4_t (&kreg)[4], const u32x4_t (&vreg)[4], LAS unsigned char* wl, int lane, float c2, F bias2) {
    const int krow = lane >> 1, dhalf = lane & 1, q31 = lane & 31, hi = lane >> 5;
#pragma unroll
    for (int i = 0; i < 4; ++i) *(LAS u32x4_t*)(wl + AW_K + krow * 144 + dhalf * 64 + i * 16) = kreg[i];
#pragma unroll
    for (int i = 0; i < 4; ++i)
#pragma unroll
        for (int e = 0; e < 4; ++e) { const int d = dhalf * 32 + i * 8 + e * 2;
            *(LAS bf16_t*)(wl + AW_V + d * 80 + krow * 2) = (bf16_t)(vreg[i][e] & 0xffffu); *(LAS bf16_t*)(wl + AW_V + (d + 1) * 80 + krow * 2) = (bf16_t)(vreg[i][e] >> 16); }
    f32x16_t s = {};
#pragma unroll
    for (int ks = 0; ks < 4; ++ks) { const bf16x8_t kf = *(const LAS bf16x8_t*)(wl + AW_K + q31 * 144 + ks * 32 + hi * 16); s = __builtin_amdgcn_mfma_f32_32x32x16_bf16(kf, qf[ks], s, 0, 0, 0); }
    float mx = -1e30f;
#pragma unroll
    for (int r = 0; r < 16; ++r) { s[r] = s[r] * c2 + bias2(r); mx = fmaxf(mx, s[r]); }
    { auto rr_ = __builtin_amdgcn_permlane32_swap(__float_as_uint(mx), __float_as_uint(mx), false, false); mx = fmaxf(__uint_as_float(rr_[0]), __uint_as_float(rr_[1])); }
    const float mnew = fmaxf(a.m, mx), alpha = __builtin_amdgcn_exp2f(a.m - mnew); a.m = mnew;
    float ps = 0.f;
#pragma unroll
    for (int r = 0; r < 16; ++r) { s[r] = __builtin_amdgcn_exp2f(s[r] - mnew); ps += s[r]; }
    a.l = a.l * alpha + ps;
#pragma unroll
    for (int r = 0; r < 16; ++r) { a.o0[r] *= alpha; a.o1[r] *= alpha; }
    const u32x4_t pw0 = (u32x4_t){pk_bf16(s[0], s[1]), pk_bf16(s[2], s[3]), pk_bf16(s[4], s[5]), pk_bf16(s[6], s[7])};
    const u32x4_t pw1 = (u32x4_t){pk_bf16(s[8], s[9]), pk_bf16(s[10], s[11]), pk_bf16(s[12], s[13]), pk_bf16(s[14], s[15])};
    const bf16x8_t pb0 = __builtin_bit_cast(bf16x8_t, pw0), pb1 = __builtin_bit_cast(bf16x8_t, pw1);
#pragma unroll
    for (int db = 0; db < 2; ++db) {
        const LAS unsigned char* vr = wl + AW_V + (32 * db + q31) * 80 + hi * 8;
        const s16x4v a0 = *(const LAS s16x4v*)(vr), a1 = *(const LAS s16x4v*)(vr + 16), b0 = *(const LAS s16x4v*)(vr + 32), b1 = *(const LAS s16x4v*)(vr + 48);
        const bf16x8_t vf0 = (bf16x8_t){a0[0], a0[1], a0[2], a0[3], a1[0], a1[1], a1[2], a1[3]}, vf1 = (bf16x8_t){b0[0], b0[1], b0[2], b0[3], b1[0], b1[1], b1[2], b1[3]};
        if (db == 0) { a.o0 = __builtin_amdgcn_mfma_f32_32x32x16_bf16(vf0, pb0, a.o0, 0, 0, 0); a.o0 = __builtin_amdgcn_mfma_f32_32x32x16_bf16(vf1, pb1, a.o0, 0, 0, 0); }
        else { a.o1 = __builtin_amdgcn_mfma_f32_32x32x16_bf16(vf0, pb0, a.o1, 0, 0, 0); a.o1 = __builtin_amdgcn_mfma_f32_32x32x16_bf16(vf1, pb1, a.o1, 0, 0, 0); }
    }
}
DEVFN void attw_store(const AttW& a, float sc, LAS unsigned char* wl, int lane, bf16_t* orow0, size_t ldo, int skip16 = 0) {
    const int q31 = lane & 31, hi = lane >> 5;
#pragma unroll
    for (int r = 0; r < 16; ++r) { const int d = (r & 3) + 8 * (r >> 2) + 4 * hi;
        *(LAS bf16_t*)(wl + q31 * 144 + d * 2) = f2bf(a.o0[r] * sc); *(LAS bf16_t*)(wl + q31 * 144 + (32 + d) * 2) = f2bf(a.o1[r] * sc); }
    const int qrow = lane >> 1, dhalf = lane & 1;
#pragma unroll
    for (int i = 0; i < 4; ++i) { const u32x4_t v = *(const LAS u32x4_t*)(wl + qrow * 144 + dhalf * 64 + i * 16); *(u32x4_t*)(orow0 + (size_t)(qrow + (qrow >> 4) * skip16) * ldo + dhalf * 32 + i * 8) = v; }
}
DEVFN void attw_qload(bf16x8_t (&qf)[4], const bf16_t* qrow  ) {
#pragma unroll
    for (int ks = 0; ks < 4; ++ks) qf[ks] = *(const bf16x8_t*)(qrow + ks * 16);
}
constexpr float LOG2E = 1.4426950408889634f;
DEVFN void ph_swa_attn_mfma(const Params& p, LAS unsigned char* lds, int tid, int bid, int G) {
    const bf16_t* Z = WSP(const bf16_t, WS_Z); bf16_t* att = WSP(bf16_t, WS_ATT); constexpr int LDZ = 1536;
    const int lane = tid & 63, wv = __builtin_amdgcn_readfirstlane(tid >> 6), q31 = lane & 31, hi = lane >> 5, krow = lane >> 1, dhalf = lane & 1;
    LAS unsigned char* wl = lds + wv * AW_BYTES;
    constexpr int XT = SEQ / 32, CT = CL / 32, NIT = NBAT * 4 * (XT + CT) * 4;
    const float c2 = 0.125f * LOG2E;
    for (int it = wv * G + bid; it < NIT; it += G * 8) {
        const int hg = it & 3, qt = (it >> 2) % (XT + CT), kvh = ((it >> 2) / (XT + CT)) & 3, b = (it >> 2) / ((XT + CT) * 4), hq = kvh * 4 + hg;
        const bool isx = qt < XT; const int q0 = isx ? qt * 32 : (qt - XT) * 32;
        const size_t qtok0 = isx ? (size_t)b * SEQ + q0 : (size_t)NX + b * CL + q0;
        bf16x8_t qf[4]; attw_qload(qf, Z + (qtok0 + q31) * LDZ + hq * 64 + 8 * hi);
        AttW a; a.o0 = (f32x16_t){}; a.o1 = (f32x16_t){}; a.m = -1e30f; a.l = 0.f;
        const int lo = isx ? imax(0, q0 - 128) : 0, hiK = isx ? imin(SEQ - 32, q0 + 128) : -32;
        const int nband = (hiK - lo) / 32 + 1, ntile = CT + (isx ? nband : 0);
        const size_t koff = 1024 + kvh * 64 + dhalf * 32, voff = 1280 + kvh * 64 + dhalf * 32;
        auto krow_tok = [&](int ti) -> size_t { return ti < CT ? (size_t)NX + b * CL + ti * 32 + krow : (size_t)b * SEQ + lo + (ti - CT) * 32 + krow; };
        u32x4_t kr[4], vr[4];
        { const size_t tk = krow_tok(0); attw_load(kr, vr, Z + tk * LDZ + koff, Z + tk * LDZ + voff); }
#pragma unroll 1
        for (int ti = 0; ti < ntile; ++ti) {
            u32x4_t kn[4], vn[4];
            { const size_t tk = krow_tok(ti + 1 < ntile ? ti + 1 : ti); attw_load(kn, vn, Z + tk * LDZ + koff, Z + tk * LDZ + voff); }
            if (ti < CT) attw_tile(a, qf, kr, vr, wl, lane, c2, [](int) { return 0.f; });
            else { const int dk = lo + (ti - CT) * 32 - q0 - q31 + 4 * hi;
                attw_tile(a, qf, kr, vr, wl, lane, c2, [dk](int r) { const int dd = dk + (r & 3) + 8 * (r >> 2); return (dd > 128 || dd < -128) ? -1e30f : 0.f; }); }
#pragma unroll
            for (int i = 0; i < 4; ++i) { kr[i] = kn[i]; vr[i] = vn[i]; }
        }
        const float sk2 = p.swa_sink[hq] * LOG2E, mf = fmaxf(a.m, sk2), al = __builtin_amdgcn_exp2f(a.m - mf);
        const float lt = (a.l + __shfl_xor(a.l, 32)) * al + __builtin_amdgcn_exp2f(sk2 - mf);
        attw_store(a, al / lt, wl, lane, att + qtok0 * D + hq * 64, D);
    }
}
DEVFN void ph_na_attn_mfma(const Params& p, LAS unsigned char* lds, int tid, int bid, int G) {
    const bf16_t* Z = WSP(const bf16_t, WS_Z); bf16_t* att = WSP(bf16_t, WS_ATT); constexpr int LDZ = 3072;
    const int lane = tid & 63, wv = __builtin_amdgcn_readfirstlane(tid >> 6), q31 = lane & 31, hi = lane >> 5, krow = lane >> 1, dhalf = lane & 1;
    LAS unsigned char* wl = lds + wv * AW_BYTES;
    constexpr int XT = SEQ / 32, CT = CL / 32, NIT = NBAT * 16 * (XT + CT);
    const float c2 = 0.125f * LOG2E;
    for (int it = wv * G + bid; it < NIT; it += G * 8) {
        const int qt = it % (XT + CT), hq = (it / (XT + CT)) & 15, b = it / ((XT + CT) * 16);
        const bool isx = qt < XT; const int q0 = isx ? qt * 32 : (qt - XT) * 32;
        const size_t qtok0 = isx ? (size_t)b * SEQ + q0 : (size_t)NX + b * CL + q0;
        bf16x8_t qf[4]; attw_qload(qf, Z + (qtok0 + q31) * LDZ + hq * 64 + 8 * hi);
        AttW a; a.o0 = (f32x16_t){}; a.o1 = (f32x16_t){}; a.m = -1e30f; a.l = 0.f;
        const int r = q0 / GW, c = (q0 % GW) + q31;
        const int rstart = iclamp(r - 4, 0, NROWS - 8), cstart = iclamp(c - 8, 0, GW - 16);
        const int ntile = CT + (isx ? 16 : 0);
        const size_t koff = 1024 + hq * 64 + dhalf * 32, voff = 2048 + hq * 64 + dhalf * 32;
        auto krow_tok = [&](int ti) -> size_t { return ti < CT ? (size_t)NX + b * CL + ti * 32 + krow : (size_t)b * SEQ + (rstart + ((ti - CT) >> 1)) * GW + ((ti - CT) & 1) * 32 + krow; };
        const float* rpb = p.na_rpb + (size_t)hq * 15 * 31;
        u32x4_t kr[4], vr[4];
        { const size_t tk = krow_tok(0); attw_load(kr, vr, Z + tk * LDZ + koff, Z + tk * LDZ + voff); }
#pragma unroll 1
        for (int ti = 0; ti < ntile; ++ti) {
            u32x4_t kn[4], vn[4];
            { const size_t tk = krow_tok(ti + 1 < ntile ? ti + 1 : ti); attw_load(kn, vn, Z + tk * LDZ + koff, Z + tk * LDZ + voff); }
            if (ti < CT) attw_tile(a, qf, kr, vr, wl, lane, c2, [](int) { return 0.f; });
            else { const int kr_ = rstart + ((ti - CT) >> 1), kc0 = ((ti - CT) & 1) * 32 + 4 * hi;
                const float* rp = rpb + (kr_ - r + 7) * 31 + 15 - c;
                attw_tile(a, qf, kr, vr, wl, lane, c2, [=](int rr) { const int kc = kc0 + (rr & 3) + 8 * (rr >> 2); const bool ok = kc >= cstart && kc < cstart + 16;
                    return ok ? rp[ok ? kc : c] * LOG2E : -1e30f; }); }
#pragma unroll
            for (int i = 0; i < 4; ++i) { kr[i] = kn[i]; vr[i] = vn[i]; }
        }
        const float lt = a.l + __shfl_xor(a.l, 32);
        attw_store(a, 1.f / lt, wl, lane, att + qtok0 * D + hq * 64, D);
    }
}
#endif
#ifndef CPU_TEST
DEVFN void tr_tile(const float* W, int N, bf16_t* WT, int item, LAS float* scr, int lane) {
    const int nblk = N / 32, kb = item / nblk, nb = item % nblk, k0 = 64 * kb, n0 = 32 * nb;
#pragma unroll 8
    for (int i = 0; i < 32; ++i) { const int kk = 2 * i + (lane >> 5); scr[kk * 33 + (lane & 31)] = W[(size_t)(k0 + kk) * N + n0 + (lane & 31)]; }
    const int c = lane & 7;
#pragma unroll
    for (int j = 0; j < 4; ++j) { const int n = (lane >> 3) + 8 * j; const LAS float* sp = scr + (8 * c) * 33 + n;
        u32x4_t o; o.x = pk_bf16(sp[0 * 33], sp[1 * 33]); o.y = pk_bf16(sp[2 * 33], sp[3 * 33]); o.z = pk_bf16(sp[4 * 33], sp[5 * 33]); o.w = pk_bf16(sp[6 * 33], sp[7 * 33]);
        *(u32x4_t*)(WT + (size_t)(n0 + n) * D + k0 + 8 * c) = o; }
}
DEVFN void ph_pro_gpu(const Params& p, LAS unsigned char* lds, int tid, int bid, int G, size_t gtid, size_t gsize) {
    const int lane = tid & 63, wv = __builtin_amdgcn_readfirstlane(tid >> 6);
    {
        LAS float* scr = (LAS float*)(lds + 61440 + wv * 8448);
        constexpr int I5120 = 16 * 160, I1536 = 16 * 48, I3072 = 16 * 96, I1024 = 16 * 32, I2048 = 16 * 64;
        constexpr int NITEMS = I5120 + 2 * I1536 + I3072 + 4 * I1024 + 4 * I2048;
        for (int it = wv * G + bid; it < NITEMS; it += G * 8) {
            int r = it;
            if (r < I5120) { tr_tile(p.hgrn_w_in, 5120, WSP(bf16_t, WS_WIN0), r, scr, lane); continue; } r -= I5120;
            if (r < I1536) { tr_tile(p.swa_w_in, 1536, WSP(bf16_t, WS_WIN1), r, scr, lane); continue; } r -= I1536;
            if (r < I3072) { tr_tile(p.na_w_in, 3072, WSP(bf16_t, WS_WIN2), r, scr, lane); continue; } r -= I3072;
            if (r < I1536) { tr_tile(p.gqa_w_in, 1536, WSP(bf16_t, WS_WIN3), r, scr, lane); continue; } r -= I1536;
            if (r < 4 * I1024) { const int m = r / I1024; const float* W = m == 0 ? p.hgrn_w_out : m == 1 ? p.swa_w_out : m == 2 ? p.na_w_out : p.gqa_w_out;
                tr_tile(W, 1024, WSP(bf16_t, WS_WOUT) + (size_t)m * D * D, r % I1024, scr, lane); continue; } r -= 4 * I1024;
            { const int m = r / I2048; tr_tile(p.peer_wq + (size_t)m * D * 2048, 2048, WSP(bf16_t, WS_WQ) + (size_t)m * 2048 * D, r % I2048, scr, lane); }
        }
    }
    {
        LAS float* sil = (LAS float*)lds;
        for (int i = tid; i < NMR * D; i += 512) { const int r = i / D, k = i % D; const float v = r < NBAT ? p.c[(size_t)r * D + k] : p.c_ctx[k]; sil[i] = v / (1.f + __expf(-v)); }
        __syncthreads();
        LAS float* red = (LAS float*)(lds + 40960);
        float* modv = WSP(float, WS_MODV);
        for (int item = bid; item < DEPTH * 48; item += G) {
            const int l = item / 48, cb = item % 48, ch = wv & 1, kq = wv >> 1, col = cb * 128 + ch * 64 + lane;
            const float* w = p.mod_w + (size_t)l * D * 6144 + (size_t)(kq * 256) * 6144 + col;
            float acc[NMR];
#pragma unroll
            for (int r = 0; r < NMR; ++r) acc[r] = 0.f;
#pragma unroll 4
            for (int k = 0; k < 256; ++k) { const float wv_ = w[(size_t)k * 6144];
#pragma unroll
                for (int r = 0; r < NMR; ++r) acc[r] = fmaf(sil[r * D + kq * 256 + k], wv_, acc[r]); }
#pragma unroll
            for (int r = 0; r < NMR; ++r) red[(wv * NMR + r) * 64 + lane] = acc[r];
            __syncthreads();
            if (kq == 0) {
#pragma unroll
                for (int r = 0; r < NMR; ++r) { float s = 0.f;
#pragma unroll
                    for (int q = 0; q < 4; ++q) s += red[((q * 2 + ch) * NMR + r) * 64 + lane];
                    modv[(size_t)(l * NMR + r) * 6144 + col] = s + p.mod_b[l * 6144 + col]; }
            }
            __syncthreads();
        }
    }
    float* lbv = WSP(float, WS_LBV);
    for (size_t c = gtid; c < (size_t)D; c += gsize) {
        float m = -1e30f;
        for (int j = 0; j < DEPTH + 1; ++j) m = fmaxf(m, p.hgrn_lb[j * D + c]);
        float sum = 0.f;
        for (int j = 0; j < DEPTH + 1; ++j) sum += expf(p.hgrn_lb[j * D + c] - m);
        lbv[c] = expf(p.hgrn_lb[c] - m) / sum;
    }
    float* rope = WSP(float, WS_ROPE);
    for (size_t i = gtid; i < (size_t)64 * 16; i += gsize) { const int pos = (int)(i / 16), fi = (int)(i % 16); const float ang = (float)pos * expf(-(float)(2 * fi) / 32.f * LN_THETA); rope[ROPE64_COS + i] = cosf(ang); rope[ROPE64_SIN + i] = sinf(ang); }
    for (size_t i = gtid; i < (size_t)64 * 32; i += gsize) { const int pos = (int)(i / 32), fi = (int)(i % 32); const float ang = (float)pos * expf(-(float)(2 * fi) / 64.f * LN_THETA); rope[ROPE128_COS + i] = cosf(ang); rope[ROPE128_SIN + i] = sinf(ang); }
    ph_cvt_keys(p, gtid, gsize);
}
DEVFN u32x4_t mod8(const f32x4_t a, const f32x4_t b, const float* shift, const float* scale) {
    const f32x4_t s0 = ((const f32x4_t*)shift)[0], s1 = ((const f32x4_t*)shift)[1], c0 = ((const f32x4_t*)scale)[0], c1 = ((const f32x4_t*)scale)[1];
    return (u32x4_t){pk_bf16(a[0] * (1.f + c0[0]) + s0[0], a[1] * (1.f + c0[1]) + s0[1]), pk_bf16(a[2] * (1.f + c0[2]) + s0[2], a[3] * (1.f + c0[3]) + s0[3]),
                     pk_bf16(b[0] * (1.f + c1[0]) + s1[0], b[1] * (1.f + c1[1]) + s1[1]), pk_bf16(b[2] * (1.f + c1[2]) + s1[2], b[3] * (1.f + c1[3]) + s1[3])};
}
DEVFN void ph_h0_gpu(const Params& p, size_t gtid, size_t gsize) {
    const float* xs = WSP(float, WS_XS); const float* modv = WSP(float, WS_MODV); bf16_t* hb = WSP(bf16_t, WS_HB);
    for (size_t i = gtid; i < (size_t)NT * D / 4; i += gsize) {
        const int t = (int)(i / (D / 4)), c = (int)(i % (D / 4)) * 4;
        const float* m = modv + (size_t)modrow(t) * 6144;
        const float* xin = t < NX ? p.x + (size_t)t * D : p.ctx + (size_t)(t - NX) * D;
        const f32x4_t a = *(const f32x4_t*)(xin + c), sh = *(const f32x4_t*)(m + c), sc = *(const f32x4_t*)(m + D + c);
        const f32x4_t hv = a * (sc + 1.f) + sh;
        *(u32x2_t*)(hb + (size_t)t * D + c) = (u32x2_t){pk_bf16(hv[0], hv[1]), pk_bf16(hv[2], hv[3])};
    }
}
DEVFN void unpack8(const u32x4_t w, float (&v)[8]) {
#pragma unroll
    for (int i = 0; i < 4; ++i) { v[2 * i] = __uint_as_float(w[i] << 16); v[2 * i + 1] = __uint_as_float(w[i] & 0xffff0000u); }
}
DEVFN u32x4_t pack8(const float (&v)[8]) { return (u32x4_t){pk_bf16(v[0], v[1]), pk_bf16(v[2], v[3]), pk_bf16(v[4], v[5]), pk_bf16(v[6], v[7])}; }
DEVFN void ph_swa_rope_gpu(const Params& p, size_t gtid, size_t gsize) {
    bf16_t* Z = WSP(bf16_t, WS_Z); const float* rope = WSP(const float, WS_ROPE); constexpr int LDZ = 1536;
    for (size_t i = gtid; i < (size_t)NX * 20 * 4; i += gsize) {
        const int gq = (int)(i & 1), a = (int)((i >> 1) & 1), hh = (int)((i >> 2) % 20), t = (int)(i / 80);
        const int s = t % SEQ, pos = a == 0 ? s / GW : s % GW;
        bf16_t* zp = Z + (size_t)t * LDZ + hh * 64 + a * 32 + gq * 8;
        float x1[8], x2[8], o1[8], o2[8];
        unpack8(*(const u32x4_t*)zp, x1); unpack8(*(const u32x4_t*)(zp + 16), x2);
        const float* cs = rope + ROPE64_COS + pos * 16 + gq * 8; const float* sn = rope + ROPE64_SIN + pos * 16 + gq * 8;
#pragma unroll
        for (int e = 0; e < 8; ++e) { o1[e] = x1[e] * cs[e] - x2[e] * sn[e]; o2[e] = x2[e] * cs[e] + x1[e] * sn[e]; }
        *(u32x4_t*)zp = pack8(o1); *(u32x4_t*)(zp + 16) = pack8(o2);
    }
}
DEVFN void ph_gqa_prep_gpu(const Params& p, size_t gtid, size_t gsize) {
    bf16_t* Z = WSP(bf16_t, WS_Z); const float* rope = WSP(const float, WS_ROPE); constexpr int LDZ = 1536;
    const size_t nitem = (size_t)NT * 10 * 16;
    for (size_t i = gtid; i < nitem; i += gsize) {
        const int j = (int)(i & 15), hh = (int)((i >> 4) % 10), t = (int)(i / 160);
        bf16_t* zp = Z + (size_t)t * LDZ + hh * 128 + j * 8;
        const float* g = (hh < 8 ? p.gqa_q_norm : p.gqa_k_norm) + j * 8;
        float x[8]; unpack8(*(const u32x4_t*)zp, x);
        float ss = 0.f;
#pragma unroll
        for (int e = 0; e < 8; ++e) ss += x[e] * x[e];
        ss += dppf(ss, 0xB1); ss += dppf(ss, 0x4E); ss += dppf(ss, 0x141); ss += dppf(ss, 0x140);
        const float r = 1.f / sqrtf(ss * (1.f / 128.f) + RMS_EPS);
#pragma unroll
        for (int e = 0; e < 8; ++e) x[e] = x[e] * r * g[e];
        float o[8];
        float y[8];
#pragma unroll
        for (int e = 0; e < 8; ++e) y[e] = __int_as_float(dpp_xor4(__float_as_int(x[e])));
        if (t < NX) {
            const int s = t % SEQ, a = j >> 3, pos = a == 0 ? s / GW : s % GW, fq = (j & 3) * 8; const bool second = (j & 4) != 0;
            const float* cs = rope + ROPE128_COS + pos * 32 + fq; const float* sn = rope + ROPE128_SIN + pos * 32 + fq;
#pragma unroll
            for (int e = 0; e < 8; ++e) o[e] = second ? x[e] * cs[e] + y[e] * sn[e] : x[e] * cs[e] - y[e] * sn[e];
        } else {
#pragma unroll
            for (int e = 0; e < 8; ++e) o[e] = x[e];
        }
        *(u32x4_t*)zp = pack8(o);
    }
}
DEVFN void ph_hgrn_readout_gpu(const Params& p, int tid, int bid, int G) {
    const bf16_t* Z = WSP(const bf16_t, WS_Z); constexpr int LDZ = 5120;
    const bf16_t* of = WSP(const bf16_t, WS_Y); const bf16_t* ob = of + (size_t)NT * D; bf16_t* att = WSP(bf16_t, WS_ATT);
    const int lane = tid & 63, wv = __builtin_amdgcn_readfirstlane(tid >> 6);
    const float* ng = p.hgrn_norm_g + (lane & 15) * 8;
    for (int t = wv * G + bid; t < NT; t += G * 8) {
#pragma unroll
        for (int j = 0; j < 2; ++j) {
            const size_t off = (size_t)t * D + 512 * j + lane * 8;
            float a[8], b[8], gz[8];
            unpack8(*(const u32x4_t*)(of + off), a); unpack8(*(const u32x4_t*)(ob + off), b); unpack8(*(const u32x4_t*)(Z + (size_t)t * LDZ + 4096 + 512 * j + lane * 8), gz);
            float ss = 0.f;
#pragma unroll
            for (int e = 0; e < 8; ++e) { a[e] += b[e]; ss += a[e] * a[e]; }
            ss += dppf(ss, 0xB1); ss += dppf(ss, 0x4E); ss += dppf(ss, 0x141); ss += dppf(ss, 0x140);
            const float r = 1.f / sqrtf(ss * (1.f / 128.f) + RMS_EPS);
            float o[8];
#pragma unroll
            for (int e = 0; e < 8; ++e) o[e] = a[e] * r * ng[e] * gz[e] / (1.f + __expf(-gz[e]));
            *(u32x4_t*)(att + off) = pack8(o);
        }
    }
}
DEVFN void ph_ln1_gpu(const Params& p, int l, int M, int tid, int bid, int G, int dry = 0) {
    bf16_t* xs = WSP(bf16_t, WS_XS); const bf16_t* Yb = WSP(const bf16_t, WS_Y); const float* modv = WSP(const float, WS_MODV); bf16_t* hb = WSP(bf16_t, WS_HB);
    const int lane = tid & 63, wv = __builtin_amdgcn_readfirstlane(tid >> 6);
    bf16_t* xs_o = dry ? WSP(bf16_t, WS_Z) : xs; bf16_t* hb_o = dry ? WSP(bf16_t, WS_Z + (size_t)NT * 4096) : hb;
    unsigned char* hqh_o = dry ? WSP(unsigned char, WS_Z + (size_t)NT * 6144) : WSP(unsigned char, WS_HQH); unsigned char* hql_o = dry ? WSP(unsigned char, WS_Z + (size_t)NT * 7168) : WSP(unsigned char, WS_HQL);
    float* hqs_o = dry ? WSP(float, WS_Z + (size_t)NT * 8192) : WSP(float, WS_HQS);
    const f32x4_t* lg0 = (const f32x4_t*)(p.ln_g + (size_t)(l * 2) * D) + lane; const f32x4_t* lb0 = (const f32x4_t*)(p.ln_b + (size_t)(l * 2) * D) + lane;
    const int t0 = wv * G + bid, tstep = G * 8;
    f32x4_t nxf[4]; u32x2_t nxb[4], ny[4];
#define LN1_LOAD(tt) { const int tt_ = (tt); const u32x2_t* yp = (const u32x2_t*)(Yb + (size_t)tt_ * D) + lane; \
        if (l == 0) { const f32x4_t* xp = (const f32x4_t*)(tt_ < NX ? p.x + (size_t)tt_ * D : p.ctx + (size_t)(tt_ - NX) * D) + lane; _Pragma("unroll") for (int j = 0; j < 4; ++j) nxf[j] = xp[64 * j]; } \
        else { const u32x2_t* xp = (const u32x2_t*)(xs + (size_t)tt_ * D) + lane; _Pragma("unroll") for (int j = 0; j < 4; ++j) nxb[j] = xp[64 * j]; } \
        _Pragma("unroll") for (int j = 0; j < 4; ++j) ny[j] = yp[64 * j]; }
    LN1_LOAD(imin(t0, M - 1))
    for (int t = t0; t < M; t += tstep) {
        const f32x4_t* lg = lg0; const f32x4_t* lb = lb0; asm volatile("" : "+v"(lg), "+v"(lb));
        const f32x4_t* m = (const f32x4_t*)(modv + (size_t)(l * NMR + modrow(t)) * 6144) + lane;
        f32x4_t cx[4]; u32x2_t cy[4];
#pragma unroll
        for (int j = 0; j < 4; ++j) { cy[j] = ny[j];
            cx[j] = l == 0 ? nxf[j] : (f32x4_t){__uint_as_float(nxb[j][0] << 16), __uint_as_float(nxb[j][0] & 0xffff0000u), __uint_as_float(nxb[j][1] << 16), __uint_as_float(nxb[j][1] & 0xffff0000u)}; }
        LN1_LOAD(imin(t + tstep, M - 1))
        f32x4_t v[4]; float s = 0.f;
#pragma unroll
        for (int j = 0; j < 4; ++j) { const f32x4_t gv = m[2 * 256 + 64 * j];
            const f32x4_t yv = {__uint_as_float(cy[j][0] << 16), __uint_as_float(cy[j][0] & 0xffff0000u), __uint_as_float(cy[j][1] << 16), __uint_as_float(cy[j][1] & 0xffff0000u)};
            v[j] = cx[j] * ALPHA + gv * yv; s += (v[j][0] + v[j][1]) + (v[j][2] + v[j][3]); }
        const float mu = row_sum(s) * (1.f / D);
        float q = 0.f;
#pragma unroll
        for (int j = 0; j < 4; ++j) { v[j] = v[j] - mu; q += (v[j][0] * v[j][0] + v[j][1] * v[j][1]) + (v[j][2] * v[j][2] + v[j][3] * v[j][3]); }
        const float rstd = 1.f / sqrtf(row_sum(q) * (1.f / D) + LN_EPS);
        f32x4_t tk[4]; float am[4];
#pragma unroll
        for (int j = 0; j < 4; ++j) { v[j] = v[j] * rstd * lg[64 * j] + lb[64 * j];
            tk[j] = v[j] * (m[4 * 256 + 64 * j] + 1.f) + m[3 * 256 + 64 * j];
            am[j] = fmaxf(fmaxf(fabsf(tk[j][0]), fabsf(tk[j][1])), fmaxf(fabsf(tk[j][2]), fabsf(tk[j][3]))); }
        u32x2_t* xo = (u32x2_t*)(xs_o + (size_t)t * D) + lane; u32x2_t* ho = (u32x2_t*)(hb_o + (size_t)t * D) + lane;
#pragma unroll
        for (int j = 0; j < 4; ++j) { xo[64 * j] = (u32x2_t){pk_bf16(v[j][0], v[j][1]), pk_bf16(v[j][2], v[j][3])}; ho[64 * j] = (u32x2_t){pk_bf16(tk[j][0], tk[j][1]), pk_bf16(tk[j][2], tk[j][3])}; }
#pragma unroll
        for (int j = 0; j < 4; ++j) am[j] = wave_maxf(am[j]);
        unsigned short* qho = (unsigned short*)(hqh_o + (size_t)t * 512) + lane; unsigned short* qlo = (unsigned short*)(hql_o + (size_t)t * 512) + lane;
#pragma unroll
        for (int j = 0; j < 4; ++j) { const float qs = am[j] > 0.f ? 119.f / am[j] : 0.f; unsigned wh = 0u, wl = 0u;
#pragma unroll
            for (int kk = 0; kk < 4; ++kk) { const int qi = (int)rintf(tk[j][kk] * qs); wh |= ((unsigned)((qi + 8) >> 4) & 15u) << (4 * kk); wl |= ((unsigned)qi & 15u) << (4 * kk); }
            qho[64 * j] = (unsigned short)wh; qlo[64 * j] = (unsigned short)wl;
            if (lane == 0) hqs_o[(size_t)t * 4 + j] = am[j] * (1.f / 119.f); }
    }
}
#endif
#ifndef CPU_TEST
typedef int i32x4_t __attribute__((ext_vector_type(4)));
DEVFN void pk_dot16(f32x2_t& acc, const u32x4_t r, const f32x2_t (&h2)[8]) {
#pragma unroll
    for (int i = 0; i < 4; ++i) { const f32x2_t lo = __builtin_amdgcn_cvt_pk_f32_fp8((int)r[i], false), hi = __builtin_amdgcn_cvt_pk_f32_fp8((int)r[i], true);
        acc = __builtin_elementwise_fma(lo, h2[2 * i], acc); acc = __builtin_elementwise_fma(hi, h2[2 * i + 1], acc); }
}
DEVFN void pk_fma16(f32x2_t (&y2)[8], const u32x4_t r, const float w) {
    const f32x2_t w2 = {w, w};
#pragma unroll
    for (int i = 0; i < 4; ++i) { const f32x2_t lo = __builtin_amdgcn_cvt_pk_f32_fp8((int)r[i], false), hi = __builtin_amdgcn_cvt_pk_f32_fp8((int)r[i], true);
        y2[2 * i] = __builtin_elementwise_fma(lo, w2, y2[2 * i]); y2[2 * i + 1] = __builtin_elementwise_fma(hi, w2, y2[2 * i + 1]); }
}
struct PvItem { u32x4_t r[16]; f32x4_t w[4]; };
DEVFN void pv_idx(int (&e)[16], const int* idx, int t, int g) {
    const i32x4_t* ip = (const i32x4_t*)(idx + (size_t)t * 128 + g * 16);
#pragma unroll
    for (int i = 0; i < 4; ++i) { const i32x4_t v = ip[i]; e[4 * i] = v[0]; e[4 * i + 1] = v[1]; e[4 * i + 2] = v[2]; e[4 * i + 3] = v[3]; }
}
struct PuvItem { u32x4_t r[16]; u32x4_t h0, h1; float hs; };
DEVFN void puv_rows(PuvItem& it, const int (&e)[16], const unsigned char* UP, const unsigned lo16, const unsigned char* qh, const unsigned char* ql, const float* hs) {
#pragma unroll
    for (int j = 0; j < 16; ++j) it.r[j] = *(const u32x4_t*)(UP + (((unsigned)e[j] << 7) | lo16));
    it.h0 = *(const u32x4_t*)qh; it.h1 = *(const u32x4_t*)ql; it.hs = *hs;
}
DEVFN void puv_compute(const PuvItem& it, bf16_t* pout, int k) {
    int qh = 0, ql = 0;
#pragma unroll
    for (int i = 0; i < 4; ++i) { qh = __builtin_amdgcn_sdot8((int)it.h0[i], 0x11111111, qh, false); ql = __builtin_amdgcn_sdot8((int)it.h1[i], 0x11111111, ql, false); }
    const int qsum = qh * 16 + ql;
    int d[16];
#pragma unroll
    for (int j = 0; j < 16; ++j) { int ah = 0, al = 0;
#pragma unroll
        for (int i = 0; i < 4; ++i) { ah = __builtin_amdgcn_sdot8((int)it.r[j][i], (int)it.h0[i], ah, false); al = __builtin_amdgcn_sdot8((int)it.r[j][i], (int)it.h1[i], al, false); }
        d[j] = ah * 32 + al * 2 + qsum; }
    int d8[8];
#pragma unroll
    for (int i = 0; i < 8; ++i) { const bool up = (k & 4) != 0; const int keep = up ? d[8 + i] : d[i], send = up ? d[i] : d[8 + i]; d8[i] = keep + dpp_xor4(send); }
    int d4[4];
#pragma unroll
    for (int i = 0; i < 4; ++i) { const bool up = (k & 2) != 0; const int keep = up ? d8[4 + i] : d8[i], send = up ? d8[i] : d8[4 + i]; d4[i] = keep + dpp_xor2(send); }
    int d2[2];
#pragma unroll
    for (int i = 0; i < 2; ++i) { const bool up = (k & 1) != 0; const int keep = up ? d4[2 + i] : d4[i], send = up ? d4[i] : d4[2 + i]; d2[i] = keep + dpp_xor1(send); }
    *(unsigned*)(pout + ((k >> 2) & 1) * 8 + ((k >> 1) & 1) * 4 + (k & 1) * 2) = pk_bf16((float)d2[0] * it.hs, (float)d2[1] * it.hs);
}
DEVFN void ph_peer_u(const Params& p, int l, int M, int tid, int bid, int G) {
    const int lane = tid & 63, wv = __builtin_amdgcn_readfirstlane(tid >> 6), g = lane >> 3, k = lane & 7, x = bid & 3;
    const unsigned char* UP = WSP(const unsigned char, WS_UV8) + (size_t)(l * 2) * PEER_N * 1024 + (size_t)x * PEER_N * 128; const unsigned lo16 = (unsigned)k * 16u;
    const int* idx = WSP(const int, WS_IDX);
    const unsigned char* qh = WSP(const unsigned char, WS_HQH) + x * 128 + k * 16; const unsigned char* ql = WSP(const unsigned char, WS_HQL) + x * 128 + k * 16; const float* hs = WSP(const float, WS_HQS) + x;
    bf16_t* part = WSP(bf16_t, WS_PART) + (size_t)x * NT * 128 + g * 16;
    const int nw = (G >> 2) * 8, t0 = (bid >> 2) * 8 + wv, last = M - 1;
    int eA[16], eB[16]; PuvItem A, B;
    pv_idx(eA, idx, imin(t0, last), g); pv_idx(eB, idx, imin(t0 + nw, last), g);
    { const size_t tt = imin(t0, last); puv_rows(A, eA, UP, lo16, qh + tt * 512, ql + tt * 512, hs + tt * 4); }
    for (int t = t0; t < M; t += 2 * nw) {
        { const size_t tt = imin(t + nw, last); puv_rows(B, eB, UP, lo16, qh + tt * 512, ql + tt * 512, hs + tt * 4); }
        pv_idx(eA, idx, imin(t + 2 * nw, last), g);
        puv_compute(A, part + (size_t)t * 128, k);
        { const size_t tt = imin(t + 2 * nw, last); puv_rows(A, eA, UP, lo16, qh + tt * 512, ql + tt * 512, hs + tt * 4); }
        pv_idx(eB, idx, imin(t + 3 * nw, last), g);
        if (t + nw < M) puv_compute(B, part + (size_t)(t + nw) * 128, k);
    }
}
DEVFN void ph_peer_comb(const Params& p, int l, int M, size_t gtid, size_t gsize) {
    const int* idx = WSP(const int, WS_IDX); const float* gate = WSP(const float, WS_GATE); const bf16_t* part = WSP(const bf16_t, WS_PART);
    unsigned char* whi = WSP(unsigned char, WS_WA); float* wsc = (float*)(whi + (size_t)NT * 256);
    const f32x2_t* SUV = WSP(const f32x2_t, WS_UVS) + (size_t)l * PEER_N;
    for (size_t i4 = gtid; i4 < (size_t)M * 32; i4 += gsize) {
        const size_t i = i4 * 4;
        f32x4_t s = {0.f, 0.f, 0.f, 0.f};
#pragma unroll
        for (int x = 0; x < 4; ++x) { const u32x2_t w = *(const u32x2_t*)(part + (size_t)x * NT * 128 + i);
            s += (f32x4_t){__uint_as_float(w[0] << 16), __uint_as_float(w[0] & 0xffff0000u), __uint_as_float(w[1] << 16), __uint_as_float(w[1] & 0xffff0000u)}; }
        const i32x4_t e = *(const i32x4_t*)(idx + i); const f32x4_t g = *(const f32x4_t*)(gate + i);
        f32x4_t o;
#pragma unroll
        for (int k = 0; k < 4; ++k) { const f32x2_t sc = SUV[e[k]]; const float dot = s[k] * sc[0]; const float u3 = 1.5957691216057308f * (dot + 0.044715f * dot * dot * dot); o[k] = g[k] * sc[1] * dot / (1.f + __expf(-u3)); }
        float am = fmaxf(fmaxf(fabsf(o[0]), fabsf(o[1])), fmaxf(fabsf(o[2]), fabsf(o[3])));
        am = fmaxf(am, dppf(am, 0xB1)); am = fmaxf(am, dppf(am, 0x4E)); am = fmaxf(am, dppf(am, 0x141)); am = fmaxf(am, dppf(am, 0x140));
        { auto rr = __builtin_amdgcn_permlane16_swap(__float_as_uint(am), __float_as_uint(am), false, false); am = fmaxf(__uint_as_float(rr[0]), __uint_as_float(rr[1])); }
        const float ws = am > 0.f ? 6.f / am : 0.f;
        const size_t t = i >> 7; const int pos = (int)(i & 127), gq = pos >> 4, j0 = pos & 15, ge = gq & 1;
        float rr[4];
#pragma unroll
        for (int k = 0; k < 4; ++k) rr[k] = o[k] * ws;
#pragma unroll
        for (int d = 0; d < 3; ++d) {
            unsigned mine = 0u;
#pragma unroll
            for (int k = 0; k < 4; ++k) {
                const unsigned wd = __builtin_amdgcn_cvt_scalef32_pk_fp4_f32(0u, rr[k], 0.f, 1.0f, 0) & 0xffu;
                const f32x2_t dec = __builtin_amdgcn_cvt_scalef32_pk_f32_fp4(wd, 1.0f, 0);
                mine |= ((wd | (wd >> 4)) & 15u) << (4 * k);
                rr[k] = (rr[k] - (dec[0] + dec[1])) * 4.f; }
            const unsigned oth = (unsigned)dpp_xor4((int)mine);
            const unsigned lo4 = ge ? oth : mine, hi4 = ge ? mine : oth;
            unsigned W = 0u;
#pragma unroll
            for (int k = 0; k < 4; ++k) W |= (((lo4 >> (4 * k)) & 15u) | (((hi4 >> (4 * k)) & 15u) << 4)) << (8 * k);
            const int cc = gq >> 1;
            const unsigned o1 = (unsigned)dpp_xor8((int)W);
            W = __builtin_amdgcn_perm(o1, W, (cc & 1) ? 0x03070105u : 0x06020400u);
            unsigned o2; { auto rr = __builtin_amdgcn_permlane16_swap(W, W, false, false); o2 = (cc & 2) ? rr[0] : rr[1]; }
            W = __builtin_amdgcn_perm(o2, W, (cc & 2) ? 0x03020706u : 0x05040100u);
            if (ge == 0) *(unsigned*)(whi + ((size_t)d * NT + t) * 64 + 4 * (j0 + cc)) = W;
        }
        if ((i4 & 31) == 0) wsc[t] = am * (1.f / 6.f);
    }
}
typedef int i32x2_t __attribute__((ext_vector_type(2)));
typedef int i32x8_t __attribute__((ext_vector_type(8)));
struct PvRows { u32x4_t r[16]; i32x4_t w4; float ws; };
DEVFN void pv_rows(PvRows& it, const int (&e)[16], const unsigned char* VP, const unsigned lo16, const unsigned char* wbt, const float* wsp, const bool hasw) {
#pragma unroll
    for (int j = 0; j < 16; ++j) it.r[j] = *(const u32x4_t*)(VP + (((unsigned)e[j] << 7) | lo16));
    it.w4 = (i32x4_t){0, 0, 0, 0};
    if (hasw) it.w4 = *(const i32x4_t*)wbt;
    it.ws = *wsp;
}
DEVFN void pv_compute(const PvRows& it, LAS unsigned char* wrE, LAS unsigned char* wrO, LAS unsigned char* rowbase, const int fsh, bf16_t* yo, const bool st) {
    asm volatile("" ::: "memory");
#pragma unroll
    for (int j = 0; j < 16; ++j) *(LAS u32x4_t*)(((j & 1) ? wrO : wrE) + j * 1024) = it.r[j];
    asm volatile("" ::: "memory");
    const i32x8_t wf = {it.w4[0], it.w4[1], it.w4[2], it.w4[3], 0, 0, 0, 0};
    const float c0 = it.ws, c1 = it.ws * 0.25f, c2 = it.ws * 0.0625f;
    unsigned res[16];
#pragma unroll
    for (int c = 0; c < 16; ++c) {
        const int off = (((c >> 1) << 4) ^ fsh) + 8 * (c & 1);
        const i32x2_t a0 = __builtin_amdgcn_ds_read_tr4_b64_v2i32((LAS i32x2_t*)(rowbase + off)), a1 = __builtin_amdgcn_ds_read_tr4_b64_v2i32((LAS i32x2_t*)(rowbase + 2048 + off));
        const i32x8_t tf = {a0[0], a0[1], a1[0], a1[1], 0, 0, 0, 0};
        f32x4_t acc = {0.f, 0.f, 0.f, 0.f};
        acc = __builtin_amdgcn_mfma_scale_f32_16x16x128_f8f6f4(wf, tf, acc, 4, 4, 0, 0, 0, 0);
        const float y = acc[0] * c0 + acc[1] * c1 + acc[2] * c2;
        const float yn = __int_as_float(__builtin_amdgcn_mov_dpp(__float_as_int(y), 0xB1, 0xf, 0xf, true));
        res[c] = pk_bf16(y, yn);
    }
    if (st) {
#pragma unroll
        for (int c = 0; c < 16; ++c) *(unsigned*)(yo + c * 16) = res[c]; }
    asm volatile("" ::: "memory");
}
DEVFN void ph_peer_v(const Params& p, LAS unsigned char* lds, int l, int M, int tid, int bid, int G) {
    const int lane = tid & 63, wv = __builtin_amdgcn_readfirstlane(tid >> 6), g = lane >> 3, sl = lane & 7, x = bid & 3, n = lane & 15, q = lane >> 4;
    LAS unsigned char* img = lds + wv * 16384;
    const unsigned char* VPl = WSP(const unsigned char, WS_UV8) + (size_t)(l * 2 + 1) * PEER_N * 1024 + (size_t)x * PEER_N * 128; const unsigned lo16 = (unsigned)sl * 16u;
    const int* idx = WSP(const int, WS_IDX);
    const unsigned char* wb = WSP(const unsigned char, WS_WA) + (size_t)(n & 3) * NT * 64 + 16 * q; const float* wsc = (const float*)(WSP(const unsigned char, WS_WA) + (size_t)NT * 256);
    const bool hasw = n < 3, st = q == 0 && (n & 1) == 0;
    bf16_t* Y = WSP(bf16_t, WS_Y) + x * 256 + n;
    LAS unsigned char* wrE = img + g * 128 + ((sl ^ (g >> 1)) << 4); LAS unsigned char* wrO = img + g * 128 + (((sl ^ (g >> 1)) << 4) ^ 64);
    const int R0 = 32 * q + n, fsh = ((R0 >> 1) & 7) << 4;
    LAS unsigned char* rowbase = img + R0 * 128;
    const int nw = (G >> 2) * 8, t0 = (bid >> 2) * 8 + wv, last = M - 1;
    int eA[16], eB[16]; PvRows A, B;
    pv_idx(eA, idx, imin(t0, last), g); pv_idx(eB, idx, imin(t0 + nw, last), g);
    { const size_t tt = imin(t0, last); pv_rows(A, eA, VPl, lo16, wb + tt * 64, wsc + tt, hasw); }
    for (int t = t0; t < M; t += 2 * nw) {
        { const size_t tt = imin(t + nw, last); pv_rows(B, eB, VPl, lo16, wb + tt * 64, wsc + tt, hasw); }
        pv_idx(eA, idx, imin(t + 2 * nw, last), g);
        pv_compute(A, wrE, wrO, rowbase, fsh, Y + (size_t)t * D, st);
        { const size_t tt = imin(t + 2 * nw, last); pv_rows(A, eA, VPl, lo16, wb + tt * 64, wsc + tt, hasw); }
        pv_idx(eB, idx, imin(t + 3 * nw, last), g);
        if (t + nw < M) pv_compute(B, wrE, wrO, rowbase, fsh, Y + (size_t)(t + nw) * D, st);
    }
}
DEVFN void ph_ln2_gpu(const Params& p, int l, int M, int tid, int bid, int G, int dry = 0) {
    bf16_t* xs = WSP(bf16_t, WS_XS); const bf16_t* Yb = WSP(const bf16_t, WS_Y); const float* modv = WSP(const float, WS_MODV); bf16_t* hb = WSP(bf16_t, WS_HB);
    const int lane = tid & 63, wv = __builtin_amdgcn_readfirstlane(tid >> 6);
    bf16_t* xs_o = dry ? WSP(bf16_t, WS_Z + (size_t)NT * 2048) : xs; bf16_t* hb_o = dry ? WSP(bf16_t, WS_Z + (size_t)NT * 4096) : hb; float* out_o = dry ? WSP(float, WS_Z) : p.out;
    const f32x4_t* lg0 = (const f32x4_t*)(p.ln_g + (size_t)(l * 2 + 1) * D) + lane; const f32x4_t* lb0 = (const f32x4_t*)(p.ln_b + (size_t)(l * 2 + 1) * D) + lane;
    const int t0 = wv * G + bid, tstep = G * 8;
    u32x2_t nx[4], ny[4];
    { const int tt = imin(t0, M - 1); const u32x2_t* xp = (const u32x2_t*)(xs + (size_t)tt * D) + lane; const u32x2_t* yp = (const u32x2_t*)(Yb + (size_t)tt * D) + lane;
#pragma unroll
      for (int j = 0; j < 4; ++j) { nx[j] = xp[64 * j]; ny[j] = yp[64 * j]; } }
    for (int t = t0; t < M; t += tstep) {
        const f32x4_t* lg = lg0; const f32x4_t* lb = lb0; asm volatile("" : "+v"(lg), "+v"(lb));
        const int mr = modrow(t);
        const f32x4_t* m = (const f32x4_t*)(modv + (size_t)(l * NMR + mr) * 6144) + lane;
        f32x4_t cx[4]; u32x2_t cy[4];
#pragma unroll
        for (int j = 0; j < 4; ++j) { cy[j] = ny[j]; cx[j] = (f32x4_t){__uint_as_float(nx[j][0] << 16), __uint_as_float(nx[j][0] & 0xffff0000u), __uint_as_float(nx[j][1] << 16), __uint_as_float(nx[j][1] & 0xffff0000u)}; }
        { const int tt = imin(t + tstep, M - 1); const u32x2_t* xp = (const u32x2_t*)(xs + (size_t)tt * D) + lane; const u32x2_t* yp = (const u32x2_t*)(Yb + (size_t)tt * D) + lane;
#pragma unroll
          for (int j = 0; j < 4; ++j) { nx[j] = xp[64 * j]; ny[j] = yp[64 * j]; } }
        f32x4_t v[4]; float s = 0.f;
#pragma unroll
        for (int j = 0; j < 4; ++j) { const f32x4_t gv = m[5 * 256 + 64 * j];
            const f32x4_t yv = {__uint_as_float(cy[j][0] << 16), __uint_as_float(cy[j][0] & 0xffff0000u), __uint_as_float(cy[j][1] << 16), __uint_as_float(cy[j][1] & 0xffff0000u)};
            v[j] = cx[j] * ALPHA + gv * yv; s += (v[j][0] + v[j][1]) + (v[j][2] + v[j][3]); }
        const float mu = row_sum(s) * (1.f / D);
        float q = 0.f;
#pragma unroll
        for (int j = 0; j < 4; ++j) { v[j] = v[j] - mu; q += (v[j][0] * v[j][0] + v[j][1] * v[j][1]) + (v[j][2] * v[j][2] + v[j][3] * v[j][3]); }
        const float rstd = 1.f / sqrtf(row_sum(q) * (1.f / D) + LN_EPS);
#pragma unroll
        for (int j = 0; j < 4; ++j) v[j] = v[j] * rstd * lg[64 * j] + lb[64 * j];
        if (l + 1 < DEPTH) {
            const f32x4_t* m2 = (const f32x4_t*)(modv + (size_t)((l + 1) * NMR + mr) * 6144) + lane;
            u32x2_t* xo = (u32x2_t*)(xs_o + (size_t)t * D) + lane; u32x2_t* ho = (u32x2_t*)(hb_o + (size_t)t * D) + lane;
#pragma unroll
            for (int j = 0; j < 4; ++j) { xo[64 * j] = (u32x2_t){pk_bf16(v[j][0], v[j][1]), pk_bf16(v[j][2], v[j][3])}; const f32x4_t hv = v[j] * (m2[256 + 64 * j] + 1.f) + m2[64 * j]; ho[64 * j] = (u32x2_t){pk_bf16(hv[0], hv[1]), pk_bf16(hv[2], hv[3])}; }
        } else if (t < NX) {
            f32x4_t* op = (f32x4_t*)(out_o + (size_t)t * D) + lane;
#pragma unroll
            for (int j = 0; j < 4; ++j) op[64 * j] = v[j];
        }
    }
}
#endif

#ifndef CPU_TEST
struct PuItem { u32x4_t a[8][2]; u32x4_t hw[4]; };
DEVFN void pu_idx(int (&e)[8], const int* idx, int t, int r16) {
    const i32x4_t* ip = (const i32x4_t*)(idx + (size_t)t * 128 + r16 * 8); const i32x4_t v0 = ip[0], v1 = ip[1];
    e[0] = v0[0]; e[1] = v0[1]; e[2] = v0[2]; e[3] = v0[3]; e[4] = v1[0]; e[5] = v1[1]; e[6] = v1[2]; e[7] = v1[3];
}
DEVFN void pu_rows(PuItem& it, const int (&e)[8], const unsigned char* UP, const bf16_t* hrow) {
#pragma unroll
    for (int ti = 0; ti < 8; ++ti) { const u32x4_t* rp = (const u32x4_t*)(UP + (size_t)e[ti] * 128); it.a[ti][0] = rp[0]; it.a[ti][1] = rp[1]; }
#pragma unroll
    for (int q = 0; q < 4; ++q) it.hw[q] = ((const u32x4_t*)hrow)[q];
}
DEVFN void pu_compute(const PuItem& it, float* pout, int r16, int kg) {
    unsigned bh[8], bl[8];
#pragma unroll
    for (int q = 0; q < 4; ++q) { const u32x4_t hw = it.hw[q];
#pragma unroll
        for (int i = 0; i < 2; ++i) {
            const float f0 = __uint_as_float(hw[2 * i] << 16), f1 = __uint_as_float(hw[2 * i] & 0xffff0000u), f2 = __uint_as_float(hw[2 * i + 1] << 16), f3 = __uint_as_float(hw[2 * i + 1] & 0xffff0000u);
            int wh = __builtin_amdgcn_cvt_pk_fp8_f32(f0, f1, 0, false); wh = __builtin_amdgcn_cvt_pk_fp8_f32(f2, f3, wh, true);
            const f32x2_t d01 = __builtin_amdgcn_cvt_pk_f32_fp8(wh, false), d23 = __builtin_amdgcn_cvt_pk_f32_fp8(wh, true);
            int wl = __builtin_amdgcn_cvt_pk_fp8_f32((f0 - d01[0]) * 16.f, (f1 - d01[1]) * 16.f, 0, false); wl = __builtin_amdgcn_cvt_pk_fp8_f32((f2 - d23[0]) * 16.f, (f3 - d23[1]) * 16.f, wl, true);
            bh[2 * q + i] = (unsigned)wh; bl[2 * q + i] = (unsigned)wl; } }
    f32x4_t dh[8], dl[8];
#pragma unroll
    for (int ti = 0; ti < 8; ++ti) {
        dh[ti] = (f32x4_t){0.f, 0.f, 0.f, 0.f}; dl[ti] = dh[ti];
#pragma unroll
        for (int s_ = 0; s_ < 4; ++s_) {
            const long av = (long)(((unsigned long long)it.a[ti][s_ >> 1][2 * (s_ & 1) + 1] << 32) | it.a[ti][s_ >> 1][2 * (s_ & 1)]);
            const long bhv = (long)(((unsigned long long)bh[2 * s_ + 1] << 32) | bh[2 * s_]), blv = (long)(((unsigned long long)bl[2 * s_ + 1] << 32) | bl[2 * s_]);
            dh[ti] = __builtin_amdgcn_mfma_f32_16x16x32_fp8_fp8(av, bhv, dh[ti], 0, 0, 0);
            dl[ti] = __builtin_amdgcn_mfma_f32_16x16x32_fp8_fp8(av, blv, dl[ti], 0, 0, 0);
        }
    }
    f32x4_t o = dh[0] + dl[0] * 0.0625f;
#pragma unroll
    for (int c = 1; c < 8; ++c) { const f32x4_t v = dh[c] + dl[c] * 0.0625f; o = (r16 == c) ? v : o; }
    if (r16 < 8) *(f32x4_t*)(pout + r16 * 16 + 4 * kg) = o;
}
DEVFN void ph_peer_u_mfma(const Params& p, int l, int M, int tid, int bid, int G) {
    const int lane = tid & 63, wv = __builtin_amdgcn_readfirstlane(tid >> 6), r16 = lane & 15, kg = lane >> 4, x = bid & 7;
    const unsigned char* UP = WSP(const unsigned char, WS_UV8) + (size_t)(l * 2) * PEER_N * 1024 + (size_t)x * PEER_N * 128 + kg * 32;
    const int* idx = WSP(const int, WS_IDX); const bf16_t* hb = WSP(const bf16_t, WS_HB) + x * 128 + kg * 32;
    float* part = WSP(float, WS_PART) + (size_t)x * NT * 128;
    const int nw = (G >> 3) * 8, t0 = (bid >> 3) * 8 + wv, last = M - 1;
    int eA[8], eB[8]; PuItem A, B;
    pu_idx(eA, idx, imin(t0, last), r16); pu_idx(eB, idx, imin(t0 + nw, last), r16);
    pu_rows(A, eA, UP, hb + (size_t)imin(t0, last) * D);
    for (int t = t0; t < M; t += 2 * nw) {
        pu_rows(B, eB, UP, hb + (size_t)imin(t + nw, last) * D);
        pu_idx(eA, idx, imin(t + 2 * nw, last), r16);
        pu_compute(A, part + (size_t)t * 128, r16, kg);
        pu_rows(A, eA, UP, hb + (size_t)imin(t + 2 * nw, last) * D);
        pu_idx(eB, idx, imin(t + 3 * nw, last), r16);
        if (t + nw < M) pu_compute(B, part + (size_t)(t + nw) * 128, r16, kg);
    }
}
#endif
#ifndef CPU_TEST
constexpr int AC_BUF = 18432, AC_V = 9216, AC_SCR = 2 * AC_BUF, AC_BYTES = AC_SCR + 8 * 4608;
template <bool MASKED, class F>
DEVFN void attc_sub(AttW& a, const bf16x8_t (&qf)[4], const LAS unsigned char* kb, const LAS unsigned char* vb, int sub, int lane, float c2, F bias2) {
    const int q31 = lane & 31, hi = lane >> 5;
    f32x16_t s = {};
#pragma unroll
    for (int ks = 0; ks < 4; ++ks) { const bf16x8_t kf = *(const LAS bf16x8_t*)(kb + (32 * sub + q31) * 144 + ks * 32 + hi * 16); s = __builtin_amdgcn_mfma_f32_32x32x16_bf16(kf, qf[ks], s, 0, 0, 0); }
    float mx = -1e30f;
#pragma unroll
    for (int r = 0; r < 16; ++r) { s[r] = MASKED ? s[r] * c2 + bias2(r) : s[r] * c2; mx = fmaxf(mx, s[r]); }
    { auto rr_ = __builtin_amdgcn_permlane32_swap(__float_as_uint(mx), __float_as_uint(mx), false, false); mx = fmaxf(__uint_as_float(rr_[0]), __uint_as_float(rr_[1])); }
    const float mnew = fmaxf(a.m, mx);
    if (!__all(mnew == a.m)) {
        const float alpha = __builtin_amdgcn_exp2f(a.m - mnew); a.m = mnew; a.l *= alpha;
#pragma unroll
        for (int r = 0; r < 16; ++r) { a.o0[r] *= alpha; a.o1[r] *= alpha; }
    }
    float ps = 0.f;
#pragma unroll
    for (int r = 0; r < 16; ++r) { s[r] = __builtin_amdgcn_exp2f(s[r] - mnew); ps += s[r]; }
    a.l += ps;
    const u32x4_t pw0 = (u32x4_t){pk_bf16(s[0], s[1]), pk_bf16(s[2], s[3]), pk_bf16(s[4], s[5]), pk_bf16(s[6], s[7])};
    const u32x4_t pw1 = (u32x4_t){pk_bf16(s[8], s[9]), pk_bf16(s[10], s[11]), pk_bf16(s[12], s[13]), pk_bf16(s[14], s[15])};
    const bf16x8_t pb0 = __builtin_bit_cast(bf16x8_t, pw0), pb1 = __builtin_bit_cast(bf16x8_t, pw1);
#pragma unroll
    for (int db = 0; db < 2; ++db) {
        const int swz = (4 * db + (q31 >> 3)) & 7, g0 = 8 * sub + hi;
        const LAS unsigned char* vr = vb + (32 * db + q31) * 144;
        const s16x4v a0 = *(const LAS s16x4v*)(vr + ((g0 ^ swz) << 3)), a1 = *(const LAS s16x4v*)(vr + (((g0 + 2) ^ swz) << 3)), b0 = *(const LAS s16x4v*)(vr + (((g0 + 4) ^ swz) << 3)), b1 = *(const LAS s16x4v*)(vr + (((g0 + 6) ^ swz) << 3));
        const bf16x8_t vf0 = (bf16x8_t){a0[0], a0[1], a0[2], a0[3], a1[0], a1[1], a1[2], a1[3]}, vf1 = (bf16x8_t){b0[0], b0[1], b0[2], b0[3], b1[0], b1[1], b1[2], b1[3]};
        if (db == 0) { a.o0 = __builtin_amdgcn_mfma_f32_32x32x16_bf16(vf0, pb0, a.o0, 0, 0, 0); a.o0 = __builtin_amdgcn_mfma_f32_32x32x16_bf16(vf1, pb1, a.o0, 0, 0, 0); }
        else { a.o1 = __builtin_amdgcn_mfma_f32_32x32x16_bf16(vf0, pb0, a.o1, 0, 0, 0); a.o1 = __builtin_amdgcn_mfma_f32_32x32x16_bf16(vf1, pb1, a.o1, 0, 0, 0); }
    }
}
template <bool MASKED, class F>
DEVFN void attc_win(AttW& a, const bf16x8_t (&qf)[4], const LAS unsigned char* kb, const LAS unsigned char* vb, int k0, int lane, float c2, F bias2) {
    const int q31 = lane & 31, hi = lane >> 5;
    f32x16_t s = {};
#pragma unroll
    for (int ks = 0; ks < 4; ++ks) { const bf16x8_t kf = *(const LAS bf16x8_t*)(kb + (k0 + q31) * 144 + ks * 32 + hi * 16); s = __builtin_amdgcn_mfma_f32_32x32x16_bf16(kf, qf[ks], s, 0, 0, 0); }
    float mx = -1e30f;
#pragma unroll
    for (int r = 0; r < 16; ++r) { s[r] = MASKED ? s[r] * c2 + bias2(r) : s[r] * c2; mx = fmaxf(mx, s[r]); }
    { auto rr_ = __builtin_amdgcn_permlane32_swap(__float_as_uint(mx), __float_as_uint(mx), false, false); mx = fmaxf(__uint_as_float(rr_[0]), __uint_as_float(rr_[1])); }
    const float mnew = fmaxf(a.m, mx);
    if (!__all(mnew == a.m)) {
        const float alpha = __builtin_amdgcn_exp2f(a.m - mnew); a.m = mnew; a.l *= alpha;
#pragma unroll
        for (int r = 0; r < 16; ++r) { a.o0[r] *= alpha; a.o1[r] *= alpha; }
    }
    float ps = 0.f;
#pragma unroll
    for (int r = 0; r < 16; ++r) { s[r] = __builtin_amdgcn_exp2f(s[r] - mnew); ps += s[r]; }
    a.l += ps;
    const u32x4_t pw0 = (u32x4_t){pk_bf16(s[0], s[1]), pk_bf16(s[2], s[3]), pk_bf16(s[4], s[5]), pk_bf16(s[6], s[7])};
    const u32x4_t pw1 = (u32x4_t){pk_bf16(s[8], s[9]), pk_bf16(s[10], s[11]), pk_bf16(s[12], s[13]), pk_bf16(s[14], s[15])};
    const bf16x8_t pb0 = __builtin_bit_cast(bf16x8_t, pw0), pb1 = __builtin_bit_cast(bf16x8_t, pw1);
#pragma unroll
    for (int db = 0; db < 2; ++db) {
        const int swz = (4 * db + (q31 >> 3)) & 7, g0 = (k0 >> 2) + hi;
        const LAS unsigned char* vr = vb + (32 * db + q31) * 144;
        const s16x4v a0 = *(const LAS s16x4v*)(vr + ((g0 ^ swz) << 3)), a1 = *(const LAS s16x4v*)(vr + (((g0 + 2) ^ swz) << 3)), b0 = *(const LAS s16x4v*)(vr + (((g0 + 4) ^ swz) << 3)), b1 = *(const LAS s16x4v*)(vr + (((g0 + 6) ^ swz) << 3));
        const bf16x8_t vf0 = (bf16x8_t){a0[0], a0[1], a0[2], a0[3], a1[0], a1[1], a1[2], a1[3]}, vf1 = (bf16x8_t){b0[0], b0[1], b0[2], b0[3], b1[0], b1[1], b1[2], b1[3]};
        if (db == 0) { a.o0 = __builtin_amdgcn_mfma_f32_32x32x16_bf16(vf0, pb0, a.o0, 0, 0, 0); a.o0 = __builtin_amdgcn_mfma_f32_32x32x16_bf16(vf1, pb1, a.o0, 0, 0, 0); }
        else { a.o1 = __builtin_amdgcn_mfma_f32_32x32x16_bf16(vf0, pb0, a.o1, 0, 0, 0); a.o1 = __builtin_amdgcn_mfma_f32_32x32x16_bf16(vf1, pb1, a.o1, 0, 0, 0); }
    }
}
DEVFN void attc_stage(LAS unsigned char* buf, const u32x4_t kreg, const u32x4_t vreg, int tid) {
    const int key = tid >> 3, piece = tid & 7;
    *(LAS u32x4_t*)(buf + key * 144 + piece * 16) = kreg;
    const int ko = (((key >> 2) ^ piece) << 3) + (key & 3) * 2;
#pragma unroll
    for (int e = 0; e < 4; ++e) { *(LAS bf16_t*)(buf + AC_V + (piece * 8 + 2 * e) * 144 + ko) = (bf16_t)(vreg[e] & 0xffffu); *(LAS bf16_t*)(buf + AC_V + (piece * 8 + 2 * e + 1) * 144 + ko) = (bf16_t)(vreg[e] >> 16); }
}
DEVFN void ph_swa_attn_wg(const Params& p, LAS unsigned char* lds, int tid, int bid, int G) {
    const bf16_t* Z = WSP(const bf16_t, WS_Z); bf16_t* att = WSP(bf16_t, WS_ATT); constexpr int LDZ = 1536;
    const int lane = tid & 63, wv = __builtin_amdgcn_readfirstlane(tid >> 6), q31 = lane & 31, hi = lane >> 5, key = tid >> 3, piece = tid & 7;
    constexpr int XB = SEQ / 64, CB = CL / 64, CT = CL / 64, NIT = NBAT * 4 * (XB + CB);
    const float c2 = 0.125f * LOG2E;
    for (int it = bid; it < NIT; it += G) {
        const int qb = it % (XB + CB), kvh = (it / (XB + CB)) & 3, b = it / ((XB + CB) * 4);
        const bool isx = qb < XB; const int q0 = isx ? qb * 64 : (qb - XB) * 64;
        const int hq = kvh * 4 + (wv & 3), qa = q0 + 32 * (wv >> 2);
        const size_t qtok0 = (isx ? (size_t)b * SEQ : (size_t)NX + b * CL) + qa;
        bf16x8_t qf[4]; attw_qload(qf, Z + (qtok0 + q31) * LDZ + hq * 64 + 8 * hi);
        AttW a; a.o0 = (f32x16_t){}; a.o1 = (f32x16_t){}; a.m = -1e30f; a.l = 0.f;
        const int lo = isx ? imax(0, q0 - 128) : 0, hiK = isx ? imin(SEQ - 64, q0 + 128) : -64;
        const int ntile = CT + (isx ? (hiK - lo) / 64 + 1 : 0);
        const size_t koff = 1024 + kvh * 64 + piece * 8, voff = 1280 + kvh * 64 + piece * 8;
        auto tile_tok = [&](int ti) -> size_t { return ti < CT ? (size_t)NX + b * CL + ti * 64 + key : (size_t)b * SEQ + lo + (ti - CT) * 64 + key; };
        u32x4_t kr, vr, kr2, vr2;
        { const size_t tk = tile_tok(0); kr = *(const u32x4_t*)(Z + tk * LDZ + koff); vr = *(const u32x4_t*)(Z + tk * LDZ + voff); }
        attc_stage(lds, kr, vr, tid);
        { const size_t tk = tile_tok(imin(1, ntile - 1)); kr = *(const u32x4_t*)(Z + tk * LDZ + koff); vr = *(const u32x4_t*)(Z + tk * LDZ + voff); }
        __syncthreads();
#pragma unroll 1
        for (int ti = 0; ti < ntile; ++ti) {
            const bool more = ti + 1 < ntile;
            { const size_t tk = tile_tok(imin(ti + 2, ntile - 1)); kr2 = *(const u32x4_t*)(Z + tk * LDZ + koff); vr2 = *(const u32x4_t*)(Z + tk * LDZ + voff); }
            const LAS unsigned char* kb = lds + (ti & 1) * AC_BUF; const LAS unsigned char* vb = kb + AC_V;
            if (ti < CT) {
                attc_sub<false>(a, qf, kb, vb, 0, lane, c2, [](int) { return 0.f; });
                attc_sub<false>(a, qf, kb, vb, 1, lane, c2, [](int) { return 0.f; });
            } else {
#pragma unroll
                for (int sub = 0; sub < 2; ++sub) {
                    const int ks = lo + (ti - CT) * 64 + 32 * sub;
                    if (ks + 31 >= qa - 128 && ks <= qa + 31 + 128) {
                        const int dk = ks - qa - q31 + 4 * hi;
                        if (ks + 31 - qa <= 128 && qa + 31 - ks <= 128) attc_sub<false>(a, qf, kb, vb, sub, lane, c2, [](int) { return 0.f; });
                        else attc_sub<true>(a, qf, kb, vb, sub, lane, c2, [dk](int r) { const int dd = dk + (r & 3) + 8 * (r >> 2); return (dd > 128 || dd < -128) ? -1e30f : 0.f; });
                    }
                }
            }
            if (more) attc_stage(lds + ((ti + 1) & 1) * AC_BUF, kr, vr, tid);
            kr = kr2; vr = vr2;
            __syncthreads();
        }
        const float sk2 = p.swa_sink[hq] * LOG2E, mf = fmaxf(a.m, sk2), al = __builtin_amdgcn_exp2f(a.m - mf);
        const float lt = (a.l + __shfl_xor(a.l, 32)) * al + __builtin_amdgcn_exp2f(sk2 - mf);
        attw_store(a, al / lt, lds + AC_SCR + wv * 4608, lane, att + qtok0 * D + hq * 64, D);
    }
}
DEVFN void ph_na_attn_wg(const Params& p, LAS unsigned char* lds, int tid, int bid, int G) {
    const bf16_t* Z = WSP(const bf16_t, WS_Z); bf16_t* att = WSP(bf16_t, WS_ATT); constexpr int LDZ = 3072;
    const int lane = tid & 63, wv = __builtin_amdgcn_readfirstlane(tid >> 6), q31 = lane & 31, hi = lane >> 5, key = tid >> 3, piece = tid & 7;
    constexpr int XG = NROWS / 4, CG = CL / 256, CT = CL / 64, NIT = NBAT * 16 * (XG + CG);
    const float c2 = 0.125f * LOG2E;
    for (int it = bid; it < NIT; it += G) {
        const int qg = it % (XG + CG), hq = (it / (XG + CG)) & 15, b = it / ((XG + CG) * 16);
        const bool isx = qg < XG;
        const int jb = wv & 3, rw = isx ? qg * 4 + 2 * (wv >> 2) : 0;
        const int r = rw + (q31 >> 4), c = 16 * jb + (q31 & 15);
        const size_t qtok = isx ? (size_t)b * SEQ + r * GW + c : (size_t)NX + b * CL + (qg - XG) * 256 + wv * 32 + q31;
        const size_t otok0 = isx ? (size_t)b * SEQ + rw * GW + 16 * jb : (size_t)NX + b * CL + (qg - XG) * 256 + wv * 32;
        bf16x8_t qf[4]; attw_qload(qf, Z + qtok * LDZ + hq * 64 + 8 * hi);
        AttW a; a.o0 = (f32x16_t){}; a.o1 = (f32x16_t){}; a.m = -1e30f; a.l = 0.f;
        const int rstart = iclamp(r - 4, 0, NROWS - 8), cstart = iclamp(c - 8, 0, GW - 16);
        const int wlo = iclamp(rw - 4, 0, NROWS - 8), whi = iclamp(rw + 1 - 4, 0, NROWS - 8) + 7;
        const int rmin = iclamp(qg * 4 - 4, 0, NROWS - 8), rmax = iclamp(qg * 4 + 3 - 4, 0, NROWS - 8) + 7;
        const int ntile = CT + (isx ? rmax - rmin + 1 : 0);
        const int k0 = iclamp(16 * jb - 8, 0, 32);
        const size_t koff = 1024 + hq * 64 + piece * 8, voff = 2048 + hq * 64 + piece * 8;
        auto tile_tok = [&](int ti) -> size_t { return ti < CT ? (size_t)NX + b * CL + ti * 64 + key : (size_t)b * SEQ + (rmin + ti - CT) * GW + key; };
        LAS float* rpl = (LAS float*)(lds + AC_BYTES);
        if (tid < 15 * 31) rpl[tid] = p.na_rpb[(size_t)hq * 15 * 31 + tid] * LOG2E;
        u32x4_t kr, vr, kr2, vr2;
        { const size_t tk = tile_tok(0); kr = *(const u32x4_t*)(Z + tk * LDZ + koff); vr = *(const u32x4_t*)(Z + tk * LDZ + voff); }
        attc_stage(lds, kr, vr, tid);
        { const size_t tk = tile_tok(imin(1, ntile - 1)); kr = *(const u32x4_t*)(Z + tk * LDZ + koff); vr = *(const u32x4_t*)(Z + tk * LDZ + voff); }
        __syncthreads();
#pragma unroll 1
        for (int ti = 0; ti < ntile; ++ti) {
            const bool more = ti + 1 < ntile;
            { const size_t tk = tile_tok(imin(ti + 2, ntile - 1)); kr2 = *(const u32x4_t*)(Z + tk * LDZ + koff); vr2 = *(const u32x4_t*)(Z + tk * LDZ + voff); }
            const LAS unsigned char* kb = lds + (ti & 1) * AC_BUF; const LAS unsigned char* vb = kb + AC_V;
            if (ti < CT) {
                attc_win<false>(a, qf, kb, vb, 0, lane, c2, [](int) { return 0.f; });
                attc_win<false>(a, qf, kb, vb, 32, lane, c2, [](int) { return 0.f; });
            } else {
                const int kr_ = rmin + ti - CT;
                if (kr_ >= wlo && kr_ <= whi) {
                    const bool rowok = kr_ >= rstart && kr_ < rstart + 8;
                    const LAS float* rp = rpl + iclamp(kr_ - r + 7, 0, 14) * 31 + 15 - c;
                    const int kc0 = k0 + 4 * hi;
                    attc_win<true>(a, qf, kb, vb, k0, lane, c2, [=](int rr) { const int kc = kc0 + (rr & 3) + 8 * (rr >> 2); const bool ok = rowok && kc >= cstart && kc < cstart + 16;
                        return ok ? rp[ok ? kc : c] : -1e30f; });
                }
            }
            if (more) attc_stage(lds + ((ti + 1) & 1) * AC_BUF, kr, vr, tid);
            kr = kr2; vr = vr2;
            __syncthreads();
        }
        const float lt = a.l + __shfl_xor(a.l, 32);
        attw_store(a, 1.f / lt, lds + AC_SCR + wv * 4608, lane, att + otok0 * D + hq * 64, D, isx ? GW - 16 : 0);
    }
}
#endif
#ifndef CPU_TEST
constexpr int G2_QS = 0, G2_KS = 8704, G2_KE = 17408, G2_VT = 27648, G2_D = 37888, G2_BUF = 38400;
struct HgRaw { unsigned short q[8], f[8], v[8]; };
DEVFN void hg_load(HgRaw& r, const bf16_t* Z, size_t row0, int step, int foff, int col) {
#pragma unroll
    for (int i = 0; i < 8; ++i) { const bf16_t* zr = Z + (size_t)((long)row0 + (long)i * step) * 5120 + col; r.q[i] = zr[0]; r.v[i] = zr[1024]; r.f[i] = zr[foff]; }
}
DEVFN void hg_prep(const HgRaw& r, LAS unsigned char* buf, int k, int tg, int lane) {
    float lf[8], cum[8]; float run = 0.f;
#pragma unroll
    for (int i = 0; i < 8; ++i) { lf[i] = (float)__builtin_bit_cast(_Float16, r.f[i]); run += lf[i]; cum[i] = run; }
    const float p1 = __shfl_xor(run, 16), ps = run + p1, q2 = __shfl_xor(ps, 32);
    const float off = ((tg & 1) ? p1 : 0.f) + ((tg & 2) ? q2 : 0.f), bend = ps + q2, eEnd = __expf(bend);
    unsigned kew[4], vtw[4];
#pragma unroll
    for (int i = 0; i < 8; ++i) {
        const float B = off + cum[i], eB = __expf(B), eN = __builtin_amdgcn_rcpf(eB), kk = 1.f - __expf(lf[i]);
        const int t = 8 * tg + i;
        const unsigned qs = pk_bf16(bf2f(r.q[i]) * eB, kk * eN);
        *(LAS bf16_t*)(buf + G2_QS + t * 272 + k * 2) = (bf16_t)(qs & 0xffffu);
        *(LAS bf16_t*)(buf + G2_KS + t * 272 + k * 2) = (bf16_t)(qs >> 16);
        const unsigned kv = pk_bf16(kk * eN * eEnd, 0.f) & 0xffffu, vt = r.v[i];
        if (i & 1) { kew[i >> 1] |= kv << 16; vtw[i >> 1] |= vt << 16; } else { kew[i >> 1] = kv; vtw[i >> 1] = vt; }
    }
    *(LAS u32x4_t*)(buf + G2_KE + k * 80 + tg * 16) = (u32x4_t){kew[0], kew[1], kew[2], kew[3]};
    *(LAS u32x4_t*)(buf + G2_VT + k * 80 + tg * 16) = (u32x4_t){vtw[0], vtw[1], vtw[2], vtw[3]};
    if (tg == 0) ((LAS float*)(buf + G2_D))[k] = eEnd;
}
DEVFN void ph_hgrn_scan2(const Params& p, LAS unsigned char* lds, int tid, int bid, int G) {
    if (bid >= NBAT * 16) { ph_cvt_uv_fp8(p, lds, tid, bid - NBAT * 16, G - NBAT * 16); return; }
    const int dir = bid & 1, h = (bid >> 1) & 7, b = bid >> 4;
    const bf16_t* Z = WSP(const bf16_t, WS_Z);
    bf16_t* od = WSP(bf16_t, WS_Y) + (dir ? (size_t)NT * D : 0);
    const int lane = tid & 63, w = __builtin_amdgcn_readfirstlane(tid >> 6), c16 = lane & 15, g = lane >> 4;
    const int pk = 16 * w + c16, ptg = g;
    constexpr int NCH = (CL + SEQ) / 32;
    const int foff = dir ? 3072 : 2048, step = dir ? -1 : 1;
    auto row0 = [&](int c) -> size_t { const int s = c * 32 + 8 * ptg; return s < CL ? (size_t)(NX + b * CL + (dir ? CL - 1 - s : s)) : (size_t)(b * SEQ + (dir ? SEQ - 1 - (s - CL) : s - CL)); };
    auto trow = [&](int s) -> size_t { return s < CL ? (size_t)(NX + b * CL + (dir ? CL - 1 - s : s)) : (size_t)(b * SEQ + (dir ? SEQ - 1 - (s - CL) : s - CL)); };
    f32x4v S[8];
#pragma unroll
    for (int i = 0; i < 8; ++i) S[i] = (f32x4v){0.f, 0.f, 0.f, 0.f};
    HgRaw raw;
    hg_load(raw, Z, row0(0), step, foff, h * 128 + pk);
    hg_prep(raw, lds, pk, ptg, lane);
    hg_load(raw, Z, row0(1), step, foff, h * 128 + pk);
    __syncthreads();
#pragma unroll 1
    for (int c = 0; c < NCH; ++c) {
        if (c + 1 < NCH) { hg_prep(raw, lds + ((c + 1) & 1) * G2_BUF, pk, ptg, lane); if (c + 2 < NCH) hg_load(raw, Z, row0(c + 2), step, foff, h * 128 + pk); }
        const LAS unsigned char* bf = lds + (c & 1) * G2_BUF;
        f32x4v X00 = {0.f, 0.f, 0.f, 0.f}, X01 = X00, X11 = X00;
#pragma unroll
        for (int ks = 0; ks < 4; ++ks) {
            const bf16x8_t a0 = *(const LAS bf16x8_t*)(bf + G2_KS + c16 * 272 + ks * 64 + g * 16), a1 = *(const LAS bf16x8_t*)(bf + G2_KS + (16 + c16) * 272 + ks * 64 + g * 16);
            const bf16x8_t b0 = *(const LAS bf16x8_t*)(bf + G2_QS + c16 * 272 + ks * 64 + g * 16), b1 = *(const LAS bf16x8_t*)(bf + G2_QS + (16 + c16) * 272 + ks * 64 + g * 16);
            X00 = __builtin_amdgcn_mfma_f32_16x16x32_bf16(a0, b0, X00, 0, 0, 0);
            X01 = __builtin_amdgcn_mfma_f32_16x16x32_bf16(a0, b1, X01, 0, 0, 0);
            X11 = __builtin_amdgcn_mfma_f32_16x16x32_bf16(a1, b1, X11, 0, 0, 0);
        }
#pragma unroll
        for (int r = 0; r < 4; ++r) { const bool keep = (4 * g + r) <= c16; X00[r] = keep ? X00[r] : 0.f; X11[r] = keep ? X11[r] : 0.f; }
        const u32x4_t p0w = (u32x4_t){pk_bf16(X00[0], X00[1]), pk_bf16(X00[2], X00[3]), 0u, 0u};
        const u32x4_t p1w = (u32x4_t){pk_bf16(X01[0], X01[1]), pk_bf16(X01[2], X01[3]), pk_bf16(X11[0], X11[1]), pk_bf16(X11[2], X11[3])};
        const int vrow = (16 * w + c16) * 80;
        const s16x4v vlo = *(const LAS s16x4v*)(bf + G2_VT + vrow + g * 8), vhi = *(const LAS s16x4v*)(bf + G2_VT + vrow + 32 + g * 8);
        const bf16x8_t vperm = (bf16x8_t){vlo[0], vlo[1], vlo[2], vlo[3], vhi[0], vhi[1], vhi[2], vhi[3]};
        f32x4v o0 = {0.f, 0.f, 0.f, 0.f}, o1 = o0;
        o0 = __builtin_amdgcn_mfma_f32_16x16x32_bf16(__builtin_bit_cast(bf16x8_t, p0w), vperm, o0, 0, 0, 0);
        o1 = __builtin_amdgcn_mfma_f32_16x16x32_bf16(__builtin_bit_cast(bf16x8_t, p1w), vperm, o1, 0, 0, 0);
#pragma unroll
        for (int ks = 0; ks < 4; ++ks) {
            const u32x4_t sw = (u32x4_t){pk_bf16(S[2 * ks][0], S[2 * ks][1]), pk_bf16(S[2 * ks][2], S[2 * ks][3]), pk_bf16(S[2 * ks + 1][0], S[2 * ks + 1][1]), pk_bf16(S[2 * ks + 1][2], S[2 * ks + 1][3])};
            const bf16x8_t sb = __builtin_bit_cast(bf16x8_t, sw);
            const s16x4v q0l = *(const LAS s16x4v*)(bf + G2_QS + c16 * 272 + ks * 64 + g * 8), q0h = *(const LAS s16x4v*)(bf + G2_QS + c16 * 272 + ks * 64 + 32 + g * 8);
            const s16x4v q1l = *(const LAS s16x4v*)(bf + G2_QS + (16 + c16) * 272 + ks * 64 + g * 8), q1h = *(const LAS s16x4v*)(bf + G2_QS + (16 + c16) * 272 + ks * 64 + 32 + g * 8);
            o0 = __builtin_amdgcn_mfma_f32_16x16x32_bf16((bf16x8_t){q0l[0], q0l[1], q0l[2], q0l[3], q0h[0], q0h[1], q0h[2], q0h[3]}, sb, o0, 0, 0, 0);
            o1 = __builtin_amdgcn_mfma_f32_16x16x32_bf16((bf16x8_t){q1l[0], q1l[1], q1l[2], q1l[3], q1h[0], q1h[1], q1h[2], q1h[3]}, sb, o1, 0, 0, 0);
        }
#pragma unroll
        for (int r = 0; r < 2; ++r) {
            od[trow(c * 32 + 4 * g + 2 * r) * D + h * 128 + 16 * w + c16] = f2bf(o0[2 * r]); od[trow(c * 32 + 4 * g + 2 * r + 1) * D + h * 128 + 16 * w + c16] = f2bf(o0[2 * r + 1]);
            od[trow(c * 32 + 16 + 4 * g + 2 * r) * D + h * 128 + 16 * w + c16] = f2bf(o1[2 * r]); od[trow(c * 32 + 16 + 4 * g + 2 * r + 1) * D + h * 128 + 16 * w + c16] = f2bf(o1[2 * r + 1]);
        }
        const bf16x8_t vb = *(const LAS bf16x8_t*)(bf + G2_VT + vrow + g * 16);
#pragma unroll
        for (int kt = 0; kt < 8; ++kt) {
            const f32x4v dv = *(const LAS f32x4v*)(bf + G2_D + (16 * kt + 4 * g) * 4);
            const bf16x8_t ka = *(const LAS bf16x8_t*)(bf + G2_KE + (16 * kt + c16) * 80 + g * 16);
            S[kt] = __builtin_amdgcn_mfma_f32_16x16x32_bf16(ka, vb, S[kt] * dv, 0, 0, 0);
        }
        __syncthreads();
    }
}
#endif
#define PEER_PHASES(l, M) \
    PH(GEMM_BF16(WS_HB, WS_WQ + (size_t)(l) * 2048 * D * 2, M, 2048, WS_QP, 2048)) \
    PEER_ROUTE(l, M) \
    PEER_EXPERTS(l, M)
#define PROGRAM \
    PH(PRO_A) \
    PH(H0) \
      \
    PH(GEMM_HGRN(WS_HB, WS_WIN0, NT, 5120, WS_Z, 5120)) \
    HGRN_SCAN \
    PH(HGRN_READOUT) \
    PH(GEMM_F32(WS_ATT, WS_WOUT + (size_t)0 * D * D * 2, NT, 1024, WS_Y, 1024)) \
    PH(LN1(0, NT)) \
    PEER_PHASES(0, NT) \
      \
    SWA_PROJ \
    PH(SWA_ATTN) \
    PH(GEMM_F32(WS_ATT, WS_WOUT + (size_t)1 * D * D * 2, NT, 1024, WS_Y, 1024)) \
    PH(LN1(1, NT)) \
    PEER_PHASES(1, NT) \
      \
    PH(GEMM_BF16(WS_HB, WS_WIN2, NT, 3072, WS_Z, 3072)) \
    PH(NA_ATTN) \
    PH(GEMM_F32(WS_ATT, WS_WOUT + (size_t)2 * D * D * 2, NT, 1024, WS_Y, 1024)) \
    PH(LN1(2, NT)) \
    PEER_PHASES(2, NT) \
      \
    PH(GEMM_BF16(WS_HB, WS_WIN3, NT, 1536, WS_Z, 1536)) \
    PH(GQA_PREP) \
    PH(GQA_ATTN) \
    PH(GEMM_F32(WS_ATT, WS_WOUT + (size_t)3 * D * D * 2, NX, 1024, WS_Y, 1024)) \
    PH(LN1(3, NX)) \
    PEER_PHASES(3, NX)
#ifdef CPU_TEST
#define PEER_EXPERTS(l, M) PH(ph_peer_act(p, l, M, gtid, gsize)) PH(ph_peer_out(p, l, M, gtid, gsize)) PH(ph_ln(p, l, 1, M, gtid, gsize))
#define PEER_ROUTE(l, M) PH(ph_peer_scores(p, l, M, gtid, gsize)) PH(ph_peer_combine(p, M, gtid, gsize))
#define PRO_A ph_pro_a(p, gtid, gsize)
#define H0 ph_h0(p, gtid, gsize)
#define HGRN_READOUT ph_hgrn_readout(p, gtid, gsize)
#define SWA_PROJ PH(GEMM_BF16(WS_HB, WS_WIN1, NT, 1536, WS_Z, 1536)) PH(ph_swa_rope(p, gtid, gsize))
#define GQA_PREP ph_gqa_prep(p, gtid, gsize)
#define LN1(l, M) ph_ln(p, l, 0, M, gtid, gsize)
#define HGRN_SCAN PH(ph_hgrn_gates(p, gtid, gsize)) PH(ph_hgrn_scan(p, gtid, gsize))
#define SWA_ATTN ph_swa_attn(p, gtid, gsize)
#define NA_ATTN ph_na_attn(p, gtid, gsize)
constexpr int NPHASES = 2 + 12 + 12 + 11 + 12;
#else
#define PEER_EXPERTS(l, M) PH(ph_peer_u(p, l, M, tid, bid, G)) PH(ph_peer_comb(p, l, M, gtid, gsize)) PH(ph_peer_v(p, lds, l, M, tid, bid, G)) PH(ph_ln2_gpu(p, l, M, tid, bid, G, rep_dry))
#define PEER_ROUTE(l, M) PH(ph_peer_route(p, l, M, lds, tid, bid, G))
#define PRO_A ph_pro_gpu(p, lds, tid, bid, G, gtid, gsize)
#define H0 ph_h0_gpu(p, gtid, gsize)
#define HGRN_READOUT ph_hgrn_readout_gpu(p, tid, bid, G)
#define SWA_PROJ PH(GEMM_SWA(WS_HB, WS_WIN1, NT, 1536, WS_Z, 1536))
#define GQA_PREP ph_gqa_prep_gpu(p, gtid, gsize)
#define LN1(l, M) ph_ln1_gpu(p, l, M, tid, bid, G, rep_dry)
#define HGRN_SCAN PH(ph_hgrn_scan2(p, lds, tid, bid, G))
#define SWA_ATTN ph_swa_attn_wg(p, lds, tid, bid, G)
#define NA_ATTN ph_na_attn_wg(p, lds, tid, bid, G)
constexpr int NPHASES = 2 + 11 + 10 + 10 + 11;
#endif
#ifndef CPU_TEST
constexpr int NTHREADS = 512;
constexpr int RING_BYTES = 131072, LDSCTL_OFF = RING_BYTES, LDS_BYTES = 147456;
#ifndef MK_REPEAT
#define MK_REPEAT 0
#endif
#ifndef MK_REP_K
#define MK_REP_K (-1)
#endif
#ifndef MK_REP_N
#define MK_REP_N 1
#endif
#ifndef MK_REP_MASK
#define MK_REP_MASK 0ull
#endif
#ifndef MK_PER_PHASE
#define MK_PER_PHASE 0
#endif
constexpr int CW_BAR = 4096;

__global__ void __launch_bounds__(NTHREADS, 2) mk_fwd(Params p) {
    extern __shared__ __attribute__((aligned(16))) unsigned char lds_raw[];
    LAS unsigned char* lds = (LAS unsigned char*)lds_raw;
    const int tid = threadIdx.x, bid = blockIdx.x, G = gridDim.x;
    for (int u = tid; u < (LDS_BYTES - LDSCTL_OFF) / 4; u += NTHREADS) ((LAS unsigned*)(lds + LDSCTL_OFF))[u] = 0u;
    __syncthreads();
    XcdBarrier bar; bar.bar = (unsigned*)(p.ws + WS_CTL) + CW_BAR; bar.x = 0; bar.st = nullptr;
    if (!MK_PER_PHASE) bar = xcd_barrier_post((unsigned*)(p.ws + WS_CTL) + CW_BAR, (volatile LAS unsigned*)(lds + LDSCTL_OFF));
    const size_t gsize = (size_t)G * NTHREADS;
    const int lo = p.ph_lo, hi = p.ph_hi;
    int kk = 0;
#define GEMM_BF16(Aoff, Boff, M_, N_, Ooff, ldc_) do { pg8::Gemm g{WSP(const bf16_t, Aoff), WSP(const bf16_t, Boff), M_, N_, D}; pg8::StaticOrder S; S.init(M_, N_, G, bid); \
        pg8::EpiBf16 E{WSP(bf16_t, Ooff), ldc_}; pg8::gemm_phase<pg8::EpiBf16, pg8::StaticOrder, true, true>(lds, g, S, E); } while (0)
#define GEMM_HGRN(Aoff, Boff, M_, N_, Ooff, ldc_) do { pg8::Gemm g{WSP(const bf16_t, Aoff), WSP(const bf16_t, Boff), M_, N_, D}; pg8::StaticOrder S; S.init(M_, N_, G, bid); \
        pg8::EpiHgrn E{WSP(bf16_t, Ooff), ldc_, WSP(const float, WS_LBV)}; pg8::gemm_phase<pg8::EpiHgrn, pg8::StaticOrder, true, true>(lds, g, S, E); } while (0)
#define GEMM_SWA(Aoff, Boff, M_, N_, Ooff, ldc_) do { pg8::Gemm g{WSP(const bf16_t, Aoff), WSP(const bf16_t, Boff), M_, N_, D}; pg8::StaticOrder S; S.init(M_, N_, G, bid); \
        pg8::EpiSwa E{WSP(bf16_t, Ooff), ldc_, WSP(const float, WS_ROPE) + ROPE64_COS, WSP(const float, WS_ROPE) + ROPE64_SIN, NX, SEQ, GW}; pg8::gemm_phase<pg8::EpiSwa, pg8::StaticOrder, true, true>(lds, g, S, E); } while (0)
#define GEMM_F32(Aoff, Boff, M_, N_, Ooff, ldc_) GEMM_BF16(Aoff, Boff, M_, N_, Ooff, ldc_)
#define GQA_ATTN ph_gqa_attn_mfma(p, (char*)lds_raw, bid, G)
#define PH_ONCE(...) PH_ONCE_D(0, __VA_ARGS__)
#define PH_ONCE_D(dry_, ...) { constexpr int rep_dry = dry_; (void)rep_dry; int tid = threadIdx.x; asm volatile("" : "+v"(tid)); const size_t gtid = ((size_t)(tid >> 6) * G + bid) * 64 + (tid & 63); __VA_ARGS__; }
#define PH(stmt) { const int k_ = kk++; if (lo <= k_ && k_ < hi) { \
        if (MK_REPEAT && ((MK_REP_MASK >> k_) & 1ull)) { PH_ONCE_D(1, stmt) xcd_barrier(bar); }     \
        PH_ONCE(stmt) \
        if (k_ + 1 < hi) xcd_barrier(bar); } }
    PROGRAM
#if MK_REPEAT
    for (int xb_ = 0; xb_ < MK_REP_N - 1; ++xb_) xcd_barrier(bar);
#endif
#undef PH
#undef GEMM_BF16
#undef GEMM_F32
#undef GEMM_HGRN
#undef GEMM_SWA
}

extern "C" void kernel_launch(void* const* d_in, const int* in_sizes, int n_in, void* d_out, int out_size, void* d_ws, size_t ws_size, hipStream_t stream) {
    static int grid = 0;
    if (grid == 0) {
        if (n_in != 26 || out_size != NX * D || ws_size < WS_END2) { fprintf(stderr, "kernel_launch: unexpected shapes (n_in %d out %d ws %zu need %zu)\n", n_in, out_size, ws_size, (size_t)WS_END2); grid = -1; return; }
        int dev = 0, cus = 0, per_cu = 0;
        if (hipGetDevice(&dev) != hipSuccess || hipDeviceGetAttribute(&cus, hipDeviceAttributeMultiprocessorCount, dev) != hipSuccess) { grid = -1; return; }
        if (hipFuncSetAttribute((const void*)mk_fwd, hipFuncAttributeMaxDynamicSharedMemorySize, LDS_BYTES) != hipSuccess) { fprintf(stderr, "kernel_launch: hipFuncSetAttribute failed\n"); grid = -1; return; }
        if (hipOccupancyMaxActiveBlocksPerMultiprocessor(&per_cu, (const void*)mk_fwd, NTHREADS, LDS_BYTES) != hipSuccess || per_cu < 1) { fprintf(stderr, "kernel_launch: occupancy query says %d\n", per_cu); grid = -1; return; }
        (void)hipGetLastError();
        grid = cus;
    }
    if (grid < 0) return;
    if (hipMemsetAsync((char*)d_ws + WS_CTL, 0, CTL_BYTES, stream) != hipSuccess) return;
    Params p{};
    const float** pp = (const float**)&p;
    for (int i = 0; i < 26; ++i) pp[i] = (const float*)d_in[i];
    p.out = (float*)d_out; p.ws = (unsigned char*)d_ws; p.rep_k = 0; p.rep_n = 0; p.rep_mask = 0;
#if MK_PER_PHASE
    for (int k = 0; k < NPHASES; ++k) { p.ph_lo = k; p.ph_hi = k + 1; hipLaunchKernelGGL(mk_fwd, dim3(grid), dim3(NTHREADS), LDS_BYTES, stream, p); }
#else
    p.ph_lo = 0; p.ph_hi = NPHASES;
    hipLaunchKernelGGL(mk_fwd, dim3(grid), dim3(NTHREADS), LDS_BYTES, stream, p);
#endif
}
#endif
```

```cpp
#ifdef CPU_TEST
#include <cmath>
#include <cstdio>
#include <cstdlib>
#include <cstring>
#include <cstddef>
#define DEVFN static inline
#else
#include <hip/hip_runtime.h>
#include <cstdio>
#define DEVFN __device__ __forceinline__
#endif

#ifndef CFG_BATCH
#define CFG_BATCH 8
#endif
#ifndef CFG_SEQ
#define CFG_SEQ 4096
#endif
#ifndef CFG_CTX
#define CFG_CTX 256
#endif
constexpr int D = 1024, NBAT = CFG_BATCH, SEQ = CFG_SEQ, CL = CFG_CTX;
constexpr int NX = NBAT * SEQ, NC = NBAT * CL, NT = NX + NC;
constexpr int GW = 64, NROWS = SEQ / GW;
constexpr int DEPTH = 4, NMR = NBAT + 1;
constexpr float ALPHA = 1.6817928305074290f;
constexpr float LN_EPS = 1e-5f, RMS_EPS = 1e-6f;
constexpr float LN_THETA = 9.210340371976184f;
constexpr int PEER_N = 16384;

typedef unsigned short bf16_t;
DEVFN float bf2f(bf16_t b) { const unsigned u = ((unsigned)b) << 16; return __builtin_bit_cast(float, u); }
DEVFN bf16_t f2bf(float f) { unsigned u = __builtin_bit_cast(unsigned, f); u += 0x7fffu + ((u >> 16) & 1u); return (bf16_t)(u >> 16); }
DEVFN float sigmoidf_(float x) { return 1.f / (1.f + expf(-x)); }
DEVFN float siluf_(float x) { return x / (1.f + expf(-x)); }
DEVFN float geluf_(float x) { return 0.5f * x * (1.f + tanhf(0.7978845608028654f * (x + 0.044715f * x * x * x))); }
DEVFN int imin(int a, int b) { return a < b ? a : b; }
DEVFN int imax(int a, int b) { return a > b ? a : b; }
DEVFN int iclamp(int v, int lo, int hi) { return v < lo ? lo : (v > hi ? hi : v); }

struct Params {
    const float *x, *c, *ctx, *c_ctx, *mod_w, *mod_b, *ln_g, *ln_b, *peer_wq, *peer_keys, *peer_u, *peer_v;
    const float *hgrn_w_in, *hgrn_lb, *hgrn_norm_g, *hgrn_w_out, *swa_w_in, *swa_sink, *swa_w_out;
    const float *na_w_in, *na_rpb, *na_w_out, *gqa_w_in, *gqa_q_norm, *gqa_k_norm, *gqa_w_out;
    float* out; unsigned char* ws; int ph_lo, ph_hi, rep_k, rep_n; unsigned long long rep_mask;
};

constexpr size_t al256(size_t x) { return (x + 255) & ~(size_t)255; }
constexpr size_t WS_CTL = 0, CTL_BYTES = 1u << 20;
constexpr size_t WS_MODV = WS_CTL + CTL_BYTES;
constexpr size_t WS_LBV = WS_MODV + al256((size_t)DEPTH * NMR * 6144 * 4);
constexpr size_t WS_WIN0 = WS_LBV + 4096;
constexpr size_t WS_WIN1 = WS_WIN0 + (size_t)5120 * 1024 * 2;
constexpr size_t WS_WIN2 = WS_WIN1 + (size_t)1536 * 1024 * 2;
constexpr size_t WS_WIN3 = WS_WIN2 + (size_t)3072 * 1024 * 2;
constexpr size_t WS_WOUT = WS_WIN3 + (size_t)1536 * 1024 * 2;
constexpr size_t WS_WQ = WS_WOUT + (size_t)4 * 1024 * 1024 * 2;
constexpr size_t WS_XS = WS_WQ + (size_t)4 * 2048 * 1024 * 2;
constexpr size_t WS_HB = WS_XS + (size_t)NT * 1024 * 4;
constexpr size_t WS_ATT = WS_HB + (size_t)NT * 1024 * 2;
constexpr size_t WS_Y = WS_ATT + (size_t)NT * 1024 * 2;
constexpr size_t WS_Z = WS_Y + (size_t)NT * 1024 * 4;
constexpr size_t WS_END = WS_Z + (size_t)NT * 5120 * 2;
constexpr size_t WS_QP = WS_Z;
constexpr size_t WS_IDX = WS_QP + (size_t)NT * 2048 * 2;
constexpr size_t WS_GATE = WS_IDX + (size_t)NT * 128 * 4;
constexpr size_t WS_WA = WS_GATE + (size_t)NT * 128 * 4;
constexpr size_t WS_PART = WS_WA + (size_t)NT * 128 * 4;
constexpr size_t WS_SV = WS_PART;
constexpr size_t WS_SI = WS_SV + (size_t)NT * 256 * 4;
static_assert(WS_PART + (size_t)8 * NT * 128 * 4 <= WS_END, "PEER aliases fit in Z");
constexpr size_t WS_UV8 = WS_END;
constexpr size_t WS_UVS = WS_UV8 + (size_t)8 * PEER_N * 1024;
constexpr size_t WS_KEYS = WS_UVS + (size_t)8 * PEER_N * 4;
constexpr size_t WS_ROPE = WS_KEYS + (size_t)4 * 16 * 128 * 128 * 2;
constexpr size_t ROPE64_COS = 0, ROPE64_SIN = 64 * 16, ROPE128_COS = 2 * 64 * 16, ROPE128_SIN = 2 * 64 * 16 + 64 * 32;
constexpr size_t WS_HQH = al256(WS_ROPE + (size_t)(2 * 64 * 16 + 2 * 64 * 32) * 4);
constexpr size_t WS_HQL = WS_HQH + (size_t)NT * 1024;
constexpr size_t WS_HQS = WS_HQL + (size_t)NT * 1024;
constexpr size_t WS_END2 = WS_HQS + (size_t)NT * 8 * 4;
#ifndef CPU_TEST
namespace pg8 {
#define PG8_LAS __attribute__((address_space(3)))
typedef short bf16x8 __attribute__((ext_vector_type(8)));
typedef float f32x4 __attribute__((ext_vector_type(4)));
typedef unsigned u32x4 __attribute__((ext_vector_type(4)));
constexpr int BM = 256, BK = 64, HALF = 128, HTB = HALF * BK * 2  , STAGE_BYTES = 8 * HTB, NXCD = 8, WGM = 8;

__host__ __device__ __forceinline__ int lds_byte(int r, int c) { const int st = (r >> 4) * 2 + (c >> 5), rr = r & 15, cc = c & 31, ob = rr * 64 + cc * 2; return st * 1024 + (ob ^ (((ob >> 9) & 1) << 5)); }
__host__ __device__ __forceinline__ void stage_rc(int b, int& R, int& C) { const int st = b / 1024, sb = b % 1024, swz = sb ^ (((sb >> 9) & 1) << 5); R = (st >> 1) * 16 + swz / 64; C = (st & 1) * 32 + (swz % 64) / 2; }
__host__ __device__ __forceinline__ int perm32(int rho) { const int n = rho >> 4, i = rho & 15; return 8 * (i >> 2) + 4 * n + (i & 3); }

struct Unit { int pm, pn; };
struct Gemm { const bf16_t* A; const bf16_t* Bt; int M, N, K; };

struct StaticOrder {
    int nM, nN, nwg, G, c;
    __host__ __device__ void init(int M, int N, int G_, int c_) { nM = M / BM; nN = N / BM; nwg = nM * nN; G = G_; c = c_; }
    __host__ __device__ bool next(int i, Unit& u) const {
        const long L = (long)i * G + c; if (L >= nwg) return false;
        int wgid = (int)L; { const int q = nwg / NXCD, r = nwg % NXCD, xcd = wgid % NXCD, off = wgid / NXCD; wgid = (xcd < r ? xcd * (q + 1) : r * (q + 1) + (xcd - r) * q) + off; }
        const int nig = WGM * nN, gid = wgid / nig, fm = gid * WGM, gsz = (nM - fm) < WGM ? (nM - fm) : WGM;
        u.pm = fm + ((wgid % nig) % gsz); u.pn = (wgid % nig) / gsz; return true;
    }
    __device__ __forceinline__ void a_ready(const Unit&) const {}
    __device__ __forceinline__ void done(const Unit&) const {}
};

__device__ __forceinline__ unsigned cvt_pk_bf16(float lo, float hi) { unsigned r; asm volatile("v_cvt_pk_bf16_f32 %0, %1, %2" : "=v"(r) : "v"(lo), "v"(hi)); return r; }
struct EpiF32 {
    static constexpr bool PERM = false, AFTER_DRAIN = false;
    float* C; int ldc;
    __device__ __forceinline__ void operator()(const f32x4 (&acc)[2][2][4][2], const Unit& u, int wr, int wc, int fr, int fq) const {
        const int row0 = u.pm * BM + wr * 64 + fr, col0 = u.pn * BM + wc * 32 + 4 * fq;
#pragma unroll
        for (int ai = 0; ai < 2; ++ai)
#pragma unroll
            for (int m = 0; m < 4; ++m) { float* rowp = C + (size_t)(row0 + ai * HALF + m * 16) * ldc + col0;
#pragma unroll
                for (int bj = 0; bj < 2; ++bj)
#pragma unroll
                    for (int n = 0; n < 2; ++n) *(f32x4*)(rowp + bj * HALF + n * 16) = acc[ai][bj][m][n]; }
    }
};
struct EpiBf16 {
    static constexpr bool PERM = true, AFTER_DRAIN = false;
    bf16_t* O; int ldc;
    __device__ __forceinline__ void operator()(const f32x4 (&acc)[2][2][4][2], const Unit& u, int wr, int wc, int fr, int fq) const {
        const int row0 = u.pm * BM + wr * 64 + fr, col0 = u.pn * BM + wc * 32 + 8 * fq;
#pragma unroll
        for (int ai = 0; ai < 2; ++ai)
#pragma unroll
            for (int m = 0; m < 4; ++m) { bf16_t* rowp = O + (size_t)(row0 + ai * HALF + m * 16) * ldc + col0;
#pragma unroll
                for (int bj = 0; bj < 2; ++bj) { const f32x4 v0 = acc[ai][bj][m][0], v1 = acc[ai][bj][m][1];
                    u32x4 w; w.x = cvt_pk_bf16(v0[0], v0[1]); w.y = cvt_pk_bf16(v0[2], v0[3]); w.z = cvt_pk_bf16(v1[0], v1[1]); w.w = cvt_pk_bf16(v1[2], v1[3]);
                    *(u32x4*)(rowp + bj * HALF) = w; } }
    }
};

struct EpiSwa {
    static constexpr bool PERM = true, AFTER_DRAIN = false;
    bf16_t* O; int ldc; const float* rope_cos; const float* rope_sin; int nx_rows, seq, gw;
    __device__ __forceinline__ void operator()(const f32x4 (&acc)[2][2][4][2], const Unit& u, int wr, int wc, int fr, int fq) const {
        const int row0 = u.pm * BM + wr * 64 + fr, col0 = u.pn * BM + wc * 32 + 8 * fq;
        const bool roped = u.pn < 5;
        const int axis = wc & 1, fi0 = 8 * (fq & 1); const bool second = (fq & 2) != 0;
#pragma unroll
        for (int ai = 0; ai < 2; ++ai)
#pragma unroll
            for (int m = 0; m < 4; ++m) {
                const int row = row0 + ai * HALF + m * 16;
                bf16_t* rowp = O + (size_t)row * ldc + col0;
                f32x4 c0 = {1.f, 1.f, 1.f, 1.f}, c1 = c0, s0 = {0.f, 0.f, 0.f, 0.f}, s1 = s0;
                if (roped && row < nx_rows) { const int sp = row % seq, pos = axis == 0 ? sp / gw : sp % gw;
                    c0 = *(const f32x4*)(rope_cos + pos * 16 + fi0); c1 = *(const f32x4*)(rope_cos + pos * 16 + fi0 + 4); s0 = *(const f32x4*)(rope_sin + pos * 16 + fi0); s1 = *(const f32x4*)(rope_sin + pos * 16 + fi0 + 4);
                    if (!second) { s0 = -s0; s1 = -s1; } }
#pragma unroll
                for (int bj = 0; bj < 2; ++bj) { f32x4 v0 = acc[ai][bj][m][0], v1 = acc[ai][bj][m][1];
                    f32x4 p0, p1;
#pragma unroll
                    for (int j = 0; j < 4; ++j) {
                        auto r0 = __builtin_amdgcn_permlane32_swap(__float_as_uint(v0[j]), __float_as_uint(v0[j]), false, false); p0[j] = __uint_as_float(second ? r0[0] : r0[1]);
                        auto r1 = __builtin_amdgcn_permlane32_swap(__float_as_uint(v1[j]), __float_as_uint(v1[j]), false, false); p1[j] = __uint_as_float(second ? r1[0] : r1[1]); }
                    v0 = v0 * c0 + p0 * s0; v1 = v1 * c1 + p1 * s1;
                    u32x4 w; w.x = cvt_pk_bf16(v0[0], v0[1]); w.y = cvt_pk_bf16(v0[2], v0[3]); w.z = cvt_pk_bf16(v1[0], v1[1]); w.w = cvt_pk_bf16(v1[2], v1[3]);
                    *(u32x4*)(rowp + bj * HALF) = w; }
            }
    }
};
typedef _Float16 f16x2 __attribute__((ext_vector_type(2)));
typedef float f32x2e __attribute__((ext_vector_type(2)));
struct EpiHgrn {
    static constexpr bool PERM = true, AFTER_DRAIN = false;
    bf16_t* O; int ldc; const float* lbv;
    __device__ __forceinline__ void operator()(const f32x4 (&acc)[2][2][4][2], const Unit& u, int wr, int wc, int fr, int fq) const {
        const int row0 = u.pm * BM + wr * 64 + fr, col0 = u.pn * BM + wc * 32 + 8 * fq, kind = u.pn >> 2;
#pragma unroll
        for (int bj = 0; bj < 2; ++bj) {
            float lb[8];
            if (kind == 2 || kind == 3) { const f32x4 l0 = *(const f32x4*)(lbv + ((col0 + bj * HALF) & 1023)), l1 = *(const f32x4*)(lbv + ((col0 + bj * HALF) & 1023) + 4);
#pragma unroll
                for (int j = 0; j < 4; ++j) { lb[j] = l0[j]; lb[4 + j] = l1[j]; } }
#pragma unroll
            for (int ai = 0; ai < 2; ++ai)
#pragma unroll
                for (int m = 0; m < 4; ++m) {
                    bf16_t* rowp = O + (size_t)(row0 + ai * HALF + m * 16) * ldc + col0 + bj * HALF;
                    float v[8];
#pragma unroll
                    for (int j = 0; j < 4; ++j) { v[j] = acc[ai][bj][m][0][j]; v[4 + j] = acc[ai][bj][m][1][j]; }
                    u32x4 w;
                    if (kind == 2 || kind == 3) {
#pragma unroll
                        for (int j = 0; j < 4; ++j) { const float f0 = lb[2 * j] + (1.f - lb[2 * j]) * __builtin_amdgcn_rcpf(1.f + __expf(-v[2 * j])), f1 = lb[2 * j + 1] + (1.f - lb[2 * j + 1]) * __builtin_amdgcn_rcpf(1.f + __expf(-v[2 * j + 1]));
                            const f32x2e lf = {__logf(f0), __logf(f1)}; w[j] = __builtin_bit_cast(unsigned, __builtin_convertvector(lf, f16x2)); }
                    } else {
                        if (kind == 0) {
#pragma unroll
                            for (int j = 0; j < 8; ++j) v[j] = v[j] * __builtin_amdgcn_rcpf(1.f + __expf(-v[j]));
                        }
                        w.x = cvt_pk_bf16(v[0], v[1]); w.y = cvt_pk_bf16(v[2], v[3]); w.z = cvt_pk_bf16(v[4], v[5]); w.w = cvt_pk_bf16(v[6], v[7]);
                    }
                    *(u32x4*)rowp = w;
                }
        }
    }
};

template <class Epi, class Sched, bool ALIGN_EPI = false, bool SP2 = false>
__device__ __forceinline__ void gemm_phase(PG8_LAS unsigned char* lds, const Gemm g, const Sched& S, const Epi& E) {
    const int tid = threadIdx.x, wid = __builtin_amdgcn_readfirstlane(tid >> 6), lane = tid & 63, wr = wid >> 2, wc = wid & 3, fr = lane & 15, fq = lane >> 4;
    const int K = g.K, nt = K / BK;
    unsigned voffA[2], voffB[2];
#pragma unroll
    for (int i = 0; i < 2; ++i) { int R, C; stage_rc(tid * 16 + i * 8192, R, C); const int Rb = Epi::PERM ? ((R & ~31) + perm32(R & 31)) : R;
        voffA[i] = (unsigned)(R * K + C) * 2u; voffB[i] = (unsigned)(Rb * K + C) * 2u; }
    const size_t kstep = (size_t)(BK * 2);
    const size_t hstep = (size_t)HALF * K * 2;
    const size_t tstep = 2 * hstep;
    const unsigned ldsw = (unsigned)wid * 1024u;
    const int aoff = lds_byte(wr * 64 + fr, fq * 8), boff = lds_byte(wc * 32 + fr, fq * 8);
#define PG8_SA(b, h) (((b) * 2 + (h)) * HTB)
#define PG8_SB(b, h) ((4 + (b) * 2 + (h)) * HTB)
#define PG8_STAGE(bufoff, gbase, voff) do { _Pragma("unroll") for (int _i = 0; _i < 2; ++_i) \
        __builtin_amdgcn_global_load_lds((const unsigned*)((const char*)(gbase) + (voff)[_i]), (PG8_LAS unsigned*)(lds + (bufoff) + ldsw + _i * 8192), 16, 0, 0); } while (0)
#define PG8_LDA(dst, b, h) do { _Pragma("unroll") for (int m = 0; m < 4; ++m) _Pragma("unroll") for (int k = 0; k < 2; ++k) dst[m][k] = *(const PG8_LAS bf16x8*)(lds + PG8_SA(b, h) + aoff + m * 2048 + k * 1024); } while (0)
#define PG8_LDB(dst, b, h) do { _Pragma("unroll") for (int n = 0; n < 2; ++n) _Pragma("unroll") for (int k = 0; k < 2; ++k) dst[n][k] = *(const PG8_LAS bf16x8*)(lds + PG8_SB(b, h) + boff + n * 2048 + k * 1024); } while (0)
#define PG8_MMA(ai, bj, At, Bt) do { __builtin_amdgcn_s_setprio(1); _Pragma("unroll") for (int m = 0; m < 4; ++m) _Pragma("unroll") for (int n = 0; n < 2; ++n) _Pragma("unroll") for (int k = 0; k < 2; ++k) \
        acc[ai][bj][m][n] = __builtin_amdgcn_mfma_f32_16x16x32_bf16(Bt[n][k], At[m][k], acc[ai][bj][m][n], 0, 0, 0); __builtin_amdgcn_s_setprio(0); } while (0)
#define PG8_WAIT_V(n) asm volatile("s_waitcnt vmcnt(" #n ")" ::: "memory")
#define PG8_WAIT_L(n) asm volatile("s_waitcnt lgkmcnt(" #n ")" ::: "memory")
#define PG8_BAR __builtin_amdgcn_s_barrier()
#define PG8_SCHED __builtin_amdgcn_sched_barrier(0)
    Unit cur, nxt; int ui = 0;
    if (!S.next(0, cur)) return;
    f32x4 acc[2][2][4][2];
#pragma unroll
    for (int a = 0; a < 2; ++a)
#pragma unroll
        for (int b = 0; b < 2; ++b)
#pragma unroll
            for (int m = 0; m < 4; ++m)
#pragma unroll
                for (int n = 0; n < 2; ++n) acc[a][b][m][n] = (f32x4){0.f, 0.f, 0.f, 0.f};
    bf16x8 At[4][2], B0[2][2], B1[2][2];
    const char* cA = (const char*)g.A + (size_t)cur.pm * tstep; const char* cB = (const char*)g.Bt + (size_t)cur.pn * tstep;
    S.a_ready(cur);
    if constexpr (SP2) {
        PG8_STAGE(PG8_SB(0, 0), cB, voffB); PG8_STAGE(PG8_SB(0, 1), cB + hstep, voffB); PG8_STAGE(PG8_SA(0, 0), cA, voffA); PG8_STAGE(PG8_SA(0, 1), cA + hstep, voffA);
        if (wr == 1) PG8_BAR;
        PG8_WAIT_V(2); PG8_BAR;
        PG8_STAGE(PG8_SB(1, 0), cB + kstep, voffB); PG8_STAGE(PG8_SA(1, 0), cA + kstep, voffA); PG8_STAGE(PG8_SB(1, 1), cB + hstep + kstep, voffB);
        PG8_WAIT_V(6); PG8_BAR;
    } else {
        PG8_STAGE(PG8_SB(0, 0), cB, voffB); PG8_STAGE(PG8_SA(0, 0), cA, voffA); PG8_STAGE(PG8_SB(0, 1), cB + hstep, voffB); PG8_STAGE(PG8_SA(0, 1), cA + hstep, voffA);
        if (wr == 1) PG8_BAR;
        PG8_WAIT_V(4); PG8_BAR;
        PG8_STAGE(PG8_SB(1, 0), cB + kstep, voffB); PG8_STAGE(PG8_SA(1, 0), cA + kstep, voffA); PG8_STAGE(PG8_SB(1, 1), cB + hstep + kstep, voffB);
        PG8_WAIT_V(6); PG8_BAR;
    }
    for (;;) {
        const bool has_next = S.next(ui + 1, nxt);
        const char* nA = has_next ? (const char*)g.A + (size_t)nxt.pm * tstep : cA; const char* nB = has_next ? (const char*)g.Bt + (size_t)nxt.pn * tstep : cB;
        for (int t = 0; t < nt; t += 2) {
            const bool last = (t == nt - 2);
            const char* a1 = cA + (size_t)(t + 1) * kstep;
            const char* a2 = last ? nA : cA + (size_t)(t + 2) * kstep; const char* b2 = last ? nB : cB + (size_t)(t + 2) * kstep;
            const char* a3 = a2 + kstep; const char* b3 = b2 + kstep;
            if (last && has_next) S.a_ready(nxt);
            if constexpr (SP2) {
            PG8_LDB(B0, 0, 0); PG8_LDB(B1, 0, 1); PG8_SCHED; PG8_LDA(At, 0, 0); PG8_STAGE(PG8_SA(1, 1), a1 + hstep, voffA);
            PG8_WAIT_V(8); PG8_WAIT_L(0); PG8_BAR; PG8_MMA(0, 0, At, B0); PG8_MMA(0, 1, At, B1); PG8_BAR; PG8_SCHED;
            PG8_LDA(At, 0, 1); PG8_STAGE(PG8_SB(0, 0), b2, voffB); PG8_STAGE(PG8_SB(0, 1), b2 + hstep, voffB); PG8_STAGE(PG8_SA(0, 0), a2, voffA);
            PG8_WAIT_V(8); PG8_WAIT_L(0); PG8_BAR; PG8_MMA(1, 0, At, B0); PG8_MMA(1, 1, At, B1); PG8_BAR; PG8_SCHED;
            PG8_LDB(B0, 1, 0); PG8_LDB(B1, 1, 1); PG8_SCHED; PG8_LDA(At, 1, 0); PG8_STAGE(PG8_SA(0, 1), a2 + hstep, voffA);
            PG8_WAIT_V(8); PG8_WAIT_L(0); PG8_BAR; PG8_MMA(0, 0, At, B0); PG8_MMA(0, 1, At, B1); PG8_BAR; PG8_SCHED;
            PG8_LDA(At, 1, 1); PG8_STAGE(PG8_SB(1, 0), b3, voffB); PG8_STAGE(PG8_SB(1, 1), b3 + hstep, voffB); PG8_STAGE(PG8_SA(1, 0), a3, voffA);
            PG8_WAIT_V(8); PG8_WAIT_L(0); PG8_BAR; PG8_MMA(1, 0, At, B0); PG8_MMA(1, 1, At, B1); PG8_BAR; PG8_SCHED;
            } else {
            PG8_LDB(B0, 0, 0); PG8_SCHED; PG8_LDA(At, 0, 0); PG8_STAGE(PG8_SA(1, 1), a1 + hstep, voffA);
            PG8_WAIT_L(8); PG8_BAR; PG8_WAIT_L(0); PG8_MMA(0, 0, At, B0); PG8_BAR; PG8_SCHED;
            PG8_LDB(B1, 0, 1); PG8_STAGE(PG8_SB(0, 0), b2, voffB);
            PG8_BAR; PG8_WAIT_L(0); PG8_MMA(0, 1, At, B1); PG8_BAR;
            PG8_LDA(At, 0, 1); PG8_STAGE(PG8_SA(0, 0), a2, voffA);
            PG8_BAR; PG8_WAIT_L(0); PG8_MMA(1, 0, At, B0); PG8_BAR; PG8_SCHED;
            PG8_STAGE(PG8_SB(0, 1), b2 + hstep, voffB);
            PG8_WAIT_V(6); PG8_BAR; PG8_MMA(1, 1, At, B1); PG8_BAR;
            PG8_LDB(B0, 1, 0); PG8_SCHED; PG8_LDA(At, 1, 0); PG8_STAGE(PG8_SA(0, 1), a2 + hstep, voffA);
            PG8_WAIT_L(8); PG8_BAR; PG8_WAIT_L(0); PG8_MMA(0, 0, At, B0); PG8_BAR; PG8_SCHED;
            PG8_LDB(B1, 1, 1); PG8_STAGE(PG8_SB(1, 0), b3, voffB);
            PG8_BAR; PG8_WAIT_L(0); PG8_MMA(0, 1, At, B1); PG8_BAR;
            PG8_LDA(At, 1, 1); PG8_STAGE(PG8_SA(1, 0), a3, voffA);
            PG8_BAR; PG8_WAIT_L(0); PG8_MMA(1, 0, At, B0); PG8_BAR; PG8_SCHED;
            PG8_STAGE(PG8_SB(1, 1), b3 + hstep, voffB);
            PG8_WAIT_V(6); PG8_BAR; PG8_MMA(1, 1, At, B1); PG8_BAR;
            }
        }
        if constexpr (ALIGN_EPI) { if (wr == 0) PG8_BAR; }
        if constexpr (!Epi::AFTER_DRAIN) { E(acc, cur, wr, wc, fr, fq); S.done(cur); }
        if (!has_next) break;
#pragma unroll
        for (int a = 0; a < 2; ++a)
#pragma unroll
            for (int b = 0; b < 2; ++b)
#pragma unroll
                for (int m = 0; m < 4; ++m)
#pragma unroll
                    for (int n = 0; n < 2; ++n) acc[a][b][m][n] = (f32x4){0.f, 0.f, 0.f, 0.f};
        cur = nxt; cA = nA; cB = nB; ++ui;
        if constexpr (ALIGN_EPI) { if (wr == 1) PG8_BAR; }
    }
    PG8_WAIT_V(0);
    if constexpr (!ALIGN_EPI) { if (wr == 0) PG8_BAR; }
    PG8_BAR;
    if constexpr (Epi::AFTER_DRAIN) { E.fused(acc, cur, wr, wc, fr, fq, lds, wid, lane); S.done(cur); }
#undef PG8_SA
#undef PG8_SB
#undef PG8_STAGE
#undef PG8_LDA
#undef PG8_LDB
#undef PG8_MMA
#undef PG8_WAIT_V
#undef PG8_WAIT_L
#undef PG8_BAR
#undef PG8_SCHED
}
}

#include <cstdio>
#include <ctime>
#include <cstdlib>
#include <cstring>
#include <cmath>
#include <vector>
#include <algorithm>
#define CK(x) do { hipError_t e_ = (x); if (e_ != hipSuccess) { fprintf(stderr, "HIP %s:%d %s\n", __FILE__, __LINE__, hipGetErrorString(e_)); exit(2); } } while (0)
typedef unsigned short u16;

#endif
#ifndef CPU_TEST
#define XB_TMO      128
#define XB_XCNT(j)  (256  + 64 * (j))
#define XB_XSUB(j)  (1280 + 64 * (j))
#define XB_XGEN(j)  (2304 + 64 * (j))
#define XB_TOP      3328
#define XB_TOPGEN   3392
#define XCD_BAR_WORDS 3456
#define XB_SPIN_CAP (1u << 22)
#define LAS __attribute__((address_space(3)))

__device__ __forceinline__ unsigned xb_ld(unsigned* p)              { return __hip_atomic_load(p, __ATOMIC_RELAXED, __HIP_MEMORY_SCOPE_AGENT); }
__device__ __forceinline__ unsigned xb_add(unsigned* p, unsigned v) { return __hip_atomic_fetch_add(p, v, __ATOMIC_RELAXED, __HIP_MEMORY_SCOPE_AGENT); }
__device__ __forceinline__ unsigned xb_xcc_id() { return (unsigned)__builtin_amdgcn_s_getreg((3 << 11) | 20) & 0xFu; }
#define XB_SPIN(cond, bar) do { unsigned _sp = 0; while (cond) { __builtin_amdgcn_s_sleep(1); \
    if ((++_sp & 255u) == 0u) { if (xb_ld(&(bar)[XB_TMO])) break; if (_sp > XB_SPIN_CAP) { atomicAdd(&(bar)[XB_TMO], 1u); break; } } } } while (0)

struct XcdBarrier {
    unsigned* bar; unsigned x;
    volatile LAS unsigned* st;
};

__device__ __forceinline__ XcdBarrier xcd_barrier_post(unsigned* bar, volatile LAS unsigned* st) {
    XcdBarrier b; b.bar = bar; b.x = xb_xcc_id(); b.st = st;
    if (threadIdx.x == 0) (void)xb_add(&bar[XB_XCNT(b.x)], 1u);
    return b;
}
__device__ __forceinline__ void xcd_barrier_complete(unsigned* bar, unsigned x, unsigned& nloc, unsigned& nx) {
    const unsigned G = gridDim.x * gridDim.y * gridDim.z;
    unsigned sum, cnt, mine, sp = 0u;
    for (;;) {
        sum = 0u; cnt = 0u; mine = 0u;
#pragma unroll
        for (unsigned j = 0; j < 16; ++j) { const unsigned c = xb_ld(&bar[XB_XCNT(j)]); sum += c; cnt += (c > 0u) ? 1u : 0u; mine = (j == x) ? c : mine; }
        if (sum == G) break;
        __builtin_amdgcn_s_sleep(1);
        if ((++sp & 255u) == 0u) { if (xb_ld(&bar[XB_TMO])) break; if (sp > XB_SPIN_CAP) { atomicAdd(&bar[XB_TMO], 1u); break; } }
    }
    nloc = mine > 0u ? mine : 1u; nx = cnt > 0u ? cnt : 1u;
}

__device__ __forceinline__ void xcd_barrier(const XcdBarrier& b) {
    asm volatile("s_waitcnt vmcnt(0)" ::: "memory");
    __syncthreads();
    if (threadIdx.x == 0) {
        unsigned* bar = b.bar;
        __builtin_amdgcn_s_waitcnt(0);
        unsigned nloc = b.st[0], nx = b.st[1];
        if (nloc == 0u) { xcd_barrier_complete(bar, b.x, nloc, nx); b.st[0] = nloc; b.st[1] = nx; }
        const unsigned old = xb_add(&bar[XB_XSUB(b.x)], 1u);
        const unsigned gen = old / nloc;
        if (old + 1u == (gen + 1u) * nloc) {
            __builtin_amdgcn_fence(__ATOMIC_RELEASE, "agent");
            asm volatile("s_waitcnt vmcnt(0)" ::: "memory");
            const unsigned og = xb_add(&bar[XB_TOP], 1u);
            const unsigned tg = og / nx;
            if (og + 1u == (tg + 1u) * nx) xb_add(&bar[XB_TOPGEN], 1u);
            else XB_SPIN(xb_ld(&bar[XB_TOPGEN]) == tg, bar);
            __builtin_amdgcn_fence(__ATOMIC_ACQUIRE, "agent");
            xb_add(&bar[XB_XGEN(b.x)], 1u);
            asm volatile("s_waitcnt vmcnt(0)" ::: "memory");
        } else {
            XB_SPIN(xb_ld(&bar[XB_XGEN(b.x)]) == gen, bar);
            __builtin_amdgcn_fence(__ATOMIC_ACQUIRE, "agent");
            asm volatile("s_waitcnt vmcnt(0)" ::: "memory");
        }
    }
    __syncthreads();
}

#endif
#ifndef CPU_TEST
namespace att128 {
using bf16 = bf16_t;
constexpr int   D = 128, NW = 8, QBLK = 32, KVBLK = 64;
constexpr float SCALE = 0.088388347648318440f;
constexpr float THR = 8.f;
constexpr int SDEPTH = 2;
constexpr int LDQ = 1536, LDK = 1536, LDO = 1024;
constexpr size_t SHM_V = KVBLK * D * 2, SHM_K = KVBLK * D * 2, SHM_ATTN = 2 * SHM_V + 2 * SHM_K + NW * 64 * 4;
using bf16x8 = __attribute__((ext_vector_type(8))) short;
using s16x4  = __attribute__((ext_vector_type(4))) short;
using f32x16 = __attribute__((ext_vector_type(16))) float;
using f32x8  = __attribute__((ext_vector_type(8))) float;
using u32x4  = __attribute__((ext_vector_type(4))) unsigned;
#define KSWZ(row, colB) ((row) * 256 + ((colB) ^ (((row) & 7) << 4)))
#define SBAR() __builtin_amdgcn_sched_barrier(0)
__device__ __forceinline__ int crow(int r, int hi) { return (r & 3) + 8 * (r >> 2) + 4 * hi; }
__device__ __forceinline__ unsigned cvtpk(float lo, float hi) {
  unsigned r; asm volatile("v_cvt_pk_bf16_f32 %0, %1, %2" : "=v"(r) : "v"(lo), "v"(hi)); return r;
}
template <typename TIn> struct Stage;
template <> struct Stage<bf16>  { using T = bf16x8;
  __device__ static __forceinline__ T ld8(const bf16* p) { return *reinterpret_cast<const bf16x8*>(p); }
  __device__ static __forceinline__ bf16x8 tobf(T x) { return x; } };
template <> struct Stage<float> { using T = f32x8;
  __device__ static __forceinline__ T ld8(const float* p) { return *reinterpret_cast<const f32x8*>(p); }
  __device__ static __forceinline__ bf16x8 tobf(T x) {
    u32x4 w = {cvtpk(x[0], x[1]), cvtpk(x[2], x[3]), cvtpk(x[4], x[5]), cvtpk(x[6], x[7])}; return *reinterpret_cast<bf16x8*>(&w); } };

__device__ __forceinline__ void partialSM(f32x16& p0, f32x16& p1, float& m_reg, float& mn, float& alpha) {
  constexpr float C = SCALE * 1.4426950408889634f;
  float pmax = p0[0]; for (int r = 1; r < 16; ++r) pmax = fmaxf(pmax, p0[r]); for (int r = 0; r < 16; ++r) pmax = fmaxf(pmax, p1[r]);
  { auto rr = __builtin_amdgcn_permlane32_swap(__float_as_uint(pmax), __float_as_uint(pmax), false, false);
    pmax = fmaxf(__uint_as_float(rr[0]), __uint_as_float(rr[1])); }
  if (__builtin_expect(__all(pmax - m_reg <= THR / SCALE), 1)) { mn = m_reg; alpha = 1.f; }
  else { mn = fmaxf(m_reg, pmax); alpha = __builtin_amdgcn_exp2f((m_reg - mn) * C); m_reg = mn; }
  float mnC = -mn * C;
  for (int r = 0; r < 16; ++r) p0[r] = fmaf(p0[r], C, mnC); for (int r = 0; r < 16; ++r) p1[r] = fmaf(p1[r], C, mnC);
  for (int r = 0; r < 16; ++r) p0[r] = __builtin_amdgcn_exp2f(p0[r]);
}
__device__ __forceinline__ void finishSM(f32x16& p0, f32x16& p1, float alpha, float& l_reg, bf16x8& pa0, bf16x8& pa1, bf16x8& pa2, bf16x8& pa3) {
  for (int r = 0; r < 16; ++r) p1[r] = __builtin_amdgcn_exp2f(p1[r]);
  float ps = 0; for (int r = 0; r < 16; ++r) ps += p0[r]; for (int r = 0; r < 16; ++r) ps += p1[r];
  { auto rr = __builtin_amdgcn_permlane32_swap(__float_as_uint(ps), __float_as_uint(ps), false, false);
    ps = __uint_as_float(rr[0]) + __uint_as_float(rr[1]); }
  l_reg = l_reg * alpha + ps;
#define PK4(P, BASE, OUT) do { unsigned a0 = cvtpk(P[BASE + 0], P[BASE + 1]), a1 = cvtpk(P[BASE + 2], P[BASE + 3]);   \
    unsigned b0 = cvtpk(P[BASE + 4], P[BASE + 5]), b1 = cvtpk(P[BASE + 6], P[BASE + 7]);                              \
    auto r0 = __builtin_amdgcn_permlane32_swap(a0, b0, false, false); auto r1 = __builtin_amdgcn_permlane32_swap(a1, b1, false, false); \
    u32x4 w = {r0[0], r1[0], r0[1], r1[1]}; OUT = *reinterpret_cast<bf16x8*>(&w); } while (0)
  PK4(p0, 0, pa0); PK4(p0, 8, pa1); PK4(p1, 0, pa2); PK4(p1, 8, pa3);
#undef PK4
}
__device__ __forceinline__ void qkt(f32x16& p0, f32x16& p1, const bf16* Ks, const bf16x8* qr, int r32, int hi) {
  p0 = f32x16{}; p1 = f32x16{};
  for (int d0 = 0; d0 < 8; ++d0) { int cb = (d0 * 16 + hi * 8) * 2;
    bf16x8 b0 = *reinterpret_cast<const bf16x8*>((const char*)Ks + KSWZ(r32, cb));
    bf16x8 b1 = *reinterpret_cast<const bf16x8*>((const char*)Ks + KSWZ(32 + r32, cb));
    p0 = __builtin_amdgcn_mfma_f32_32x32x16_bf16(b0, qr[d0], p0, 0, 0, 0);
    p1 = __builtin_amdgcn_mfma_f32_32x32x16_bf16(b1, qr[d0], p1, 0, 0, 0); }
}
__device__ __forceinline__ int v_st(int k, int c) { const int kk = (k & ~0xC) | ((k & 4) << 1) | ((k & 8) >> 1); return ((kk >> 3) * 4 + (c >> 5)) * 512 + ((kk & 7) * 32 + (c & 31)) * 2; }
__device__ __forceinline__ int v_rd_base(int lane) { return ((lane & 3) << 3) | (((lane >> 2) & 3) << 6) | (((lane >> 4) & 1) << 5) | (((lane >> 5) & 1) << 8); }
constexpr int v_rd_off(int d0, int ks, int half) { return d0 * 512 + ks * 4096 + half * 2048; }
template <int OFF> __device__ __forceinline__ s16x4 tr_read(int vb) {
  s16x4 r; asm volatile("ds_read_b64_tr_b16 %0, %1 offset:%2" : "=&v"(r) : "v"(vb), "i"(OFF) : "memory"); return r;
}
template <int D0> __device__ __forceinline__ void pv_one(f32x16& od, int vb, bf16x8 pa0, bf16x8 pa1, bf16x8 pa2, bf16x8 pa3) {
  const s16x4 l0 = tr_read<v_rd_off(D0, 0, 0)>(vb), h0 = tr_read<v_rd_off(D0, 0, 1)>(vb), l1 = tr_read<v_rd_off(D0, 1, 0)>(vb), h1 = tr_read<v_rd_off(D0, 1, 1)>(vb);
  const s16x4 l2 = tr_read<v_rd_off(D0, 2, 0)>(vb), h2 = tr_read<v_rd_off(D0, 2, 1)>(vb), l3 = tr_read<v_rd_off(D0, 3, 0)>(vb), h3 = tr_read<v_rd_off(D0, 3, 1)>(vb);
  asm volatile("s_waitcnt lgkmcnt(0)" ::: "memory"); SBAR();
#define PK(L, H) (bf16x8){L[0], L[1], L[2], L[3], H[0], H[1], H[2], H[3]}
  od = __builtin_amdgcn_mfma_f32_32x32x16_bf16(pa0, PK(l0, h0), od, 0, 0, 0);
  od = __builtin_amdgcn_mfma_f32_32x32x16_bf16(pa1, PK(l1, h1), od, 0, 0, 0);
  od = __builtin_amdgcn_mfma_f32_32x32x16_bf16(pa2, PK(l2, h2), od, 0, 0, 0);
  od = __builtin_amdgcn_mfma_f32_32x32x16_bf16(pa3, PK(l3, h3), od, 0, 0, 0);
#undef PK
}
__device__ __forceinline__ void pv_d0(f32x16* o, int vb, bf16x8 pa0, bf16x8 pa1, bf16x8 pa2, bf16x8 pa3) {
  pv_one<0>(o[0], vb, pa0, pa1, pa2, pa3); pv_one<1>(o[1], vb, pa0, pa1, pa2, pa3); pv_one<2>(o[2], vb, pa0, pa1, pa2, pa3); pv_one<3>(o[3], vb, pa0, pa1, pa2, pa3);
}

template <typename TQ>
__device__ __forceinline__ void attn_dense_body(const TQ* __restrict__ Qb, const bf16* __restrict__ Kh, const bf16* __restrict__ Vh, const bf16* __restrict__ Kc, const bf16* __restrict__ Vc,
                                                bf16* __restrict__ Ob, int seq, char* lds) {
  using St = Stage<bf16>; using SQ = Stage<TQ>;
  const int tid = threadIdx.x, wid = tid >> 6, lane = tid & 63, r32 = lane & 31, hi = lane >> 5;
  bf16* V_lds = (bf16*)lds; bf16* K_lds = (bf16*)(lds + 2 * SHM_V);
  float* ws = (float*)(lds + 2 * SHM_V + 2 * SHM_K) + wid * 64; float* li_l = ws; float* al_l = ws + 32;
  float m_reg = -1e30f, l_reg = 0; f32x16 o[4] = {}; bf16x8 qr[8];
  const TQ* Qw = Qb + (long)(wid * QBLK + r32) * LDQ + hi * 8;
#pragma unroll
  for (int d0 = 0; d0 < 8; ++d0) qr[d0] = SQ::tobf(SQ::ld8(Qw + d0 * 16));
  const int sr = tid >> 4, sc = (tid & 15) * 8, vst0 = v_st(sr, sc), vst1 = v_st(32 + sr, sc);
  const int vb0 = (int)(uintptr_t)V_lds + v_rd_base(lane);
  struct { typename St::T vs0, vs1, ks0, ks1; } sr_[SDEPTH];
#define SLOAD(i, k0) do { const int k0_ = (k0); const bf16* Vt_ = k0_ < SEQ ? Vh + (long)k0_ * LDK : Vc + (long)(k0_ - SEQ) * LDK; const bf16* Kt_ = k0_ < SEQ ? Kh + (long)k0_ * LDK : Kc + (long)(k0_ - SEQ) * LDK; \
    sr_[i].vs0 = St::ld8(&Vt_[(long)(sr) * LDK + sc]); sr_[i].vs1 = St::ld8(&Vt_[(long)(32 + sr) * LDK + sc]); \
    sr_[i].ks0 = St::ld8(&Kt_[(long)(sr) * LDK + sc]); sr_[i].ks1 = St::ld8(&Kt_[(long)(32 + sr) * LDK + sc]); } while (0)
#define SWRITE(b, i) do { *(bf16x8*)((char*)V_lds + (b) * SHM_V + vst0) = St::tobf(sr_[i].vs0);          \
    *(bf16x8*)((char*)V_lds + (b) * SHM_V + vst1) = St::tobf(sr_[i].vs1); int kc = sc * 2;               \
    *(bf16x8*)((char*)K_lds + (b) * SHM_K + KSWZ(sr, kc)) = St::tobf(sr_[i].ks0);                       \
    *(bf16x8*)((char*)K_lds + (b) * SHM_K + KSWZ(32 + sr, kc)) = St::tobf(sr_[i].ks1); } while (0)
#define SWAIT() do { if constexpr (SDEPTH == 2) asm volatile("s_waitcnt vmcnt(4)" ::: "memory"); else asm volatile("s_waitcnt vmcnt(0)" ::: "memory"); } while (0)
#define RESC(a) do { if (__any((a) < 1.f)) { if (hi == 0) al_l[r32] = (a); asm volatile("s_waitcnt lgkmcnt(0)" ::: "memory"); \
    for (int d = 0; d < 4; ++d) for (int r = 0; r < 16; ++r) o[d][r] *= al_l[crow(r, hi)]; } } while (0)
  f32x16 pA0, pA1, pB0, pB1; float mnA, mnB, alA, alB; bf16x8 pa0, pa1, pa2, pa3; const int NT = seq / KVBLK;
  constexpr int SE = 0, SO = SDEPTH - 1;
  SLOAD(SE, 0); asm volatile("s_waitcnt vmcnt(0)" ::: "memory"); SWRITE(0, SE); __syncthreads();
  qkt(pA0, pA1, K_lds, qr, r32, hi); partialSM(pA0, pA1, m_reg, mnA, alA);
  SLOAD(SO, KVBLK); if constexpr (SDEPTH == 2) { if (2 < NT) SLOAD(SE, 2 * KVBLK); }
  SWAIT(); SWRITE(1, SO); __syncthreads();
  for (int j = 1; j + 1 < NT; j += 2) {
    SBAR(); qkt(pB0, pB1, (bf16*)((char*)K_lds + SHM_K), qr, r32, hi);
    finishSM(pA0, pA1, alA, l_reg, pa0, pa1, pa2, pa3); SBAR();
    SLOAD(SO, (j + SDEPTH) * KVBLK); SBAR();
    pv_d0(o, vb0, pa0, pa1, pa2, pa3); partialSM(pB0, pB1, m_reg, mnB, alB);
    __syncthreads(); SWAIT(); SWRITE(0, SE);
    RESC(alB); __syncthreads();
    SBAR(); qkt(pA0, pA1, K_lds, qr, r32, hi);
    finishSM(pB0, pB1, alB, l_reg, pa0, pa1, pa2, pa3); SBAR();
    if (SDEPTH == 1 || j + 3 < NT) SLOAD(SE, (j + 1 + SDEPTH) * KVBLK); SBAR();
    pv_d0(o, vb0 + (int)SHM_V, pa0, pa1, pa2, pa3); partialSM(pA0, pA1, m_reg, mnA, alA);
    __syncthreads(); SWAIT(); SWRITE(1, SO);
    RESC(alA); __syncthreads();
  }
  SBAR(); qkt(pB0, pB1, (bf16*)((char*)K_lds + SHM_K), qr, r32, hi);
  finishSM(pA0, pA1, alA, l_reg, pa0, pa1, pa2, pa3); SBAR();
  pv_d0(o, vb0, pa0, pa1, pa2, pa3); partialSM(pB0, pB1, m_reg, mnB, alB);
  __syncthreads(); RESC(alB);
  finishSM(pB0, pB1, alB, l_reg, pa0, pa1, pa2, pa3); SBAR();
  pv_d0(o, vb0 + (int)SHM_V, pa0, pa1, pa2, pa3);
  if (hi == 0) li_l[r32] = l_reg; asm volatile("s_waitcnt lgkmcnt(0)" ::: "memory");
  float rli[16];
#pragma unroll
  for (int r = 0; r < 16; ++r) rli[r] = __builtin_amdgcn_rcpf(li_l[crow(r, hi)]);
  bf16* Ow = Ob + (long)(wid * QBLK) * LDO;
#pragma unroll
  for (int r = 0; r < 16; ++r) { int orow = crow(r, hi);
    for (int d0 = 0; d0 < 4; ++d0) Ow[(long)orow * LDO + d0 * 32 + r32] = f2bf(o[d0][r] * rli[r]); }
#undef SLOAD
#undef SWRITE
#undef SWAIT
#undef RESC
}

}
#endif
#ifdef CPU_TEST
constexpr int RL = 1;
DEVFN float row_sum(float v) { return v; }
#else
constexpr int RL = 64;
DEVFN float dppf(float v, const int ctrl) { return ctrl == 0xB1 ? __int_as_float(__builtin_amdgcn_mov_dpp(__float_as_int(v), 0xB1, 0xf, 0xf, true)) : ctrl == 0x4E ? __int_as_float(__builtin_amdgcn_mov_dpp(__float_as_int(v), 0x4E, 0xf, 0xf, true))
    : ctrl == 0x141 ? __int_as_float(__builtin_amdgcn_mov_dpp(__float_as_int(v), 0x141, 0xf, 0xf, true)) : __int_as_float(__builtin_amdgcn_mov_dpp(__float_as_int(v), 0x140, 0xf, 0xf, true)); }
DEVFN int dpp_xor1(int v) { return __builtin_amdgcn_mov_dpp(v, 0xB1, 0xf, 0xf, true); }
DEVFN int dpp_xor2(int v) { return __builtin_amdgcn_mov_dpp(v, 0x4E, 0xf, 0xf, true); }
DEVFN int dpp_xor4(int v) { return __builtin_amdgcn_mov_dpp(__builtin_amdgcn_mov_dpp(v, 0x141, 0xf, 0xf, true), 0x1B, 0xf, 0xf, true); }
DEVFN int dpp_xor8(int v) { return __builtin_amdgcn_mov_dpp(v, 0x128, 0xf, 0xf, true); }
DEVFN float rdl(float v, const int l) { return __int_as_float(__builtin_amdgcn_readlane(__float_as_int(v), l)); }
DEVFN float row_sum(float v) {
    v += dppf(v, 0xB1); v += dppf(v, 0x4E); v += dppf(v, 0x141); v += dppf(v, 0x140);
    { auto rr = __builtin_amdgcn_permlane16_swap(__float_as_uint(v), __float_as_uint(v), false, false); v = __uint_as_float(rr[0]) + __uint_as_float(rr[1]); }
    { auto rr = __builtin_amdgcn_permlane32_swap(__float_as_uint(v), __float_as_uint(v), false, false); v = __uint_as_float(rr[0]) + __uint_as_float(rr[1]); }
    return v;
}
DEVFN float wave_maxf(float v) {
    v = fmaxf(v, dppf(v, 0xB1)); v = fmaxf(v, dppf(v, 0x4E)); v = fmaxf(v, dppf(v, 0x141)); v = fmaxf(v, dppf(v, 0x140));
    { auto rr = __builtin_amdgcn_permlane16_swap(__float_as_uint(v), __float_as_uint(v), false, false); v = fmaxf(__uint_as_float(rr[0]), __uint_as_float(rr[1])); }
    { auto rr = __builtin_amdgcn_permlane32_swap(__float_as_uint(v), __float_as_uint(v), false, false); v = fmaxf(__uint_as_float(rr[0]), __uint_as_float(rr[1])); }
    return v;
}
#endif
#define WSP(T, off) ((T*)(p.ws + (off)))
DEVFN int modrow(int t) { return t < NX ? t / SEQ : NBAT; }

DEVFN void tr_w(const float* W, int N, bf16_t* Wt, size_t gtid, size_t gsize) {
    for (size_t i = gtid; i < (size_t)N * D; i += gsize) { const int k = (int)(i / N), n = (int)(i % N); Wt[(size_t)n * D + k] = f2bf(W[i]); }
}
DEVFN void ph_pro_a(const Params& p, size_t gtid, size_t gsize) {
    float* modv = WSP(float, WS_MODV);
    for (size_t i = gtid; i < (size_t)DEPTH * NMR * 6144; i += gsize) {
        const int l = (int)(i / (NMR * 6144)), r = (int)((i / 6144) % NMR), c = (int)(i % 6144);
        const float* cv = r < NBAT ? p.c + (size_t)r * D : p.c_ctx;
        const float* w = p.mod_w + (size_t)l * D * 6144 + c;
        float s = 0.f;
        for (int k = 0; k < D; ++k) s += siluf_(cv[k]) * w[(size_t)k * 6144];
        modv[i] = s + p.mod_b[l * 6144 + c];
    }
    float* lbv = WSP(float, WS_LBV);
    for (size_t c = gtid; c < (size_t)D; c += gsize) {
        float m = -1e30f;
        for (int j = 0; j < DEPTH + 1; ++j) m = fmaxf(m, p.hgrn_lb[j * D + c]);
        float sum = 0.f;
        for (int j = 0; j < DEPTH + 1; ++j) sum += expf(p.hgrn_lb[j * D + c] - m);
        lbv[c] = expf(p.hgrn_lb[c] - m) / sum;
    }
    tr_w(p.hgrn_w_in, 5120, WSP(bf16_t, WS_WIN0), gtid, gsize);
    tr_w(p.swa_w_in, 1536, WSP(bf16_t, WS_WIN1), gtid, gsize);
    tr_w(p.na_w_in, 3072, WSP(bf16_t, WS_WIN2), gtid, gsize);
    tr_w(p.gqa_w_in, 1536, WSP(bf16_t, WS_WIN3), gtid, gsize);
    tr_w(p.hgrn_w_out, 1024, WSP(bf16_t, WS_WOUT) + (size_t)0 * D * D, gtid, gsize);
    tr_w(p.swa_w_out, 1024, WSP(bf16_t, WS_WOUT) + (size_t)1 * D * D, gtid, gsize);
    tr_w(p.na_w_out, 1024, WSP(bf16_t, WS_WOUT) + (size_t)2 * D * D, gtid, gsize);
    tr_w(p.gqa_w_out, 1024, WSP(bf16_t, WS_WOUT) + (size_t)3 * D * D, gtid, gsize);
    for (int l = 0; l < DEPTH; ++l) tr_w(p.peer_wq + (size_t)l * D * 2048, 2048, WSP(bf16_t, WS_WQ) + (size_t)l * 2048 * D, gtid, gsize);
    float* xs = WSP(float, WS_XS);
    for (size_t i = gtid; i < (size_t)NT * D; i += gsize) xs[i] = i < (size_t)NX * D ? p.x[i] : p.ctx[i - (size_t)NX * D];
}
DEVFN void ph_h0(const Params& p, size_t gtid, size_t gsize) {
    const float* xs = WSP(float, WS_XS); const float* modv = WSP(float, WS_MODV); bf16_t* hb = WSP(bf16_t, WS_HB);
    for (size_t i = gtid; i < (size_t)NT * D; i += gsize) {
        const int t = (int)(i / D), c = (int)(i % D);
        const float* m = modv + (size_t)(0 * NMR + modrow(t)) * 6144;
        hb[i] = f2bf(xs[i] * (1.f + m[D + c]) + m[c]);
    }
}
#ifdef CPU_TEST
DEVFN void cpu_gemm(const bf16_t* A, const bf16_t* Bt, int M, int N, int K, bf16_t* ob, float* of, int ldc, size_t gtid, size_t gsize) {
    for (size_t i = gtid; i < (size_t)M * N; i += gsize) {
        const int m = (int)(i / N), n = (int)(i % N); float s = 0.f;
        for (int k = 0; k < K; ++k) s += bf2f(A[(size_t)m * K + k]) * bf2f(Bt[(size_t)n * K + k]);
        if (ob) ob[(size_t)m * ldc + n] = f2bf(s); else of[(size_t)m * ldc + n] = s;
    }
}
#endif

DEVFN void ph_swa_rope(const Params& p, size_t gtid, size_t gsize) {
    bf16_t* Z = WSP(bf16_t, WS_Z); constexpr int LDZ = 1536;
    for (size_t i = gtid; i < (size_t)NX * 20 * 32; i += gsize) {
        const int pi = (int)(i % 32), hh = (int)((i / 32) % 20), t = (int)(i / (32 * 20));
        const int s = t % SEQ, a = pi >> 4, fi = pi & 15;
        const float pos = a == 0 ? (float)(s / GW) : (float)(s % GW);
        const float inv = expf(-(float)(2 * fi) / 32.f * LN_THETA);
        const float ang = pos * inv, cs = cosf(ang), sn = sinf(ang);
        bf16_t* zp = Z + (size_t)t * LDZ + hh * 64 + a * 32 + fi;
        const float x1 = bf2f(zp[0]), x2 = bf2f(zp[16]);
        zp[0] = f2bf(x1 * cs - x2 * sn); zp[16] = f2bf(x2 * cs + x1 * sn);
    }
}
DEVFN void ph_gqa_prep(const Params& p, size_t gtid, size_t gsize) {
    bf16_t* Z = WSP(bf16_t, WS_Z); constexpr int LDZ = 1536;
    for (size_t i = gtid; i < (size_t)NT * 10; i += gsize) {
        const int hh = (int)(i % 10), t = (int)(i / 10);
        bf16_t* zp = Z + (size_t)t * LDZ + hh * 128;
        const float* g = hh < 8 ? p.gqa_q_norm : p.gqa_k_norm;
        float ss = 0.f;
        for (int d = 0; d < 128; ++d) { const float v = bf2f(zp[d]); ss += v * v; }
        const float r = 1.f / sqrtf(ss * (1.f / 128.f) + RMS_EPS);
        if (t < NX) {
            const int s = t % SEQ;
            for (int a = 0; a < 2; ++a) {
                const float pos = a == 0 ? (float)(s / GW) : (float)(s % GW);
                for (int fi = 0; fi < 32; ++fi) {
                    const int d1 = a * 64 + fi, d2 = d1 + 32;
                    const float inv = expf(-(float)(2 * fi) / 64.f * LN_THETA);
                    const float ang = pos * inv, cs = cosf(ang), sn = sinf(ang);
                    const float x1 = bf2f(zp[d1]) * r * g[d1], x2 = bf2f(zp[d2]) * r * g[d2];
                    zp[d1] = f2bf(x1 * cs - x2 * sn); zp[d2] = f2bf(x2 * cs + x1 * sn);
                }
            }
        } else {
            for (int d = 0; d < 128; ++d) zp[d] = f2bf(bf2f(zp[d]) * r * g[d]);
        }
    }
}

template <int DH, int DCH>
DEVFN void att_key(const float (&q)[DH], float (&acc)[DCH], float& m, float& l, const bf16_t* kp, const bf16_t* vp, float scale, float bias) {
    float s = 0.f;
#pragma unroll
    for (int d = 0; d < DH; ++d) s += q[d] * bf2f(kp[d]);
    s = s * scale + bias;
    const float mn = fmaxf(m, s), a = expf(m - mn), pw = expf(s - mn);
    l = l * a + pw;
#pragma unroll
    for (int d = 0; d < DCH; ++d) acc[d] = acc[d] * a + pw * bf2f(vp[d]);
    m = mn;
}
DEVFN void ph_swa_attn(const Params& p, size_t gtid, size_t gsize) {
    const bf16_t* Z = WSP(bf16_t, WS_Z); bf16_t* att = WSP(bf16_t, WS_ATT); constexpr int LDZ = 1536;
    for (size_t i = gtid; i < (size_t)NT * 16; i += gsize) {
        const int hq = (int)(i % 16), t = (int)(i / 16), kvh = hq / 4;
        float q[64], acc[64]; float m = -1e30f, l = 0.f;
#pragma unroll
        for (int d = 0; d < 64; ++d) { q[d] = bf2f(Z[(size_t)t * LDZ + hq * 64 + d]); acc[d] = 0.f; }
        int b;
        if (t < NX) {
            b = t / SEQ; const int s = t % SEQ, lo = imax(0, s - 128), hi = imin(SEQ - 1, s + 128);
            for (int kp = lo; kp <= hi; ++kp) { const bf16_t* zr = Z + (size_t)(b * SEQ + kp) * LDZ; att_key<64, 64>(q, acc, m, l, zr + 1024 + kvh * 64, zr + 1280 + kvh * 64, 0.125f, 0.f); }
        } else b = (t - NX) / CL;
        for (int j = 0; j < CL; ++j) { const bf16_t* zr = Z + (size_t)(NX + b * CL + j) * LDZ; att_key<64, 64>(q, acc, m, l, zr + 1024 + kvh * 64, zr + 1280 + kvh * 64, 0.125f, 0.f); }
        const float sk = p.swa_sink[hq], mn = fmaxf(m, sk), a = expf(m - mn); l = l * a + expf(sk - mn);
        const float sc = a / l;
#pragma unroll
        for (int d = 0; d < 64; ++d) att[(size_t)t * D + hq * 64 + d] = f2bf(acc[d] * sc);
    }
}
DEVFN void ph_na_attn(const Params& p, size_t gtid, size_t gsize) {
    const bf16_t* Z = WSP(bf16_t, WS_Z); bf16_t* att = WSP(bf16_t, WS_ATT); constexpr int LDZ = 3072;
    for (size_t i = gtid; i < (size_t)NT * 16; i += gsize) {
        const int hq = (int)(i % 16), t = (int)(i / 16);
        float q[64], acc[64]; float m = -1e30f, l = 0.f;
#pragma unroll
        for (int d = 0; d < 64; ++d) { q[d] = bf2f(Z[(size_t)t * LDZ + hq * 64 + d]); acc[d] = 0.f; }
        int b;
        if (t < NX) {
            b = t / SEQ; const int s = t % SEQ, r = s / GW, c = s % GW;
            const int rstart = iclamp(r - 4, 0, NROWS - 8), cstart = iclamp(c - 8, 0, GW - 16);
            for (int ii = 0; ii < 8; ++ii)
                for (int jj = 0; jj < 16; ++jj) {
                    const int kr = rstart + ii, kc = cstart + jj;
                    const bf16_t* zr = Z + (size_t)(b * SEQ + kr * GW + kc) * LDZ;
                    const float bias = p.na_rpb[(hq * 15 + (kr - r + 7)) * 31 + (kc - c + 15)];
                    att_key<64, 64>(q, acc, m, l, zr + 1024 + hq * 64, zr + 2048 + hq * 64, 0.125f, bias);
                }
        } else b = (t - NX) / CL;
        for (int j = 0; j < CL; ++j) { const bf16_t* zr = Z + (size_t)(NX + b * CL + j) * LDZ; att_key<64, 64>(q, acc, m, l, zr + 1024 + hq * 64, zr + 2048 + hq * 64, 0.125f, 0.f); }
        const float sc = 1.f / l;
#pragma unroll
        for (int d = 0; d < 64; ++d) att[(size_t)t * D + hq * 64 + d] = f2bf(acc[d] * sc);
    }
}
DEVFN void ph_gqa_attn(const Params& p, size_t gtid, size_t gsize) {
    const bf16_t* Z = WSP(bf16_t, WS_Z); bf16_t* att = WSP(bf16_t, WS_ATT); constexpr int LDZ = 1536;
    for (size_t i = gtid; i < (size_t)NX * 32; i += gsize) {
        const int ch = (int)(i % 4), hq = (int)((i / 4) % 8), t = (int)(i / 32), kvh = hq / 4, b = t / SEQ;
        float q[128], acc[32]; float m = -1e30f, l = 0.f;
#pragma unroll
        for (int d = 0; d < 128; ++d) q[d] = bf2f(Z[(size_t)t * LDZ + hq * 128 + d]);
#pragma unroll
        for (int d = 0; d < 32; ++d) acc[d] = 0.f;
        for (int kp = 0; kp < SEQ; ++kp) { const bf16_t* zr = Z + (size_t)(b * SEQ + kp) * LDZ; att_key<128, 32>(q, acc, m, l, zr + 1024 + kvh * 128, zr + 1280 + kvh * 128 + ch * 32, 0.08838834764831845f, 0.f); }
        for (int j = 0; j < CL; ++j) { const bf16_t* zr = Z + (size_t)(NX + b * CL + j) * LDZ; att_key<128, 32>(q, acc, m, l, zr + 1024 + kvh * 128, zr + 1280 + kvh * 128 + ch * 32, 0.08838834764831845f, 0.f); }
        const float sc = 1.f / l;
#pragma unroll
        for (int d = 0; d < 32; ++d) att[(size_t)t * D + hq * 128 + ch * 32 + d] = f2bf(acc[d] * sc);
    }
}

DEVFN void ph_hgrn_gates(const Params& p, size_t gtid, size_t gsize) {
    bf16_t* Z = WSP(bf16_t, WS_Z); const float* lbv = WSP(float, WS_LBV); constexpr int LDZ = 5120;
    for (size_t i = gtid; i < (size_t)NT * D; i += gsize) {
        const size_t t = i / D; const int c = (int)(i % D);
        bf16_t* zr = Z + t * LDZ;
        zr[c] = f2bf(siluf_(bf2f(zr[c])));
        const float lb = lbv[c];
        zr[2048 + c] = f2bf((1.f - lb) * sigmoidf_(-bf2f(zr[2048 + c])));
        zr[3072 + c] = f2bf((1.f - lb) * sigmoidf_(-bf2f(zr[3072 + c])));
    }
}
DEVFN void ph_hgrn_scan(const Params& p, size_t gtid, size_t gsize) {
    const bf16_t* Z = WSP(bf16_t, WS_Z); constexpr int LDZ = 5120;
    bf16_t* of = WSP(bf16_t, WS_Y); bf16_t* ob = of + (size_t)NT * D;
    for (size_t i = gtid; i < (size_t)NBAT * 8 * 2 * 128; i += gsize) {
        const int j = (int)(i % 128), dir = (int)((i / 128) % 2), h = (int)((i / 256) % 8), b = (int)(i / 2048);
        float S[128];
#pragma unroll
        for (int k = 0; k < 128; ++k) S[k] = 0.f;
        bf16_t* od = dir ? ob : of;
        for (int step = 0; step < CL + SEQ; ++step) {
            int t;
            if (step < CL) t = NX + b * CL + (dir ? CL - 1 - step : step);
            else { const int s = step - CL; t = b * SEQ + (dir ? SEQ - 1 - s : s); }
            const bf16_t* zr = Z + (size_t)t * LDZ;
            const float vj = bf2f(zr[1024 + h * 128 + j]);
            const bf16_t* kr = zr + (dir ? 3072 : 2048) + h * 128; const bf16_t* qr = zr + h * 128;
            float o = 0.f;
#pragma unroll
            for (int k = 0; k < 128; ++k) {
                const float kk = bf2f(kr[k]);
                S[k] = (1.f - kk) * S[k] + kk * vj;
                o += bf2f(qr[k]) * S[k];
            }
            od[(size_t)t * D + h * 128 + j] = f2bf(o);
        }
    }
}
DEVFN void ph_hgrn_readout(const Params& p, size_t gtid, size_t gsize) {
    const bf16_t* Z = WSP(bf16_t, WS_Z); constexpr int LDZ = 5120;
    const bf16_t* of = WSP(bf16_t, WS_Y); const bf16_t* ob = of + (size_t)NT * D; bf16_t* att = WSP(bf16_t, WS_ATT);
    const int lane = (int)(gtid % RL);
    for (size_t it = gtid / RL; it < (size_t)NT * 8; it += gsize / RL) {
        const int h = (int)(it % 8), t = (int)(it / 8);
        const size_t base = (size_t)t * D + h * 128;
        float ss = 0.f;
        for (int k = lane; k < 128; k += RL) { const float o = bf2f(of[base + k]) + bf2f(ob[base + k]); ss += o * o; }
        ss = row_sum(ss);
        const float r = 1.f / sqrtf(ss * (1.f / 128.f) + RMS_EPS);
        for (int k = lane; k < 128; k += RL) {
            const float o = bf2f(of[base + k]) + bf2f(ob[base + k]);
            const float g = bf2f(Z[(size_t)t * LDZ + 4096 + h * 128 + k]);
            att[base + k] = f2bf(o * r * p.hgrn_norm_g[k] * siluf_(g));
        }
    }
}

DEVFN void ph_ln(const Params& p, int l, int which, int M, size_t gtid, size_t gsize) {
    float* xs = WSP(float, WS_XS); const float* Y = WSP(float, WS_Y); const float* modv = WSP(float, WS_MODV); bf16_t* hb = WSP(bf16_t, WS_HB);
    const int lane = (int)(gtid % RL);
    const float* g = p.ln_g + (size_t)(l * 2 + which) * D; const float* bb = p.ln_b + (size_t)(l * 2 + which) * D;
    for (size_t t = gtid / RL; t < (size_t)M; t += gsize / RL) {
        const float* m = modv + (size_t)(l * NMR + modrow((int)t)) * 6144; const float* gate = m + (which == 0 ? 2 * D : 5 * D);
        float* xr = xs + t * D; const float* yr = Y + t * D;
        float mu = 0.f;
        for (int c = lane; c < D; c += RL) mu += ALPHA * xr[c] + gate[c] * yr[c];
        mu = row_sum(mu) * (1.f / D);
        float var = 0.f;
        for (int c = lane; c < D; c += RL) { const float d = ALPHA * xr[c] + gate[c] * yr[c] - mu; var += d * d; }
        var = row_sum(var) * (1.f / D);
        const float rstd = 1.f / sqrtf(var + LN_EPS);
        const float* m2 = modv + (size_t)((l + 1 < DEPTH ? l + 1 : l) * NMR + modrow((int)t)) * 6144;
        for (int c = lane; c < D; c += RL) {
            const float v = (ALPHA * xr[c] + gate[c] * yr[c] - mu) * rstd * g[c] + bb[c];
            xr[c] = v;
            if (which == 0) hb[t * D + c] = f2bf(v * (1.f + m[4 * D + c]) + m[3 * D + c]);
            else if (l + 1 < DEPTH) hb[t * D + c] = f2bf(v * (1.f + m2[D + c]) + m2[c]);
            else if (t < (size_t)NX) p.out[t * D + c] = v;
        }
    }
}

DEVFN void ph_peer_scores(const Params& p, int l, int M, size_t gtid, size_t gsize) {
    const bf16_t* qp = WSP(bf16_t, WS_QP); float* sv = WSP(float, WS_SV); int* si = WSP(int, WS_SI);
    for (size_t i = gtid; i < (size_t)M * 16; i += gsize) {
        const int hp = (int)(i / M), t = (int)(i % M);
        const bf16_t* qr = qp + (size_t)t * 2048 + hp * 128;
        const float* kb = p.peer_keys + ((size_t)l * 16 + hp) * 128 * 128;
        float tv[16]; int ti[16];
#pragma unroll
        for (int j = 0; j < 16; ++j) { tv[j] = -3.0e38f; ti[j] = 0; }
        for (int n = 0; n < 128; ++n) {
            float s = 0.f;
            for (int d = 0; d < 128; ++d) s += bf2f(qr[d]) * kb[n * 128 + d];
            int ni = n;
#pragma unroll
            for (int j = 0; j < 16; ++j) if (s > tv[j]) { const float ts = tv[j]; tv[j] = s; s = ts; const int tn = ti[j]; ti[j] = ni; ni = tn; }
        }
#pragma unroll
        for (int j = 0; j < 16; ++j) { sv[((size_t)t * 16 + hp) * 16 + j] = tv[j]; si[((size_t)t * 16 + hp) * 16 + j] = ti[j]; }
    }
}
DEVFN void ph_peer_combine(const Params& p, int M, size_t gtid, size_t gsize) {
    const float* sv = WSP(float, WS_SV); const int* si = WSP(int, WS_SI); int* idx = WSP(int, WS_IDX); float* gate = WSP(float, WS_GATE);
    for (size_t i = gtid; i < (size_t)M * 8; i += gsize) {
        const int h = (int)(i % 8), t = (int)(i / 8);
        const float* s0 = sv + ((size_t)t * 16 + h * 2) * 16; const float* s1 = s0 + 16;
        const int* i0 = si + ((size_t)t * 16 + h * 2) * 16; const int* i1 = i0 + 16;
        float tv[16]; int ti[16];
#pragma unroll
        for (int j = 0; j < 16; ++j) { tv[j] = -3.0e38f; ti[j] = 0; }
        for (int a = 0; a < 16; ++a)
            for (int b = 0; b < 16; ++b) {
                float s = s0[a] + s1[b]; int ni = i0[a] * 128 + i1[b];
#pragma unroll
                for (int j = 0; j < 16; ++j) if (s > tv[j]) { const float ts = tv[j]; tv[j] = s; s = ts; const int tn = ti[j]; ti[j] = ni; ni = tn; }
            }
        float sum = 0.f;
#pragma unroll
        for (int j = 0; j < 16; ++j) sum += expf(tv[j] - tv[0]);
#pragma unroll
        for (int j = 0; j < 16; ++j) { idx[(size_t)t * 128 + h * 16 + j] = ti[j]; gate[(size_t)t * 128 + h * 16 + j] = expf(tv[j] - tv[0]) / sum; }
    }
}
DEVFN void ph_peer_act(const Params& p, int l, int M, size_t gtid, size_t gsize) {
    const int* idx = WSP(int, WS_IDX); const float* gate = WSP(float, WS_GATE); float* wa = WSP(float, WS_WA); const bf16_t* hb = WSP(bf16_t, WS_HB);
    const float* U = p.peer_u + (size_t)l * PEER_N * D;
    const int lane = (int)(gtid % RL);
    for (size_t it = gtid / RL; it < (size_t)M * 128; it += gsize / RL) {
        const size_t t = it / 128; const float* ur = U + (size_t)idx[it] * D; const bf16_t* hr = hb + t * D;
        float s = 0.f;
        for (int c = lane; c < D; c += RL) s += bf2f(hr[c]) * ur[c];
        s = row_sum(s);
        if (lane == 0) wa[it] = gate[it] * geluf_(s);
    }
}
DEVFN void ph_peer_out(const Params& p, int l, int M, size_t gtid, size_t gsize) {
    const int* idx = WSP(int, WS_IDX); const float* wa = WSP(float, WS_WA); float* y = WSP(float, WS_Y);
    const float* V = p.peer_v + (size_t)l * PEER_N * D;
    for (size_t i = gtid; i < (size_t)M * D; i += gsize) {
        const size_t t = i / D; const int d = (int)(i % D);
        float s = 0.f;
        for (int j = 0; j < 128; ++j) s += wa[t * 128 + j] * V[(size_t)idx[t * 128 + j] * D + d];
        y[i] = s;
    }
}
#ifndef CPU_TEST
DEVFN void ph_gqa_attn_mfma(const Params& p, char* lds, int bid, int G) {
    const bf16_t* Z = WSP(const bf16_t, WS_Z); bf16_t* att = WSP(bf16_t, WS_ATT);
    constexpr int NQB = SEQ / 256, LDZ = 1536;
    const bool xaff = (G & 7) == 0;
    for (int v = xaff ? (bid >> 3) : bid; v < (xaff ? NBAT * 8 * NQB / 8 : NBAT * 8 * NQB); v += xaff ? (G >> 3) : G) {
        const int u = xaff ? ((v / (4 * NQB)) * 8 + (bid & 7)) * (4 * NQB) + v % (4 * NQB) : v;
        const int qb = u % NQB, hq4 = (u / NQB) & 3, pair = u / (4 * NQB), b = pair >> 1, kvh = pair & 1, hq = kvh * 4 + hq4;
        const bf16_t* Qb = Z + (size_t)(b * SEQ + qb * 256) * LDZ + hq * 128;
        const bf16_t* Kh = Z + (size_t)(b * SEQ) * LDZ + 1024 + kvh * 128; const bf16_t* Vh = Kh + 256;
        const bf16_t* Kc = Z + (size_t)(NX + b * CL) * LDZ + 1024 + kvh * 128; const bf16_t* Vc = Kc + 256;
        att128::attn_dense_body<bf16_t>(Qb, Kh, Vh, Kc, Vc, att + (size_t)(b * SEQ + qb * 256) * D + hq * 128, SEQ + CL, lds);
        __syncthreads();
    }
}
#endif
#ifndef CPU_TEST
typedef float f32x2_t __attribute__((ext_vector_type(2)));
typedef unsigned u32x2_t __attribute__((ext_vector_type(2)));
typedef unsigned u32x4_t __attribute__((ext_vector_type(4)));
typedef float f32x4_t __attribute__((ext_vector_type(4)));
DEVFN float wave_max(float v) {
#pragma unroll
    for (int o = 1; o < 64; o <<= 1) v = fmaxf(v, __shfl_xor(v, o));
    return v;
}
DEVFN void ph_cvt_uv_fp8(const Params& p, LAS unsigned char* lds, int tid, int bid, int G) {
    const int lane = tid & 63, wv = __builtin_amdgcn_readfirstlane(tid >> 6);
    unsigned char* dst = WSP(unsigned char, WS_UV8); float* scl = WSP(float, WS_UVS);
    LAS unsigned* img = (LAS unsigned*)(lds + wv * 1024);
    for (int r = wv * G + bid; r < 8 * PEER_N; r += G * 8) {
        const int tb = r / PEER_N, l = tb >> 1, which = tb & 1, e = r % PEER_N;
        const f32x4_t* src = (const f32x4_t*)((which ? p.peer_v : p.peer_u) + ((size_t)l * PEER_N + e) * D) + lane;
        f32x4_t a[4];
#pragma unroll
        for (int j = 0; j < 4; ++j) a[j] = src[64 * j];
        if (which) {
            float ss = 0.f;
#pragma unroll
            for (int j = 0; j < 4; ++j) ss += (a[j].x * a[j].x + a[j].y * a[j].y) + (a[j].z * a[j].z + a[j].w * a[j].w);
            ss = row_sum(ss);
            const float rms = sqrtf(ss * (1.f / D)), sc = rms > 0.f ? 2.f / rms : 0.f;
#pragma unroll
            for (int j = 0; j < 4; ++j) {
                unsigned w = 0u;
                w = __builtin_amdgcn_cvt_scalef32_pk_fp4_f32(w, a[j].x * sc, a[j].y * sc, 1.0f, 0);
                w = __builtin_amdgcn_cvt_scalef32_pk_fp4_f32(w, a[j].z * sc, a[j].w * sc, 1.0f, 1);
                ((LAS unsigned short*)img)[64 * j + lane] = (unsigned short)w;
            }
            const u32x4_t o = *(const LAS u32x4_t*)((LAS unsigned char*)img + (lane & 31) * 16);
            if (lane < 32) *(u32x4_t*)(dst + (size_t)tb * PEER_N * 1024 + (size_t)(lane >> 3) * PEER_N * 128 + (size_t)e * 128 + (lane & 7) * 16) = o;
            if (lane == 0) scl[((size_t)l * PEER_N + e) * 2 + 1] = rms * 0.5f;
        } else {
            float ss = 0.f;
#pragma unroll
            for (int j = 0; j < 4; ++j) ss += (a[j].x * a[j].x + a[j].y * a[j].y) + (a[j].z * a[j].z + a[j].w * a[j].w);
            ss = row_sum(ss);
            const float step = sqrtf(ss * (1.f / D)) * (2.6f / 8.f), istep = step > 0.f ? 1.f / step : 0.f;
#pragma unroll
            for (int j = 0; j < 4; ++j) {
                unsigned w = 0u;
#pragma unroll
                for (int kk = 0; kk < 4; ++kk) { const int n = (int)fminf(fmaxf(floorf(a[j][kk] * istep), -8.f), 7.f); w |= ((unsigned)n & 15u) << (4 * kk); }
                ((LAS unsigned short*)img)[64 * j + lane] = (unsigned short)w;
            }
            const u32x4_t o = *(const LAS u32x4_t*)((LAS unsigned char*)img + (lane & 31) * 16);
            if (lane < 32) *(u32x4_t*)(dst + (size_t)tb * PEER_N * 1024 + (size_t)(lane >> 3) * PEER_N * 128 + (size_t)e * 128 + (lane & 7) * 16) = o;
            if (lane == 0) scl[((size_t)l * PEER_N + e) * 2] = step * 0.5f;
        }
    }
}
DEVFN float dot16_fp8(const u32x4_t r, const float (&h)[16]) {
    float s0 = 0.f, s1 = 0.f;
#pragma unroll
    for (int i = 0; i < 4; ++i) { const f32x2_t lo = __builtin_amdgcn_cvt_pk_f32_fp8((int)r[i], false), hi = __builtin_amdgcn_cvt_pk_f32_fp8((int)r[i], true);
        s0 = fmaf(lo.x, h[4 * i], s0); s1 = fmaf(lo.y, h[4 * i + 1], s1); s0 = fmaf(hi.x, h[4 * i + 2], s0); s1 = fmaf(hi.y, h[4 * i + 3], s1); }
    return s0 + s1;
}
DEVFN void fma16_fp8(float (&y)[16], const u32x4_t r, const float w) {
#pragma unroll
    for (int i = 0; i < 4; ++i) { const f32x2_t lo = __builtin_amdgcn_cvt_pk_f32_fp8((int)r[i], false), hi = __builtin_amdgcn_cvt_pk_f32_fp8((int)r[i], true);
        y[4 * i] = fmaf(w, lo.x, y[4 * i]); y[4 * i + 1] = fmaf(w, lo.y, y[4 * i + 1]); y[4 * i + 2] = fmaf(w, hi.x, y[4 * i + 2]); y[4 * i + 3] = fmaf(w, hi.y, y[4 * i + 3]); }
}
DEVFN float treduce64(float (&p)[64], int lane) {
#pragma unroll
    for (int i = 0; i < 32; ++i) { auto r = __builtin_amdgcn_permlane32_swap(__float_as_uint(p[i]), __float_as_uint(p[i + 32]), false, false); p[i] = __uint_as_float(r[0]) + __uint_as_float(r[1]); }
#pragma unroll
    for (int i = 0; i < 16; ++i) { auto r = __builtin_amdgcn_permlane16_swap(__float_as_uint(p[i]), __float_as_uint(p[i + 16]), false, false); p[i] = __uint_as_float(r[0]) + __uint_as_float(r[1]); }
#pragma unroll
    for (int i = 0; i < 8; ++i) { const bool up = (lane & 8) != 0; const float keep = up ? p[i + 8] : p[i], send = up ? p[i] : p[i + 8]; p[i] = keep + __shfl_xor(send, 8); }
#pragma unroll
    for (int i = 0; i < 4; ++i) { const bool up = (lane & 4) != 0; const float keep = up ? p[i + 4] : p[i], send = up ? p[i] : p[i + 4]; p[i] = keep + __shfl_xor(send, 4); }
#pragma unroll
    for (int i = 0; i < 2; ++i) { const bool up = (lane & 2) != 0; const float keep = up ? p[i + 2] : p[i], send = up ? p[i] : p[i + 2]; p[i] = keep + __shfl_xor(send, 2); }
    { const bool up = (lane & 1) != 0; const float keep = up ? p[1] : p[0], send = up ? p[0] : p[1]; p[0] = keep + __shfl_xor(send, 1); }
    return p[0];
}
DEVFN float treduce32(float (&p)[32], int lane) {
#pragma unroll
    for (int i = 0; i < 16; ++i) { auto r = __builtin_amdgcn_permlane16_swap(__float_as_uint(p[i]), __float_as_uint(p[i + 16]), false, false); p[i] = __uint_as_float(r[0]) + __uint_as_float(r[1]); }
#pragma unroll
    for (int i = 0; i < 8; ++i) { const bool up = (lane & 8) != 0; const float keep = up ? p[i + 8] : p[i], send = up ? p[i] : p[i + 8]; p[i] = keep + __shfl_xor(send, 8); }
#pragma unroll
    for (int i = 0; i < 4; ++i) { const bool up = (lane & 4) != 0; const float keep = up ? p[i + 4] : p[i], send = up ? p[i] : p[i + 4]; p[i] = keep + __shfl_xor(send, 4); }
#pragma unroll
    for (int i = 0; i < 2; ++i) { const bool up = (lane & 2) != 0; const float keep = up ? p[i + 2] : p[i], send = up ? p[i] : p[i + 2]; p[i] = keep + __shfl_xor(send, 2); }
    { const bool up = (lane & 1) != 0; const float keep = up ? p[1] : p[0], send = up ? p[0] : p[1]; p[0] = keep + __shfl_xor(send, 1); }
    return p[0] + __shfl_xor(p[0], 32);
}
DEVFN void ph_peer_experts(const Params& p, int l, int M, int tid, int bid, int G) {
    const int lane = tid & 63;
    const unsigned char* U8 = WSP(const unsigned char, WS_UV8) + (size_t)(l * 2) * PEER_N * 1024; const unsigned char* V8 = U8 + (size_t)PEER_N * 1024;
    const float* SU = WSP(const float, WS_UVS) + (size_t)(l * 2) * PEER_N; const float* SV = SU + PEER_N;
    const int* idx = WSP(const int, WS_IDX); const float* gate = WSP(const float, WS_GATE);
    float* xs = WSP(float, WS_XS); bf16_t* hb = WSP(bf16_t, WS_HB); const float* modv = WSP(const float, WS_MODV);
    const float* lg0 = p.ln_g + (size_t)(l * 2 + 1) * D + lane * 16; const float* lb0 = p.ln_b + (size_t)(l * 2 + 1) * D + lane * 16;
    for (int t = __builtin_amdgcn_readfirstlane(tid >> 6) * G + bid; t < M; t += G * 8) {
        const float* lg = lg0; const float* lb = lb0;
        asm volatile("" : "+v"(lg), "+v"(lb));
        float h[16];
        { const u32x4_t* hp = (const u32x4_t*)(hb + (size_t)t * D + lane * 16); const u32x4_t h0 = hp[0], h1 = hp[1];
#pragma unroll
          for (int i = 0; i < 4; ++i) { h[2 * i] = __uint_as_float(h0[i] << 16); h[2 * i + 1] = __uint_as_float(h0[i] & 0xffff0000u); h[8 + 2 * i] = __uint_as_float(h1[i] << 16); h[8 + 2 * i + 1] = __uint_as_float(h1[i] & 0xffff0000u); } }
        int eidx[2]; float wgt[2];
#pragma unroll
        for (int half = 0; half < 2; ++half) {
            const int myidx = idx[(size_t)t * 128 + half * 64 + lane]; const float mygate = gate[(size_t)t * 128 + half * 64 + lane];
            const float su = SU[myidx], sv = SV[myidx];
            float dsel = 0.f;
#pragma unroll
            for (int sh = 0; sh < 2; ++sh) {
                float part[32];
#pragma unroll
                for (int g = 0; g < 2; ++g) {
                    u32x4_t r[16];
                    int mi = myidx; asm volatile("" : "+v"(mi));
#pragma unroll
                    for (int j = 0; j < 16; ++j) { const int e = __builtin_amdgcn_readlane(mi, sh * 32 + g * 16 + j); r[j] = *((const u32x4_t*)(U8 + (size_t)e * 1024) + lane); }
                    __builtin_amdgcn_sched_barrier(0);
#pragma unroll
                    for (int j = 0; j < 16; ++j) { part[g * 16 + j] = dot16_fp8(r[j], h); if (j & 1) __builtin_amdgcn_sched_barrier(0); }
                }
                const float rs = treduce32(part, lane);
                dsel = ((lane >> 5) == sh) ? rs : dsel;
            }
            const float dot = dsel * su;
            const float u3 = 1.5957691216057308f * (dot + 0.044715f * dot * dot * dot);
            eidx[half] = myidx; wgt[half] = mygate * sv * dot / (1.f + __expf(-u3));
        }
        __builtin_amdgcn_sched_barrier(0);
        float y[16];
#pragma unroll
        for (int i = 0; i < 16; ++i) y[i] = 0.f;
#pragma unroll
        for (int half = 0; half < 2; ++half) {
#pragma unroll
            for (int g = 0; g < 4; ++g) {
                u32x4_t r[16];
                int mi = eidx[half]; asm volatile("" : "+v"(mi));
#pragma unroll
                for (int j = 0; j < 16; ++j) { const int e = __builtin_amdgcn_readlane(mi, g * 16 + j); r[j] = *((const u32x4_t*)(V8 + (size_t)e * 1024) + lane); }
                __builtin_amdgcn_sched_barrier(0);
#pragma unroll
                for (int j = 0; j < 16; ++j) { const float we = __uint_as_float(__builtin_amdgcn_readlane(__float_as_uint(wgt[half]), g * 16 + j)); fma16_fp8(y, r[j], we); if (j & 1) __builtin_amdgcn_sched_barrier(0); }
            }
        }
        const int mr = modrow(t);
        const float* m = modv + (size_t)(l * NMR + mr) * 6144 + lane * 16;
        float* xr = xs + (size_t)t * D + lane * 16;
        float v[16]; float s = 0.f;
#pragma unroll
        for (int i = 0; i < 4; ++i) { const f32x4_t xv = ((const f32x4_t*)xr)[i], gv = ((const f32x4_t*)(m + 5 * D))[i];
#pragma unroll
            for (int k = 0; k < 4; ++k) { v[4 * i + k] = ALPHA * xv[k] + gv[k] * y[4 * i + k]; s += v[4 * i + k]; } }
        const float mu = row_sum(s) * (1.f / D);
        float q = 0.f;
#pragma unroll
        for (int i = 0; i < 16; ++i) { v[i] -= mu; q += v[i] * v[i]; }
        const float rstd = 1.f / sqrtf(row_sum(q) * (1.f / D) + LN_EPS);
#pragma unroll
        for (int i = 0; i < 4; ++i) { const f32x4_t gg = ((const f32x4_t*)lg)[i], bb = ((const f32x4_t*)lb)[i];
#pragma unroll
            for (int k = 0; k < 4; ++k) v[4 * i + k] = v[4 * i + k] * rstd * gg[k] + bb[k]; }
#pragma unroll
        for (int i = 0; i < 4; ++i) ((f32x4_t*)xr)[i] = (f32x4_t){v[4 * i], v[4 * i + 1], v[4 * i + 2], v[4 * i + 3]};
        if (l + 1 < DEPTH) {
            const float* m2 = modv + (size_t)((l + 1) * NMR + mr) * 6144 + lane * 16;
            u32x4_t o0, o1;
#pragma unroll
            for (int i = 0; i < 4; ++i) { const f32x4_t sh = ((const f32x4_t*)m2)[i], sc = ((const f32x4_t*)(m2 + D))[i];
                const unsigned a = (unsigned)f2bf(v[4 * i] * (1.f + sc[0]) + sh[0]) | ((unsigned)f2bf(v[4 * i + 1] * (1.f + sc[1]) + sh[1]) << 16);
                const unsigned b = (unsigned)f2bf(v[4 * i + 2] * (1.f + sc[2]) + sh[2]) | ((unsigned)f2bf(v[4 * i + 3] * (1.f + sc[3]) + sh[3]) << 16);
                if (i < 2) { o0[2 * i] = a; o0[2 * i + 1] = b; } else { o1[2 * (i - 2)] = a; o1[2 * (i - 2) + 1] = b; } }
            u32x4_t* hp = (u32x4_t*)(hb + (size_t)t * D + lane * 16); hp[0] = o0; hp[1] = o1;
        } else if (t < NX) {
            float* op = p.out + (size_t)t * D + lane * 16;
#pragma unroll
            for (int i = 0; i < 4; ++i) ((f32x4_t*)op)[i] = (f32x4_t){v[4 * i], v[4 * i + 1], v[4 * i + 2], v[4 * i + 3]};
        }
    }
}
#endif
#ifndef CPU_TEST
typedef short bf16x8_t __attribute__((ext_vector_type(8)));
typedef float f32x16_t __attribute__((ext_vector_type(16)));
DEVFN void ph_cvt_keys(const Params& p, size_t gtid, size_t gsize) {
    bf16_t* kb = WSP(bf16_t, WS_KEYS);
    for (size_t i = gtid; i < (size_t)4 * 16 * 128 * 128; i += gsize) kb[i] = f2bf(p.peer_keys[i]);
}
DEVFN void ce1(float& a, float& b) { const float hi = fmaxf(a, b), lo = fminf(a, b); a = hi; b = lo; }
DEVFN void ce2(float& a, int& ia, float& b, int& ib) { const bool sw = b > a; const float ta = sw ? b : a, tb = sw ? a : b; const int ja = sw ? ib : ia, jb = sw ? ia : ib; a = ta; b = tb; ia = ja; ib = jb; }
DEVFN void bsort16(float (&v)[16]) {
#pragma unroll
    for (int k = 2; k <= 16; k <<= 1)
#pragma unroll
        for (int j = k >> 1; j > 0; j >>= 1)
#pragma unroll
            for (int i = 0; i < 16; ++i) { const int l = i ^ j; if (l > i) { if ((i & k) == 0) ce1(v[i], v[l]); else ce1(v[l], v[i]); } }
}
DEVFN void bmerge16(float (&a)[16], const float (&b)[16]) {
#pragma unroll
    for (int i = 0; i < 16; ++i) a[i] = fmaxf(a[i], b[15 - i]);
#pragma unroll
    for (int j = 8; j > 0; j >>= 1)
#pragma unroll
        for (int i = 0; i < 16; ++i) { const int l = i ^ j; if (l > i) ce1(a[i], a[l]); }
}
DEVFN void bsort16p(float (&v)[16], int (&x)[16]) {
#pragma unroll
    for (int k = 2; k <= 16; k <<= 1)
#pragma unroll
        for (int j = k >> 1; j > 0; j >>= 1)
#pragma unroll
            for (int i = 0; i < 16; ++i) { const int l = i ^ j; if (l > i) { if ((i & k) == 0) ce2(v[i], x[i], v[l], x[l]); else ce2(v[l], x[l], v[i], x[i]); } }
}
DEVFN void bmerge16p(float (&a)[16], int (&ia)[16], const float (&b)[16], const int (&ib)[16]) {
#pragma unroll
    for (int i = 0; i < 16; ++i) { const bool sw = b[15 - i] > a[i]; a[i] = sw ? b[15 - i] : a[i]; ia[i] = sw ? ib[15 - i] : ia[i]; }
#pragma unroll
    for (int j = 8; j > 0; j >>= 1)
#pragma unroll
        for (int i = 0; i < 16; ++i) { const int l = i ^ j; if (l > i) ce2(a[i], ia[i], a[l], ia[l]); }
}
DEVFN void peer_top16(float (&top)[16], const bf16_t* qrow  , const bf16_t* kb  , int hi) {
    bf16x8_t qf[8];
#pragma unroll
    for (int ks = 0; ks < 8; ++ks) qf[ks] = *(const bf16x8_t*)(qrow + ks * 16);
    float grp[2][16];
#pragma unroll
    for (int nb = 0; nb < 4; ++nb) {
        f32x16_t acc = {};
#pragma unroll
        for (int ks = 0; ks < 8; ++ks) { const bf16x8_t kf = *(const bf16x8_t*)(kb + (size_t)nb * 32 * 128 + ks * 16); acc = __builtin_amdgcn_mfma_f32_32x32x16_bf16(kf, qf[ks], acc, 0, 0, 0); }
        float v[16];
#pragma unroll
        for (int r = 0; r < 16; ++r) { const unsigned n = (unsigned)(nb * 32 + (r & 3) + 8 * (r >> 2) + 4 * hi); v[r] = __uint_as_float((__float_as_uint(acc[r]) & ~127u) | n); }
        bsort16(v);
        if (nb == 0) {
#pragma unroll
            for (int r = 0; r < 16; ++r) grp[0][r] = v[r];
        } else if (nb == 1) bmerge16(grp[0], v);
        else if (nb == 2) {
#pragma unroll
            for (int r = 0; r < 16; ++r) grp[1][r] = v[r];
        } else { bmerge16(grp[1], v); bmerge16(grp[0], grp[1]); }
        __builtin_amdgcn_sched_barrier(0);
    }
    float oth[16];
#pragma unroll
    for (int r = 0; r < 16; ++r) { auto rr_ = __builtin_amdgcn_permlane32_swap(__float_as_uint(grp[0][r]), __float_as_uint(grp[0][r]), false, false); oth[r] = __uint_as_float(hi ? rr_[0] : rr_[1]); }
    bmerge16(grp[0], oth);
#pragma unroll
    for (int r = 0; r < 16; ++r) top[r] = grp[0][r];
}
DEVFN void ph_peer_route(const Params& p, int l, int M, LAS unsigned char* lds, int tid, int bid, int G) {
    const int lane = tid & 63, hi = lane >> 5, tl = lane & 31;
    const bf16_t* qp = WSP(const bf16_t, WS_QP); const bf16_t* keys = WSP(const bf16_t, WS_KEYS) + (size_t)l * 16 * 128 * 128;
    int* idx = WSP(int, WS_IDX); float* gate = WSP(float, WS_GATE);
    LAS unsigned char* tabl = lds + (tid * 36);
#pragma unroll 1
    for (int item = __builtin_amdgcn_readfirstlane(tid >> 6) * G + bid; item < (M / 32) * 8; item += G * 8) {
        int tile = item >> 3, h = item & 7;
        asm volatile("" : "+s"(tile), "+s"(h));
        const int t = tile * 32 + tl;
        {
            float ta[16], tb[16];
            peer_top16(ta, qp + (size_t)t * 2048 + (h * 2) * 128 + 8 * hi, keys + ((size_t)(h * 2) * 128 + tl) * 128 + 8 * hi, hi);
            __builtin_amdgcn_sched_barrier(0);
            peer_top16(tb, qp + (size_t)t * 2048 + (h * 2 + 1) * 128 + 8 * hi, keys + ((size_t)(h * 2 + 1) * 128 + tl) * 128 + 8 * hi, hi);
#pragma unroll
            for (int j = 0; j < 4; ++j) {
                ((LAS unsigned*)tabl)[j] = (__float_as_uint(ta[4 * j]) & 127u) | ((__float_as_uint(ta[4 * j + 1]) & 127u) << 8) | ((__float_as_uint(ta[4 * j + 2]) & 127u) << 16) | ((__float_as_uint(ta[4 * j + 3]) & 127u) << 24);
                ((LAS unsigned*)tabl)[4 + j] = (__float_as_uint(tb[4 * j]) & 127u) | ((__float_as_uint(tb[4 * j + 1]) & 127u) << 8) | ((__float_as_uint(tb[4 * j + 2]) & 127u) << 16) | ((__float_as_uint(tb[4 * j + 3]) & 127u) << 24);
            }
            float cs[4][16]; int n = 0;
#pragma unroll
            for (int a = 0; a < 16; ++a)
#pragma unroll
                for (int b = 0; b < 16; ++b)
                    if ((a + 1) * (b + 1) <= 16) {
                        const float sm = __uint_as_float(__float_as_uint(ta[a]) & ~127u) + __uint_as_float(__float_as_uint(tb[b]) & ~127u);
                        cs[n >> 4][n & 15] = __uint_as_float((__float_as_uint(sm) & ~255u) | (unsigned)(a * 16 + b)); ++n;
                    }
#pragma unroll
            for (int k = 50; k < 64; ++k) cs[k >> 4][k & 15] = -3.0e38f;
            bsort16(cs[0]); bsort16(cs[1]); bsort16(cs[2]); bsort16(cs[3]);
            bmerge16(cs[0], cs[1]); bmerge16(cs[2], cs[3]); bmerge16(cs[0], cs[2]);
            float e[16], sum = 0.f; const float mx = __uint_as_float(__float_as_uint(cs[0][0]) & ~255u);
#pragma unroll
            for (int j = 0; j < 16; ++j) { e[j] = __expf(__uint_as_float(__float_as_uint(cs[0][j]) & ~255u) - mx); sum += e[j]; }
            const float rs = 1.f / sum;
            if (hi == 0) {
                unsigned id[16];
#pragma unroll
                for (int j = 0; j < 16; ++j) { const unsigned ab = __float_as_uint(cs[0][j]) & 255u; id[j] = (unsigned)tabl[ab >> 4] * 128u + (unsigned)tabl[16 + (ab & 15u)]; }
                u32x4_t* op = (u32x4_t*)(idx + (size_t)t * 128 + h * 16);
#pragma unroll
                for (int j = 0; j < 4; ++j) op[j] = (u32x4_t){id[4 * j], id[4 * j + 1], id[4 * j + 2], id[4 * j + 3]};
            } else {
                f32x4_t* op = (f32x4_t*)(gate + (size_t)t * 128 + h * 16);
#pragma unroll
                for (int j = 0; j < 4; ++j) op[j] = (f32x4_t){e[4 * j] * rs, e[4 * j + 1] * rs, e[4 * j + 2] * rs, e[4 * j + 3] * rs};
            }
        }
    }
}
#endif
#ifndef CPU_TEST
typedef float f32x4v __attribute__((ext_vector_type(4)));
typedef short s16x4v __attribute__((ext_vector_type(4)));
constexpr int GS_QS = 0, GS_KS = 8704, GS_KE = 17408, GS_VT = 27648, GS_D = 37888, GS_GS = 38400, GS_END = 40448;
typedef __bf16 bf16x2_hw __attribute__((ext_vector_type(2)));
DEVFN unsigned pk_bf16(float lo, float hi) { const f32x2_t f = {lo, hi}; return __builtin_bit_cast(unsigned, __builtin_convertvector(f, bf16x2_hw)); }
DEVFN void ph_hgrn_scan_mfma(const Params& p, LAS unsigned char* lds, int tid, int bid) {
    if (bid >= NBAT * 16) return;
    const int dir = bid & 1, h = (bid >> 1) & 7, b = bid >> 4;
    const bf16_t* Z = WSP(const bf16_t, WS_Z); const float* lbv = WSP(const float, WS_LBV); constexpr int LDZ = 5120;
    bf16_t* od = WSP(bf16_t, WS_Y) + (dir ? (size_t)NT * D : 0);
    const int lane = tid & 63, w = tid >> 6, c16 = lane & 15, g = lane >> 4;
    const int pk = tid & 127, ptg = tid >> 7;
    const float lb = lbv[h * 128 + pk];
    constexpr int NCH = (CL + SEQ) / 32;
    f32x4v S[8];
#pragma unroll
    for (int i = 0; i < 8; ++i) S[i] = (f32x4v){0.f, 0.f, 0.f, 0.f};
    auto trow = [&](int s) -> size_t { return s < CL ? (size_t)(NX + b * CL + (dir ? CL - 1 - s : s)) : (size_t)(b * SEQ + (dir ? SEQ - 1 - (s - CL) : s - CL)); };
    unsigned short rq[8], rf[8], rv[8];
#pragma unroll
    for (int i = 0; i < 8; ++i) { const bf16_t* zr = Z + trow(8 * ptg + i) * LDZ + h * 128 + pk; rq[i] = zr[0]; rv[i] = zr[1024]; rf[i] = zr[dir ? 3072 : 2048]; }
#pragma unroll 1
    for (int c = 0; c < NCH; ++c) {
        float qv[8], kk[8], cum[8], vv[8]; float run = 0.f;
#pragma unroll
        for (int i = 0; i < 8; ++i) {
            const float f = lb + (1.f - lb) / (1.f + __expf(-bf2f(rf[i])));
            run += __logf(f); cum[i] = run; kk[i] = 1.f - f;
            const float q = bf2f(rq[i]); qv[i] = q / (1.f + __expf(-q)); vv[i] = bf2f(rv[i]);
        }
        if (c + 1 < NCH) {
#pragma unroll
            for (int i = 0; i < 8; ++i) { const bf16_t* zr = Z + trow((c + 1) * 32 + 8 * ptg + i) * LDZ + h * 128 + pk; rq[i] = zr[0]; rv[i] = zr[1024]; rf[i] = zr[dir ? 3072 : 2048]; }
        }
        ((LAS float*)(lds + GS_GS))[ptg * 128 + pk] = run;
        __syncthreads();
        float off = 0.f, bend = 0.f;
#pragma unroll
        for (int j = 0; j < 4; ++j) { const float gsum = ((LAS float*)(lds + GS_GS))[j * 128 + pk]; off += j < ptg ? gsum : 0.f; bend += gsum; }
        unsigned kew[4], vtw[4];
#pragma unroll
        for (int i = 0; i < 8; ++i) {
            const float B = off + cum[i], eB = __expf(B), eN = __expf(-B), eE = __expf(bend - B);
            const int t = 8 * ptg + i;
            *(LAS bf16_t*)(lds + GS_QS + t * 272 + pk * 2) = f2bf(qv[i] * eB);
            *(LAS bf16_t*)(lds + GS_KS + t * 272 + pk * 2) = f2bf(kk[i] * eN);
            const unsigned ke = f2bf(kk[i] * eE), vt = f2bf(vv[i]);
            if (i & 1) { kew[i >> 1] |= ke << 16; vtw[i >> 1] |= vt << 16; } else { kew[i >> 1] = ke; vtw[i >> 1] = vt; }
        }
        *(LAS u32x4_t*)(lds + GS_KE + pk * 80 + ptg * 16) = (u32x4_t){kew[0], kew[1], kew[2], kew[3]};
        *(LAS u32x4_t*)(lds + GS_VT + pk * 80 + ptg * 16) = (u32x4_t){vtw[0], vtw[1], vtw[2], vtw[3]};
        if (ptg == 0) ((LAS float*)(lds + GS_D))[pk] = __expf(bend);
        __syncthreads();
        f32x4v X00 = {0.f, 0.f, 0.f, 0.f}, X01 = X00, X11 = X00;
#pragma unroll
        for (int ks = 0; ks < 4; ++ks) {
            const bf16x8_t a0 = *(const LAS bf16x8_t*)(lds + GS_KS + c16 * 272 + ks * 64 + g * 16), a1 = *(const LAS bf16x8_t*)(lds + GS_KS + (16 + c16) * 272 + ks * 64 + g * 16);
            const bf16x8_t b0 = *(const LAS bf16x8_t*)(lds + GS_QS + c16 * 272 + ks * 64 + g * 16), b1 = *(const LAS bf16x8_t*)(lds + GS_QS + (16 + c16) * 272 + ks * 64 + g * 16);
            X00 = __builtin_amdgcn_mfma_f32_16x16x32_bf16(a0, b0, X00, 0, 0, 0);
            X01 = __builtin_amdgcn_mfma_f32_16x16x32_bf16(a0, b1, X01, 0, 0, 0);
            X11 = __builtin_amdgcn_mfma_f32_16x16x32_bf16(a1, b1, X11, 0, 0, 0);
        }
#pragma unroll
        for (int r = 0; r < 4; ++r) { const bool keep = (4 * g + r) <= c16; X00[r] = keep ? X00[r] : 0.f; X11[r] = keep ? X11[r] : 0.f; }
        const u32x4_t p0w = (u32x4_t){pk_bf16(X00[0], X00[1]), pk_bf16(X00[2], X00[3]), 0u, 0u};
        const u32x4_t p1w = (u32x4_t){pk_bf16(X01[0], X01[1]), pk_bf16(X01[2], X01[3]), pk_bf16(X11[0], X11[1]), pk_bf16(X11[2], X11[3])};
        const int vrow = (16 * w + c16) * 80;
        const s16x4v vlo = *(const LAS s16x4v*)(lds + GS_VT + vrow + g * 8), vhi = *(const LAS s16x4v*)(lds + GS_VT + vrow + 32 + g * 8);
        const bf16x8_t vperm = (bf16x8_t){vlo[0], vlo[1], vlo[2], vlo[3], vhi[0], vhi[1], vhi[2], vhi[3]};
        f32x4v o0 = {0.f, 0.f, 0.f, 0.f}, o1 = o0;
        o0 = __builtin_amdgcn_mfma_f32_16x16x32_bf16(__builtin_bit_cast(bf16x8_t, p0w), vperm, o0, 0, 0, 0);
        o1 = __builtin_amdgcn_mfma_f32_16x16x32_bf16(__builtin_bit_cast(bf16x8_t, p1w), vperm, o1, 0, 0, 0);
#pragma unroll
        for (int ks = 0; ks < 4; ++ks) {
            const u32x4_t sw = (u32x4_t){pk_bf16(S[2 * ks][0], S[2 * ks][1]), pk_bf16(S[2 * ks][2], S[2 * ks][3]), pk_bf16(S[2 * ks + 1][0], S[2 * ks + 1][1]), pk_bf16(S[2 * ks + 1][2], S[2 * ks + 1][3])};
            const bf16x8_t sb = __builtin_bit_cast(bf16x8_t, sw);
            const s16x4v q0l = *(const LAS s16x4v*)(lds + GS_QS + c16 * 272 + ks * 64 + g * 8), q0h = *(const LAS s16x4v*)(lds + GS_QS + c16 * 272 + ks * 64 + 32 + g * 8);
            const s16x4v q1l = *(const LAS s16x4v*)(lds + GS_QS + (16 + c16) * 272 + ks * 64 + g * 8), q1h = *(const LAS s16x4v*)(lds + GS_QS + (16 + c16) * 272 + ks * 64 + 32 + g * 8);
            o0 = __builtin_amdgcn_mfma_f32_16x16x32_bf16((bf16x8_t){q0l[0], q0l[1], q0l[2], q0l[3], q0h[0], q0h[1], q0h[2], q0h[3]}, sb, o0, 0, 0, 0);
            o1 = __builtin_amdgcn_mfma_f32_16x16x32_bf16((bf16x8_t){q1l[0], q1l[1], q1l[2], q1l[3], q1h[0], q1h[1], q1h[2], q1h[3]}, sb, o1, 0, 0, 0);
        }
#pragma unroll
        for (int r = 0; r < 4; ++r) {
            od[trow(c * 32 + 4 * g + r) * D + h * 128 + 16 * w + c16] = f2bf(o0[r]);
            od[trow(c * 32 + 16 + 4 * g + r) * D + h * 128 + 16 * w + c16] = f2bf(o1[r]);
        }
        const bf16x8_t vb = *(const LAS bf16x8_t*)(lds + GS_VT + vrow + g * 16);
#pragma unroll
        for (int kt = 0; kt < 8; ++kt) {
            const f32x4v dv = *(const LAS f32x4v*)(lds + GS_D + (16 * kt + 4 * g) * 4);
            const bf16x8_t ka = *(const LAS bf16x8_t*)(lds + GS_KE + (16 * kt + c16) * 80 + g * 16);
            S[kt] = __builtin_amdgcn_mfma_f32_16x16x32_bf16(ka, vb, S[kt] * dv, 0, 0, 0);
        }
        __syncthreads();
    }
}
#endif
#ifndef CPU_TEST
constexpr int AW_K = 0, AW_V = 4608, AW_BYTES = 9728;
struct AttW { f32x16_t o0, o1; float m, l; };
DEVFN void attw_load(u32x4_t (&kreg)[4], u32x4_t (&vreg)[4], const bf16_t* kp, const bf16_t* vp) {
#pragma unroll
    for (int i = 0; i < 4; ++i) { kreg[i] = ((const u32x4_t*)kp)[i]; vreg[i] = ((const u32x4_t*)vp)[i]; }
}
template <class F>
DEVFN void attw_tile(AttW& a, const bf16x8_t (&qf)[4], const u32x4_t (&kreg)[4], const u32x4_t (&vreg)[4], LAS unsigned char* wl, int lane, float c2, F bias2) {
    const int krow = lane >> 1, dhalf = lane & 1, q31 = lane & 31, hi = lane >> 5;
#pragma unroll
    for (int i = 0; i < 4; ++i) *(LAS u32x4_t*)(wl + AW_K + krow * 144 + dhalf * 64 + i * 16) = kreg[i];
#pragma unroll
    for (int i = 0; i < 4; ++i)
#pragma unroll
        for (int e = 0; e < 4; ++e) { const int d = dhalf * 32 + i * 8 + e * 2;
            *(LAS bf16_t*)(wl + AW_V + d * 80 + krow * 2) = (bf16_t)(vreg[i][e] & 0xffffu); *(LAS bf16_t*)(wl + AW_V + (d + 1) * 80 + krow * 2) = (bf16_t)(vreg[i][e] >> 16); }
    f32x16_t s = {};
#pragma unroll
    for (int ks = 0; ks < 4; ++ks) { const bf16x8_t kf = *(const LAS bf16x8_t*)(wl + AW_K + q31 * 144 + ks * 32 + hi * 16); s = __builtin_amdgcn_mfma_f32_32x32x16_bf16(kf, qf[ks], s, 0, 0, 0); }
    float mx = -1e30f;
#pragma unroll
    for (int r = 0; r < 16; ++r) { s[r] = s[r] * c2 + bias2(r); mx = fmaxf(mx, s[r]); }
    { auto rr_ = __builtin_amdgcn_permlane32_swap(__float_as_uint(mx), __float_as_uint(mx), false, false); mx = fmaxf(__uint_as_float(rr_[0]), __uint_as_float(rr_[1])); }
    const float mnew = fmaxf(a.m, mx), alpha = __builtin_amdgcn_exp2f(a.m - mnew); a.m = mnew;
    float ps = 0.f;
#pragma unroll
    for (int r = 0; r < 16; ++r) { s[r] = __builtin_amdgcn_exp2f(s[r] - mnew); ps += s[r]; }
    a.l = a.l * alpha + ps;
#pragma unroll
    for (int r = 0; r < 16; ++r) { a.o0[r] *= alpha; a.o1[r] *= alpha; }
    const u32x4_t pw0 = (u32x4_t){pk_bf16(s[0], s[1]), pk_bf16(s[2], s[3]), pk_bf16(s[4], s[5]), pk_bf16(s[6], s[7])};
    const u32x4_t pw1 = (u32x4_t){pk_bf16(s[8], s[9]), pk_bf16(s[10], s[11]), pk_bf16(s[12], s[13]), pk_bf16(s[14], s[15])};
    const bf16x8_t pb0 = __builtin_bit_cast(bf16x8_t, pw0), pb1 = __builtin_bit_cast(bf16x8_t, pw1);
#pragma unroll
    for (int db = 0; db < 2; ++db) {
        const LAS unsigned char* vr = wl + AW_V + (32 * db + q31) * 80 + hi * 8;
        const s16x4v a0 = *(const LAS s16x4v*)(vr), a1 = *(const LAS s16x4v*)(vr + 16), b0 = *(const LAS s16x4v*)(vr + 32), b1 = *(const LAS s16x4v*)(vr + 48);
        const bf16x8_t vf0 = (bf16x8_t){a0[0], a0[1], a0[2], a0[3], a1[0], a1[1], a1[2], a1[3]}, vf1 = (bf16x8_t){b0[0], b0[1], b0[2], b0[3], b1[0], b1[1], b1[2], b1[3]};
        if (db == 0) { a.o0 = __builtin_amdgcn_mfma_f32_32x32x16_bf16(vf0, pb0, a.o0, 0, 0, 0); a.o0 = __builtin_amdgcn_mfma_f32_32x32x16_bf16(vf1, pb1, a.o0, 0, 0, 0); }
        else { a.o1 = __builtin_amdgcn_mfma_f32_32x32x16_bf16(vf0, pb0, a.o1, 0, 0, 0); a.o1 = __builtin_amdgcn_mfma_f32_32x32x16_bf16(vf1, pb1, a.o1, 0, 0, 0); }
    }
}
DEVFN void attw_store(const AttW& a, float sc, LAS unsigned char* wl, int lane, bf16_t* orow0, size_t ldo, int skip16 = 0) {
    const int q31 = lane & 31, hi = lane >> 5;
#pragma unroll
    for (int r = 0; r < 16; ++r) { const int d = (r & 3) + 8 * (r >> 2) + 4 * hi;
        *(LAS bf16_t*)(wl + q31 * 144 + d * 2) = f2bf(a.o0[r] * sc); *(LAS bf16_t*)(wl + q31 * 144 + (32 + d) * 2) = f2bf(a.o1[r] * sc); }
    const int qrow = lane >> 1, dhalf = lane & 1;
#pragma unroll
    for (int i = 0; i < 4; ++i) { const u32x4_t v = *(const LAS u32x4_t*)(wl + qrow * 144 + dhalf * 64 + i * 16); *(u32x4_t*)(orow0 + (size_t)(qrow + (qrow >> 4) * skip16) * ldo + dhalf * 32 + i * 8) = v; }
}
DEVFN void attw_qload(bf16x8_t (&qf)[4], const bf16_t* qrow  ) {
#pragma unroll
    for (int ks = 0; ks < 4; ++ks) qf[ks] = *(const bf16x8_t*)(qrow + ks * 16);
}
constexpr float LOG2E = 1.4426950408889634f;
DEVFN void ph_swa_attn_mfma(const Params& p, LAS unsigned char* lds, int tid, int bid, int G) {
    const bf16_t* Z = WSP(const bf16_t, WS_Z); bf16_t* att = WSP(bf16_t, WS_ATT); constexpr int LDZ = 1536;
    const int lane = tid & 63, wv = __builtin_amdgcn_readfirstlane(tid >> 6), q31 = lane & 31, hi = lane >> 5, krow = lane >> 1, dhalf = lane & 1;
    LAS unsigned char* wl = lds + wv * AW_BYTES;
    constexpr int XT = SEQ / 32, CT = CL / 32, NIT = NBAT * 4 * (XT + CT) * 4;
    const float c2 = 0.125f * LOG2E;
    for (int it = wv * G + bid; it < NIT; it += G * 8) {
        const int hg = it & 3, qt = (it >> 2) % (XT + CT), kvh = ((it >> 2) / (XT + CT)) & 3, b = (it >> 2) / ((XT + CT) * 4), hq = kvh * 4 + hg;
        const bool isx = qt < XT; const int q0 = isx ? qt * 32 : (qt - XT) * 32;
        const size_t qtok0 = isx ? (size_t)b * SEQ + q0 : (size_t)NX + b * CL + q0;
        bf16x8_t qf[4]; attw_qload(qf, Z + (qtok0 + q31) * LDZ + hq * 64 + 8 * hi);
        AttW a; a.o0 = (f32x16_t){}; a.o1 = (f32x16_t){}; a.m = -1e30f; a.l = 0.f;
        const int lo = isx ? imax(0, q0 - 128) : 0, hiK = isx ? imin(SEQ - 32, q0 + 128) : -32;
        const int nband = (hiK - lo) / 32 + 1, ntile = CT + (isx ? nband : 0);
        const size_t koff = 1024 + kvh * 64 + dhalf * 32, voff = 1280 + kvh * 64 + dhalf * 32;
        auto krow_tok = [&](int ti) -> size_t { return ti < CT ? (size_t)NX + b * CL + ti * 32 + krow : (size_t)b * SEQ + lo + (ti - CT) * 32 + krow; };
        u32x4_t kr[4], vr[4];
        { const size_t tk = krow_tok(0); attw_load(kr, vr, Z + tk * LDZ + koff, Z + tk * LDZ + voff); }
#pragma unroll 1
        for (int ti = 0; ti < ntile; ++ti) {
            u32x4_t kn[4], vn[4];
            { const size_t tk = krow_tok(ti + 1 < ntile ? ti + 1 : ti); attw_load(kn, vn, Z + tk * LDZ + koff, Z + tk * LDZ + voff); }
            if (ti < CT) attw_tile(a, qf, kr, vr, wl, lane, c2, [](int) { return 0.f; });
            else { const int dk = lo + (ti - CT) * 32 - q0 - q31 + 4 * hi;
                attw_tile(a, qf, kr, vr, wl, lane, c2, [dk](int r) { const int dd = dk + (r & 3) + 8 * (r >> 2); return (dd > 128 || dd < -128) ? -1e30f : 0.f; }); }
#pragma unroll
            for (int i = 0; i < 4; ++i) { kr[i] = kn[i]; vr[i] = vn[i]; }
        }
        const float sk2 = p.swa_sink[hq] * LOG2E, mf = fmaxf(a.m, sk2), al = __builtin_amdgcn_exp2f(a.m - mf);
        const float lt = (a.l + __shfl_xor(a.l, 32)) * al + __builtin_amdgcn_exp2f(sk2 - mf);
        attw_store(a, al / lt, wl, lane, att + qtok0 * D + hq * 64, D);
    }
}
DEVFN void ph_na_attn_mfma(const Params& p, LAS unsigned char* lds, int tid, int bid, int G) {
    const bf16_t* Z = WSP(const bf16_t, WS_Z); bf16_t* att = WSP(bf16_t, WS_ATT); constexpr int LDZ = 3072;
    const int lane = tid & 63, wv = __builtin_amdgcn_readfirstlane(tid >> 6), q31 = lane & 31, hi = lane >> 5, krow = lane >> 1, dhalf = lane & 1;
    LAS unsigned char* wl = lds + wv * AW_BYTES;
    constexpr int XT = SEQ / 32, CT = CL / 32, NIT = NBAT * 16 * (XT + CT);
    const float c2 = 0.125f * LOG2E;
    for (int it = wv * G + bid; it < NIT; it += G * 8) {
        const int qt = it % (XT + CT), hq = (it / (XT + CT)) & 15, b = it / ((XT + CT) * 16);
        const bool isx = qt < XT; const int q0 = isx ? qt * 32 : (qt - XT) * 32;
        const size_t qtok0 = isx ? (size_t)b * SEQ + q0 : (size_t)NX + b * CL + q0;
        bf16x8_t qf[4]; attw_qload(qf, Z + (qtok0 + q31) * LDZ + hq * 64 + 8 * hi);
        AttW a; a.o0 = (f32x16_t){}; a.o1 = (f32x16_t){}; a.m = -1e30f; a.l = 0.f;
        const int r = q0 / GW, c = (q0 % GW) + q31;
        const int rstart = iclamp(r - 4, 0, NROWS - 8), cstart = iclamp(c - 8, 0, GW - 16);
        const int ntile = CT + (isx ? 16 : 0);
        const size_t koff = 1024 + hq * 64 + dhalf * 32, voff = 2048 + hq * 64 + dhalf * 32;
        auto krow_tok = [&](int ti) -> size_t { return ti < CT ? (size_t)NX + b * CL + ti * 32 + krow : (size_t)b * SEQ + (rstart + ((ti - CT) >> 1)) * GW + ((ti - CT) & 1) * 32 + krow; };
        const float* rpb = p.na_rpb + (size_t)hq * 15 * 31;
        u32x4_t kr[4], vr[4];
        { const size_t tk = krow_tok(0); attw_load(kr, vr, Z + tk * LDZ + koff, Z + tk * LDZ + voff); }
#pragma unroll 1
        for (int ti = 0; ti < ntile; ++ti) {
            u32x4_t kn[4], vn[4];
            { const size_t tk = krow_tok(ti + 1 < ntile ? ti + 1 : ti); attw_load(kn, vn, Z + tk * LDZ + koff, Z + tk * LDZ + voff); }
            if (ti < CT) attw_tile(a, qf, kr, vr, wl, lane, c2, [](int) { return 0.f; });
            else { const int kr_ = rstart + ((ti - CT) >> 1), kc0 = ((ti - CT) & 1) * 32 + 4 * hi;
                const float* rp = rpb + (kr_ - r + 7) * 31 + 15 - c;
                attw_tile(a, qf, kr, vr, wl, lane, c2, [=](int rr) { const int kc = kc0 + (rr & 3) + 8 * (rr >> 2); const bool ok = kc >= cstart && kc < cstart + 16;
                    return ok ? rp[ok ? kc : c] * LOG2E : -1e30f; }); }
#pragma unroll
            for (int i = 0; i < 4; ++i) { kr[i] = kn[i]; vr[i] = vn[i]; }
        }
        const float lt = a.l + __shfl_xor(a.l, 32);
        attw_store(a, 1.f / lt, wl, lane, att + qtok0 * D + hq * 64, D);
    }
}
#endif
#ifndef CPU_TEST
DEVFN void tr_tile(const float* W, int N, bf16_t* WT, int item, LAS float* scr, int lane) {
    const int nblk = N / 32, kb = item / nblk, nb = item % nblk, k0 = 64 * kb, n0 = 32 * nb;
#pragma unroll 8
    for (int i = 0; i < 32; ++i) { const int kk = 2 * i + (lane >> 5); scr[kk * 33 + (lane & 31)] = W[(size_t)(k0 + kk) * N + n0 + (lane & 31)]; }
    const int c = lane & 7;
#pragma unroll
    for (int j = 0; j < 4; ++j) { const int n = (lane >> 3) + 8 * j; const LAS float* sp = scr + (8 * c) * 33 + n;
        u32x4_t o; o.x = pk_bf16(sp[0 * 33], sp[1 * 33]); o.y = pk_bf16(sp[2 * 33], sp[3 * 33]); o.z = pk_bf16(sp[4 * 33], sp[5 * 33]); o.w = pk_bf16(sp[6 * 33], sp[7 * 33]);
        *(u32x4_t*)(WT + (size_t)(n0 + n) * D + k0 + 8 * c) = o; }
}
DEVFN void ph_pro_gpu(const Params& p, LAS unsigned char* lds, int tid, int bid, int G, size_t gtid, size_t gsize) {
    const int lane = tid & 63, wv = __builtin_amdgcn_readfirstlane(tid >> 6);
    {
        LAS float* scr = (LAS float*)(lds + 61440 + wv * 8448);
        constexpr int I5120 = 16 * 160, I1536 = 16 * 48, I3072 = 16 * 96, I1024 = 16 * 32, I2048 = 16 * 64;
        constexpr int NITEMS = I5120 + 2 * I1536 + I3072 + 4 * I1024 + 4 * I2048;
        for (int it = wv * G + bid; it < NITEMS; it += G * 8) {
            int r = it;
            if (r < I5120) { tr_tile(p.hgrn_w_in, 5120, WSP(bf16_t, WS_WIN0), r, scr, lane); continue; } r -= I5120;
            if (r < I1536) { tr_tile(p.swa_w_in, 1536, WSP(bf16_t, WS_WIN1), r, scr, lane); continue; } r -= I1536;
            if (r < I3072) { tr_tile(p.na_w_in, 3072, WSP(bf16_t, WS_WIN2), r, scr, lane); continue; } r -= I3072;
            if (r < I1536) { tr_tile(p.gqa_w_in, 1536, WSP(bf16_t, WS_WIN3), r, scr, lane); continue; } r -= I1536;
            if (r < 4 * I1024) { const int m = r / I1024; const float* W = m == 0 ? p.hgrn_w_out : m == 1 ? p.swa_w_out : m == 2 ? p.na_w_out : p.gqa_w_out;
                tr_tile(W, 1024, WSP(bf16_t, WS_WOUT) + (size_t)m * D * D, r % I1024, scr, lane); continue; } r -= 4 * I1024;
            { const int m = r / I2048; tr_tile(p.peer_wq + (size_t)m * D * 2048, 2048, WSP(bf16_t, WS_WQ) + (size_t)m * 2048 * D, r % I2048, scr, lane); }
        }
    }
    {
        LAS float* sil = (LAS float*)lds;
        for (int i = tid; i < NMR * D; i += 512) { const int r = i / D, k = i % D; const float v = r < NBAT ? p.c[(size_t)r * D + k] : p.c_ctx[k]; sil[i] = v / (1.f + __expf(-v)); }
        __syncthreads();
        LAS float* red = (LAS float*)(lds + 40960);
        float* modv = WSP(float, WS_MODV);
        for (int item = bid; item < DEPTH * 48; item += G) {
            const int l = item / 48, cb = item % 48, ch = wv & 1, kq = wv >> 1, col = cb * 128 + ch * 64 + lane;
            const float* w = p.mod_w + (size_t)l * D * 6144 + (size_t)(kq * 256) * 6144 + col;
            float acc[NMR];
#pragma unroll
            for (int r = 0; r < NMR; ++r) acc[r] = 0.f;
#pragma unroll 4
            for (int k = 0; k < 256; ++k) { const float wv_ = w[(size_t)k * 6144];
#pragma unroll
                for (int r = 0; r < NMR; ++r) acc[r] = fmaf(sil[r * D + kq * 256 + k], wv_, acc[r]); }
#pragma unroll
            for (int r = 0; r < NMR; ++r) red[(wv * NMR + r) * 64 + lane] = acc[r];
            __syncthreads();
            if (kq == 0) {
#pragma unroll
                for (int r = 0; r < NMR; ++r) { float s = 0.f;
#pragma unroll
                    for (int q = 0; q < 4; ++q) s += red[((q * 2 + ch) * NMR + r) * 64 + lane];
                    modv[(size_t)(l * NMR + r) * 6144 + col] = s + p.mod_b[l * 6144 + col]; }
            }
            __syncthreads();
        }
    }
    float* lbv = WSP(float, WS_LBV);
    for (size_t c = gtid; c < (size_t)D; c += gsize) {
        float m = -1e30f;
        for (int j = 0; j < DEPTH + 1; ++j) m = fmaxf(m, p.hgrn_lb[j * D + c]);
        float sum = 0.f;
        for (int j = 0; j < DEPTH + 1; ++j) sum += expf(p.hgrn_lb[j * D + c] - m);
        lbv[c] = expf(p.hgrn_lb[c] - m) / sum;
    }
    float* rope = WSP(float, WS_ROPE);
    for (size_t i = gtid; i < (size_t)64 * 16; i += gsize) { const int pos = (int)(i / 16), fi = (int)(i % 16); const float ang = (float)pos * expf(-(float)(2 * fi) / 32.f * LN_THETA); rope[ROPE64_COS + i] = cosf(ang); rope[ROPE64_SIN + i] = sinf(ang); }
    for (size_t i = gtid; i < (size_t)64 * 32; i += gsize) { const int pos = (int)(i / 32), fi = (int)(i % 32); const float ang = (float)pos * expf(-(float)(2 * fi) / 64.f * LN_THETA); rope[ROPE128_COS + i] = cosf(ang); rope[ROPE128_SIN + i] = sinf(ang); }
    ph_cvt_keys(p, gtid, gsize);
}
DEVFN u32x4_t mod8(const f32x4_t a, const f32x4_t b, const float* shift, const float* scale) {
    const f32x4_t s0 = ((const f32x4_t*)shift)[0], s1 = ((const f32x4_t*)shift)[1], c0 = ((const f32x4_t*)scale)[0], c1 = ((const f32x4_t*)scale)[1];
    return (u32x4_t){pk_bf16(a[0] * (1.f + c0[0]) + s0[0], a[1] * (1.f + c0[1]) + s0[1]), pk_bf16(a[2] * (1.f + c0[2]) + s0[2], a[3] * (1.f + c0[3]) + s0[3]),
                     pk_bf16(b[0] * (1.f + c1[0]) + s1[0], b[1] * (1.f + c1[1]) + s1[1]), pk_bf16(b[2] * (1.f + c1[2]) + s1[2], b[3] * (1.f + c1[3]) + s1[3])};
}
DEVFN void ph_h0_gpu(const Params& p, size_t gtid, size_t gsize) {
    const float* xs = WSP(float, WS_XS); const float* modv = WSP(float, WS_MODV); bf16_t* hb = WSP(bf16_t, WS_HB);
    for (size_t i = gtid; i < (size_t)NT * D / 4; i += gsize) {
        const int t = (int)(i / (D / 4)), c = (int)(i % (D / 4)) * 4;
        const float* m = modv + (size_t)modrow(t) * 6144;
        const float* xin = t < NX ? p.x + (size_t)t * D : p.ctx + (size_t)(t - NX) * D;
        const f32x4_t a = *(const f32x4_t*)(xin + c), sh = *(const f32x4_t*)(m + c), sc = *(const f32x4_t*)(m + D + c);
        const f32x4_t hv = a * (sc + 1.f) + sh;
        *(u32x2_t*)(hb + (size_t)t * D + c) = (u32x2_t){pk_bf16(hv[0], hv[1]), pk_bf16(hv[2], hv[3])};
    }
}
DEVFN void unpack8(const u32x4_t w, float (&v)[8]) {
#pragma unroll
    for (int i = 0; i < 4; ++i) { v[2 * i] = __uint_as_float(w[i] << 16); v[2 * i + 1] = __uint_as_float(w[i] & 0xffff0000u); }
}
DEVFN u32x4_t pack8(const float (&v)[8]) { return (u32x4_t){pk_bf16(v[0], v[1]), pk_bf16(v[2], v[3]), pk_bf16(v[4], v[5]), pk_bf16(v[6], v[7])}; }
DEVFN void ph_swa_rope_gpu(const Params& p, size_t gtid, size_t gsize) {
    bf16_t* Z = WSP(bf16_t, WS_Z); const float* rope = WSP(const float, WS_ROPE); constexpr int LDZ = 1536;
    for (size_t i = gtid; i < (size_t)NX * 20 * 4; i += gsize) {
        const int gq = (int)(i & 1), a = (int)((i >> 1) & 1), hh = (int)((i >> 2) % 20), t = (int)(i / 80);
        const int s = t % SEQ, pos = a == 0 ? s / GW : s % GW;
        bf16_t* zp = Z + (size_t)t * LDZ + hh * 64 + a * 32 + gq * 8;
        float x1[8], x2[8], o1[8], o2[8];
        unpack8(*(const u32x4_t*)zp, x1); unpack8(*(const u32x4_t*)(zp + 16), x2);
        const float* cs = rope + ROPE64_COS + pos * 16 + gq * 8; const float* sn = rope + ROPE64_SIN + pos * 16 + gq * 8;
#pragma unroll
        for (int e = 0; e < 8; ++e) { o1[e] = x1[e] * cs[e] - x2[e] * sn[e]; o2[e] = x2[e] * cs[e] + x1[e] * sn[e]; }
        *(u32x4_t*)zp = pack8(o1); *(u32x4_t*)(zp + 16) = pack8(o2);
    }
}
DEVFN void ph_gqa_prep_gpu(const Params& p, size_t gtid, size_t gsize) {
    bf16_t* Z = WSP(bf16_t, WS_Z); const float* rope = WSP(const float, WS_ROPE); constexpr int LDZ = 1536;
    const size_t nitem = (size_t)NT * 10 * 16;
    for (size_t i = gtid; i < nitem; i += gsize) {
        const int j = (int)(i & 15), hh = (int)((i >> 4) % 10), t = (int)(i / 160);
        bf16_t* zp = Z + (size_t)t * LDZ + hh * 128 + j * 8;
        const float* g = (hh < 8 ? p.gqa_q_norm : p.gqa_k_norm) + j * 8;
        float x[8]; unpack8(*(const u32x4_t*)zp, x);
        float ss = 0.f;
#pragma unroll
        for (int e = 0; e < 8; ++e) ss += x[e] * x[e];
        ss += dppf(ss, 0xB1); ss += dppf(ss, 0x4E); ss += dppf(ss, 0x141); ss += dppf(ss, 0x140);
        const float r = 1.f / sqrtf(ss * (1.f / 128.f) + RMS_EPS);
#pragma unroll
        for (int e = 0; e < 8; ++e) x[e] = x[e] * r * g[e];
        float o[8];
        float y[8];
#pragma unroll
        for (int e = 0; e < 8; ++e) y[e] = __int_as_float(dpp_xor4(__float_as_int(x[e])));
        if (t < NX) {
            const int s = t % SEQ, a = j >> 3, pos = a == 0 ? s / GW : s % GW, fq = (j & 3) * 8; const bool second = (j & 4) != 0;
            const float* cs = rope + ROPE128_COS + pos * 32 + fq; const float* sn = rope + ROPE128_SIN + pos * 32 + fq;
#pragma unroll
            for (int e = 0; e < 8; ++e) o[e] = second ? x[e] * cs[e] + y[e] * sn[e] : x[e] * cs[e] - y[e] * sn[e];
        } else {
#pragma unroll
            for (int e = 0; e < 8; ++e) o[e] = x[e];
        }
        *(u32x4_t*)zp = pack8(o);
    }
}
DEVFN void ph_hgrn_readout_gpu(const Params& p, int tid, int bid, int G) {
    const bf16_t* Z = WSP(const bf16_t, WS_Z); constexpr int LDZ = 5120;
    const bf16_t* of = WSP(const bf16_t, WS_Y); const bf16_t* ob = of + (size_t)NT * D; bf16_t* att = WSP(bf16_t, WS_ATT);
    const int lane = tid & 63, wv = __builtin_amdgcn_readfirstlane(tid >> 6);
    const float* ng = p.hgrn_norm_g + (lane & 15) * 8;
    for (int t = wv * G + bid; t < NT; t += G * 8) {
#pragma unroll
        for (int j = 0; j < 2; ++j) {
            const size_t off = (size_t)t * D + 512 * j + lane * 8;
            float a[8], b[8], gz[8];
            unpack8(*(const u32x4_t*)(of + off), a); unpack8(*(const u32x4_t*)(ob + off), b); unpack8(*(const u32x4_t*)(Z + (size_t)t * LDZ + 4096 + 512 * j + lane * 8), gz);
            float ss = 0.f;
#pragma unroll
            for (int e = 0; e < 8; ++e) { a[e] += b[e]; ss += a[e] * a[e]; }
            ss += dppf(ss, 0xB1); ss += dppf(ss, 0x4E); ss += dppf(ss, 0x141); ss += dppf(ss, 0x140);
            const float r = 1.f / sqrtf(ss * (1.f / 128.f) + RMS_EPS);
            float o[8];
#pragma unroll
            for (int e = 0; e < 8; ++e) o[e] = a[e] * r * ng[e] * gz[e] / (1.f + __expf(-gz[e]));
            *(u32x4_t*)(att + off) = pack8(o);
        }
    }
}
DEVFN void ph_ln1_gpu(const Params& p, int l, int M, int tid, int bid, int G, int dry = 0) {
    bf16_t* xs = WSP(bf16_t, WS_XS); const bf16_t* Yb = WSP(const bf16_t, WS_Y); const float* modv = WSP(const float, WS_MODV); bf16_t* hb = WSP(bf16_t, WS_HB);
    const int lane = tid & 63, wv = __builtin_amdgcn_readfirstlane(tid >> 6);
    bf16_t* xs_o = dry ? WSP(bf16_t, WS_Z) : xs; bf16_t* hb_o = dry ? WSP(bf16_t, WS_Z + (size_t)NT * 4096) : hb;
    unsigned char* hqh_o = dry ? WSP(unsigned char, WS_Z + (size_t)NT * 6144) : WSP(unsigned char, WS_HQH); unsigned char* hql_o = dry ? WSP(unsigned char, WS_Z + (size_t)NT * 7168) : WSP(unsigned char, WS_HQL);
    float* hqs_o = dry ? WSP(float, WS_Z + (size_t)NT * 8192) : WSP(float, WS_HQS);
    const f32x4_t* lg0 = (const f32x4_t*)(p.ln_g + (size_t)(l * 2) * D) + lane; const f32x4_t* lb0 = (const f32x4_t*)(p.ln_b + (size_t)(l * 2) * D) + lane;
    const int t0 = wv * G + bid, tstep = G * 8;
    f32x4_t nxf[4]; u32x2_t nxb[4], ny[4];
#define LN1_LOAD(tt) { const int tt_ = (tt); const u32x2_t* yp = (const u32x2_t*)(Yb + (size_t)tt_ * D) + lane; \
        if (l == 0) { const f32x4_t* xp = (const f32x4_t*)(tt_ < NX ? p.x + (size_t)tt_ * D : p.ctx + (size_t)(tt_ - NX) * D) + lane; _Pragma("unroll") for (int j = 0; j < 4; ++j) nxf[j] = xp[64 * j]; } \
        else { const u32x2_t* xp = (const u32x2_t*)(xs + (size_t)tt_ * D) + lane; _Pragma("unroll") for (int j = 0; j < 4; ++j) nxb[j] = xp[64 * j]; } \
        _Pragma("unroll") for (int j = 0; j < 4; ++j) ny[j] = yp[64 * j]; }
    LN1_LOAD(imin(t0, M - 1))
    for (int t = t0; t < M; t += tstep) {
        const f32x4_t* lg = lg0; const f32x4_t* lb = lb0; asm volatile("" : "+v"(lg), "+v"(lb));
        const f32x4_t* m = (const f32x4_t*)(modv + (size_t)(l * NMR + modrow(t)) * 6144) + lane;
        f32x4_t cx[4]; u32x2_t cy[4];
#pragma unroll
        for (int j = 0; j < 4; ++j) { cy[j] = ny[j];
            cx[j] = l == 0 ? nxf[j] : (f32x4_t){__uint_as_float(nxb[j][0] << 16), __uint_as_float(nxb[j][0] & 0xffff0000u), __uint_as_float(nxb[j][1] << 16), __uint_as_float(nxb[j][1] & 0xffff0000u)}; }
        LN1_LOAD(imin(t + tstep, M - 1))
        f32x4_t v[4]; float s = 0.f;
#pragma unroll
        for (int j = 0; j < 4; ++j) { const f32x4_t gv = m[2 * 256 + 64 * j];
            const f32x4_t yv = {__uint_as_float(cy[j][0] << 16), __uint_as_float(cy[j][0] & 0xffff0000u), __uint_as_float(cy[j][1] << 16), __uint_as_float(cy[j][1] & 0xffff0000u)};
            v[j] = cx[j] * ALPHA + gv * yv; s += (v[j][0] + v[j][1]) + (v[j][2] + v[j][3]); }
        const float mu = row_sum(s) * (1.f / D);
        float q = 0.f;
#pragma unroll
        for (int j = 0; j < 4; ++j) { v[j] = v[j] - mu; q += (v[j][0] * v[j][0] + v[j][1] * v[j][1]) + (v[j][2] * v[j][2] + v[j][3] * v[j][3]); }
        const float rstd = 1.f / sqrtf(row_sum(q) * (1.f / D) + LN_EPS);
        f32x4_t tk[4]; float am[4];
#pragma unroll
        for (int j = 0; j < 4; ++j) { v[j] = v[j] * rstd * lg[64 * j] + lb[64 * j];
            tk[j] = v[j] * (m[4 * 256 + 64 * j] + 1.f) + m[3 * 256 + 64 * j];
            am[j] = fmaxf(fmaxf(fabsf(tk[j][0]), fabsf(tk[j][1])), fmaxf(fabsf(tk[j][2]), fabsf(tk[j][3]))); }
        u32x2_t* xo = (u32x2_t*)(xs_o + (size_t)t * D) + lane; u32x2_t* ho = (u32x2_t*)(hb_o + (size_t)t * D) + lane;
#pragma unroll
        for (int j = 0; j < 4; ++j) { xo[64 * j] = (u32x2_t){pk_bf16(v[j][0], v[j][1]), pk_bf16(v[j][2], v[j][3])}; ho[64 * j] = (u32x2_t){pk_bf16(tk[j][0], tk[j][1]), pk_bf16(tk[j][2], tk[j][3])}; }
#pragma unroll
        for (int j = 0; j < 4; ++j) am[j] = wave_maxf(am[j]);
        unsigned short* qho = (unsigned short*)(hqh_o + (size_t)t * 512) + lane; unsigned short* qlo = (unsigned short*)(hql_o + (size_t)t * 512) + lane;
#pragma unroll
        for (int j = 0; j < 4; ++j) { const float qs = am[j] > 0.f ? 119.f / am[j] : 0.f; unsigned wh = 0u, wl = 0u;
#pragma unroll
            for (int kk = 0; kk < 4; ++kk) { const int qi = (int)rintf(tk[j][kk] * qs); wh |= ((unsigned)((qi + 8) >> 4) & 15u) << (4 * kk); wl |= ((unsigned)qi & 15u) << (4 * kk); }
            qho[64 * j] = (unsigned short)wh; qlo[64 * j] = (unsigned short)wl;
            if (lane == 0) hqs_o[(size_t)t * 4 + j] = am[j] * (1.f / 119.f); }
    }
}
#endif
#ifndef CPU_TEST
typedef int i32x4_t __attribute__((ext_vector_type(4)));
DEVFN void pk_dot16(f32x2_t& acc, const u32x4_t r, const f32x2_t (&h2)[8]) {
#pragma unroll
    for (int i = 0; i < 4; ++i) { const f32x2_t lo = __builtin_amdgcn_cvt_pk_f32_fp8((int)r[i], false), hi = __builtin_amdgcn_cvt_pk_f32_fp8((int)r[i], true);
        acc = __builtin_elementwise_fma(lo, h2[2 * i], acc); acc = __builtin_elementwise_fma(hi, h2[2 * i + 1], acc); }
}
DEVFN void pk_fma16(f32x2_t (&y2)[8], const u32x4_t r, const float w) {
    const f32x2_t w2 = {w, w};
#pragma unroll
    for (int i = 0; i < 4; ++i) { const f32x2_t lo = __builtin_amdgcn_cvt_pk_f32_fp8((int)r[i], false), hi = __builtin_amdgcn_cvt_pk_f32_fp8((int)r[i], true);
        y2[2 * i] = __builtin_elementwise_fma(lo, w2, y2[2 * i]); y2[2 * i + 1] = __builtin_elementwise_fma(hi, w2, y2[2 * i + 1]); }
}
struct PvItem { u32x4_t r[16]; f32x4_t w[4]; };
DEVFN void pv_idx(int (&e)[16], const int* idx, int t, int g) {
    const i32x4_t* ip = (const i32x4_t*)(idx + (size_t)t * 128 + g * 16);
#pragma unroll
    for (int i = 0; i < 4; ++i) { const i32x4_t v = ip[i]; e[4 * i] = v[0]; e[4 * i + 1] = v[1]; e[4 * i + 2] = v[2]; e[4 * i + 3] = v[3]; }
}
struct PuvItem { u32x4_t r[16]; u32x4_t h0, h1; float hs; };
DEVFN void puv_rows(PuvItem& it, const int (&e)[16], const unsigned char* UP, const unsigned lo16, const unsigned char* qh, const unsigned char* ql, const float* hs) {
#pragma unroll
    for (int j = 0; j < 16; ++j) it.r[j] = *(const u32x4_t*)(UP + (((unsigned)e[j] << 7) | lo16));
    it.h0 = *(const u32x4_t*)qh; it.h1 = *(const u32x4_t*)ql; it.hs = *hs;
}
DEVFN void puv_compute(const PuvItem& it, bf16_t* pout, int k) {
    int qh = 0, ql = 0;
#pragma unroll
    for (int i = 0; i < 4; ++i) { qh = __builtin_amdgcn_sdot8((int)it.h0[i], 0x11111111, qh, false); ql = __builtin_amdgcn_sdot8((int)it.h1[i], 0x11111111, ql, false); }
    const int qsum = qh * 16 + ql;
    int d[16];
#pragma unroll
    for (int j = 0; j < 16; ++j) { int ah = 0, al = 0;
#pragma unroll
        for (int i = 0; i < 4; ++i) { ah = __builtin_amdgcn_sdot8((int)it.r[j][i], (int)it.h0[i], ah, false); al = __builtin_amdgcn_sdot8((int)it.r[j][i], (int)it.h1[i], al, false); }
        d[j] = ah * 32 + al * 2 + qsum; }
    int d8[8];
#pragma unroll
    for (int i = 0; i < 8; ++i) { const bool up = (k & 4) != 0; const int keep = up ? d[8 + i] : d[i], send = up ? d[i] : d[8 + i]; d8[i] = keep + dpp_xor4(send); }
    int d4[4];
#pragma unroll
    for (int i = 0; i < 4; ++i) { const bool up = (k & 2) != 0; const int keep = up ? d8[4 + i] : d8[i], send = up ? d8[i] : d8[4 + i]; d4[i] = keep + dpp_xor2(send); }
    int d2[2];
#pragma unroll
    for (int i = 0; i < 2; ++i) { const bool up = (k & 1) != 0; const int keep = up ? d4[2 + i] : d4[i], send = up ? d4[i] : d4[2 + i]; d2[i] = keep + dpp_xor1(send); }
    *(unsigned*)(pout + ((k >> 2) & 1) * 8 + ((k >> 1) & 1) * 4 + (k & 1) * 2) = pk_bf16((float)d2[0] * it.hs, (float)d2[1] * it.hs);
}
DEVFN void ph_peer_u(const Params& p, int l, int M, int tid, int bid, int G) {
    const int lane = tid & 63, wv = __builtin_amdgcn_readfirstlane(tid >> 6), g = lane >> 3, k = lane & 7, x = bid & 3;
    const unsigned char* UP = WSP(const unsigned char, WS_UV8) + (size_t)(l * 2) * PEER_N * 1024 + (size_t)x * PEER_N * 128; const unsigned lo16 = (unsigned)k * 16u;
    const int* idx = WSP(const int, WS_IDX);
    const unsigned char* qh = WSP(const unsigned char, WS_HQH) + x * 128 + k * 16; const unsigned char* ql = WSP(const unsigned char, WS_HQL) + x * 128 + k * 16; const float* hs = WSP(const float, WS_HQS) + x;
    bf16_t* part = WSP(bf16_t, WS_PART) + (size_t)x * NT * 128 + g * 16;
    const int nw = (G >> 2) * 8, t0 = (bid >> 2) * 8 + wv, last = M - 1;
    int eA[16], eB[16]; PuvItem A, B;
    pv_idx(eA, idx, imin(t0, last), g); pv_idx(eB, idx, imin(t0 + nw, last), g);
    { const size_t tt = imin(t0, last); puv_rows(A, eA, UP, lo16, qh + tt * 512, ql + tt * 512, hs + tt * 4); }
    for (int t = t0; t < M; t += 2 * nw) {
        { const size_t tt = imin(t + nw, last); puv_rows(B, eB, UP, lo16, qh + tt * 512, ql + tt * 512, hs + tt * 4); }
        pv_idx(eA, idx, imin(t + 2 * nw, last), g);
        puv_compute(A, part + (size_t)t * 128, k);
        { const size_t tt = imin(t + 2 * nw, last); puv_rows(A, eA, UP, lo16, qh + tt * 512, ql + tt * 512, hs + tt * 4); }
        pv_idx(eB, idx, imin(t + 3 * nw, last), g);
        if (t + nw < M) puv_compute(B, part + (size_t)(t + nw) * 128, k);
    }
}
DEVFN void ph_peer_comb(const Params& p, int l, int M, size_t gtid, size_t gsize) {
    const int* idx = WSP(const int, WS_IDX); const float* gate = WSP(const float, WS_GATE); const bf16_t* part = WSP(const bf16_t, WS_PART);
    unsigned char* whi = WSP(unsigned char, WS_WA); float* wsc = (float*)(whi + (size_t)NT * 256);
    const f32x2_t* SUV = WSP(const f32x2_t, WS_UVS) + (size_t)l * PEER_N;
    for (size_t i4 = gtid; i4 < (size_t)M * 32; i4 += gsize) {
        const size_t i = i4 * 4;
        f32x4_t s = {0.f, 0.f, 0.f, 0.f};
#pragma unroll
        for (int x = 0; x < 4; ++x) { const u32x2_t w = *(const u32x2_t*)(part + (size_t)x * NT * 128 + i);
            s += (f32x4_t){__uint_as_float(w[0] << 16), __uint_as_float(w[0] & 0xffff0000u), __uint_as_float(w[1] << 16), __uint_as_float(w[1] & 0xffff0000u)}; }
        const i32x4_t e = *(const i32x4_t*)(idx + i); const f32x4_t g = *(const f32x4_t*)(gate + i);
        f32x4_t o;
#pragma unroll
        for (int k = 0; k < 4; ++k) { const f32x2_t sc = SUV[e[k]]; const float dot = s[k] * sc[0]; const float u3 = 1.5957691216057308f * (dot + 0.044715f * dot * dot * dot); o[k] = g[k] * sc[1] * dot / (1.f + __expf(-u3)); }
        float am = fmaxf(fmaxf(fabsf(o[0]), fabsf(o[1])), fmaxf(fabsf(o[2]), fabsf(o[3])));
        am = fmaxf(am, dppf(am, 0xB1)); am = fmaxf(am, dppf(am, 0x4E)); am = fmaxf(am, dppf(am, 0x141)); am = fmaxf(am, dppf(am, 0x140));
        { auto rr = __builtin_amdgcn_permlane16_swap(__float_as_uint(am), __float_as_uint(am), false, false); am = fmaxf(__uint_as_float(rr[0]), __uint_as_float(rr[1])); }
        const float ws = am > 0.f ? 6.f / am : 0.f;
        const size_t t = i >> 7; const int pos = (int)(i & 127), gq = pos >> 4, j0 = pos & 15, ge = gq & 1;
        float rr[4];
#pragma unroll
        for (int k = 0; k < 4; ++k) rr[k] = o[k] * ws;
#pragma unroll
        for (int d = 0; d < 3; ++d) {
            unsigned mine = 0u;
#pragma unroll
            for (int k = 0; k < 4; ++k) {
                const unsigned wd = __builtin_amdgcn_cvt_scalef32_pk_fp4_f32(0u, rr[k], 0.f, 1.0f, 0) & 0xffu;
                const f32x2_t dec = __builtin_amdgcn_cvt_scalef32_pk_f32_fp4(wd, 1.0f, 0);
                mine |= ((wd | (wd >> 4)) & 15u) << (4 * k);
                rr[k] = (rr[k] - (dec[0] + dec[1])) * 4.f; }
            const unsigned oth = (unsigned)dpp_xor4((int)mine);
            const unsigned lo4 = ge ? oth : mine, hi4 = ge ? mine : oth;
            unsigned W = 0u;
#pragma unroll
            for (int k = 0; k < 4; ++k) W |= (((lo4 >> (4 * k)) & 15u) | (((hi4 >> (4 * k)) & 15u) << 4)) << (8 * k);
            const int cc = gq >> 1;
            const unsigned o1 = (unsigned)dpp_xor8((int)W);
            W = __builtin_amdgcn_perm(o1, W, (cc & 1) ? 0x03070105u : 0x06020400u);
            unsigned o2; { auto rr = __builtin_amdgcn_permlane16_swap(W, W, false, false); o2 = (cc & 2) ? rr[0] : rr[1]; }
            W = __builtin_amdgcn_perm(o2, W, (cc & 2) ? 0x03020706u : 0x05040100u);
            if (ge == 0) *(unsigned*)(whi + ((size_t)d * NT + t) * 64 + 4 * (j0 + cc)) = W;
        }
        if ((i4 & 31) == 0) wsc[t] = am * (1.f / 6.f);
    }
}
typedef int i32x2_t __attribute__((ext_vector_type(2)));
typedef int i32x8_t __attribute__((ext_vector_type(8)));
struct PvRows { u32x4_t r[16]; i32x4_t w4; float ws; };
DEVFN void pv_rows(PvRows& it, const int (&e)[16], const unsigned char* VP, const unsigned lo16, const unsigned char* wbt, const float* wsp, const bool hasw) {
#pragma unroll
    for (int j = 0; j < 16; ++j) it.r[j] = *(const u32x4_t*)(VP + (((unsigned)e[j] << 7) | lo16));
    it.w4 = (i32x4_t){0, 0, 0, 0};
    if (hasw) it.w4 = *(const i32x4_t*)wbt;
    it.ws = *wsp;
}
DEVFN void pv_compute(const PvRows& it, LAS unsigned char* wrE, LAS unsigned char* wrO, LAS unsigned char* rowbase, const int fsh, bf16_t* yo, const bool st) {
    asm volatile("" ::: "memory");
#pragma unroll
    for (int j = 0; j < 16; ++j) *(LAS u32x4_t*)(((j & 1) ? wrO : wrE) + j * 1024) = it.r[j];
    asm volatile("" ::: "memory");
    const i32x8_t wf = {it.w4[0], it.w4[1], it.w4[2], it.w4[3], 0, 0, 0, 0};
    const float c0 = it.ws, c1 = it.ws * 0.25f, c2 = it.ws * 0.0625f;
    unsigned res[16];
#pragma unroll
    for (int c = 0; c < 16; ++c) {
        const int off = (((c >> 1) << 4) ^ fsh) + 8 * (c & 1);
        const i32x2_t a0 = __builtin_amdgcn_ds_read_tr4_b64_v2i32((LAS i32x2_t*)(rowbase + off)), a1 = __builtin_amdgcn_ds_read_tr4_b64_v2i32((LAS i32x2_t*)(rowbase + 2048 + off));
        const i32x8_t tf = {a0[0], a0[1], a1[0], a1[1], 0, 0, 0, 0};
        f32x4_t acc = {0.f, 0.f, 0.f, 0.f};
        acc = __builtin_amdgcn_mfma_scale_f32_16x16x128_f8f6f4(wf, tf, acc, 4, 4, 0, 0, 0, 0);
        const float y = acc[0] * c0 + acc[1] * c1 + acc[2] * c2;
        const float yn = __int_as_float(__builtin_amdgcn_mov_dpp(__float_as_int(y), 0xB1, 0xf, 0xf, true));
        res[c] = pk_bf16(y, yn);
    }
    if (st) {
#pragma unroll
        for (int c = 0; c < 16; ++c) *(unsigned*)(yo + c * 16) = res[c]; }
    asm volatile("" ::: "memory");
}
DEVFN void ph_peer_v(const Params& p, LAS unsigned char* lds, int l, int M, int tid, int bid, int G) {
    const int lane = tid & 63, wv = __builtin_amdgcn_readfirstlane(tid >> 6), g = lane >> 3, sl = lane & 7, x = bid & 3, n = lane & 15, q = lane >> 4;
    LAS unsigned char* img = lds + wv * 16384;
    const unsigned char* VPl = WSP(const unsigned char, WS_UV8) + (size_t)(l * 2 + 1) * PEER_N * 1024 + (size_t)x * PEER_N * 128; const unsigned lo16 = (unsigned)sl * 16u;
    const int* idx = WSP(const int, WS_IDX);
    const unsigned char* wb = WSP(const unsigned char, WS_WA) + (size_t)(n & 3) * NT * 64 + 16 * q; const float* wsc = (const float*)(WSP(const unsigned char, WS_WA) + (size_t)NT * 256);
    const bool hasw = n < 3, st = q == 0 && (n & 1) == 0;
    bf16_t* Y = WSP(bf16_t, WS_Y) + x * 256 + n;
    LAS unsigned char* wrE = img + g * 128 + ((sl ^ (g >> 1)) << 4); LAS unsigned char* wrO = img + g * 128 + (((sl ^ (g >> 1)) << 4) ^ 64);
    const int R0 = 32 * q + n, fsh = ((R0 >> 1) & 7) << 4;
    LAS unsigned char* rowbase = img + R0 * 128;
    const int nw = (G >> 2) * 8, t0 = (bid >> 2) * 8 + wv, last = M - 1;
    int eA[16], eB[16]; PvRows A, B;
    pv_idx(eA, idx, imin(t0, last), g); pv_idx(eB, idx, imin(t0 + nw, last), g);
    { const size_t tt = imin(t0, last); pv_rows(A, eA, VPl, lo16, wb + tt * 64, wsc + tt, hasw); }
    for (int t = t0; t < M; t += 2 * nw) {
        { const size_t tt = imin(t + nw, last); pv_rows(B, eB, VPl, lo16, wb + tt * 64, wsc + tt, hasw); }
        pv_idx(eA, idx, imin(t + 2 * nw, last), g);
        pv_compute(A, wrE, wrO, rowbase, fsh, Y + (size_t)t * D, st);
        { const size_t tt = imin(t + 2 * nw, last); pv_rows(A, eA, VPl, lo16, wb + tt * 64, wsc + tt, hasw); }
        pv_idx(eB, idx, imin(t + 3 * nw, last), g);
        if (t + nw < M) pv_compute(B, wrE, wrO, rowbase, fsh, Y + (size_t)(t + nw) * D, st);
    }
}
DEVFN void ph_ln2_gpu(const Params& p, int l, int M, int tid, int bid, int G, int dry = 0) {
    bf16_t* xs = WSP(bf16_t, WS_XS); const bf16_t* Yb = WSP(const bf16_t, WS_Y); const float* modv = WSP(const float, WS_MODV); bf16_t* hb = WSP(bf16_t, WS_HB);
    const int lane = tid & 63, wv = __builtin_amdgcn_readfirstlane(tid >> 6);
    bf16_t* xs_o = dry ? WSP(bf16_t, WS_Z + (size_t)NT * 2048) : xs; bf16_t* hb_o = dry ? WSP(bf16_t, WS_Z + (size_t)NT * 4096) : hb; float* out_o = dry ? WSP(float, WS_Z) : p.out;
    const f32x4_t* lg0 = (const f32x4_t*)(p.ln_g + (size_t)(l * 2 + 1) * D) + lane; const f32x4_t* lb0 = (const f32x4_t*)(p.ln_b + (size_t)(l * 2 + 1) * D) + lane;
    const int t0 = wv * G + bid, tstep = G * 8;
    u32x2_t nx[4], ny[4];
    { const int tt = imin(t0, M - 1); const u32x2_t* xp = (const u32x2_t*)(xs + (size_t)tt * D) + lane; const u32x2_t* yp = (const u32x2_t*)(Yb + (size_t)tt * D) + lane;
#pragma unroll
      for (int j = 0; j < 4; ++j) { nx[j] = xp[64 * j]; ny[j] = yp[64 * j]; } }
    for (int t = t0; t < M; t += tstep) {
        const f32x4_t* lg = lg0; const f32x4_t* lb = lb0; asm volatile("" : "+v"(lg), "+v"(lb));
        const int mr = modrow(t);
        const f32x4_t* m = (const f32x4_t*)(modv + (size_t)(l * NMR + mr) * 6144) + lane;
        f32x4_t cx[4]; u32x2_t cy[4];
#pragma unroll
        for (int j = 0; j < 4; ++j) { cy[j] = ny[j]; cx[j] = (f32x4_t){__uint_as_float(nx[j][0] << 16), __uint_as_float(nx[j][0] & 0xffff0000u), __uint_as_float(nx[j][1] << 16), __uint_as_float(nx[j][1] & 0xffff0000u)}; }
        { const int tt = imin(t + tstep, M - 1); const u32x2_t* xp = (const u32x2_t*)(xs + (size_t)tt * D) + lane; const u32x2_t* yp = (const u32x2_t*)(Yb + (size_t)tt * D) + lane;
#pragma unroll
          for (int j = 0; j < 4; ++j) { nx[j] = xp[64 * j]; ny[j] = yp[64 * j]; } }
        f32x4_t v[4]; float s = 0.f;
#pragma unroll
        for (int j = 0; j < 4; ++j) { const f32x4_t gv = m[5 * 256 + 64 * j];
            const f32x4_t yv = {__uint_as_float(cy[j][0] << 16), __uint_as_float(cy[j][0] & 0xffff0000u), __uint_as_float(cy[j][1] << 16), __uint_as_float(cy[j][1] & 0xffff0000u)};
            v[j] = cx[j] * ALPHA + gv * yv; s += (v[j][0] + v[j][1]) + (v[j][2] + v[j][3]); }
        const float mu = row_sum(s) * (1.f / D);
        float q = 0.f;
#pragma unroll
        for (int j = 0; j < 4; ++j) { v[j] = v[j] - mu; q += (v[j][0] * v[j][0] + v[j][1] * v[j][1]) + (v[j][2] * v[j][2] + v[j][3] * v[j][3]); }
        const float rstd = 1.f / sqrtf(row_sum(q) * (1.f / D) + LN_EPS);
#pragma unroll
        for (int j = 0; j < 4; ++j) v[j] = v[j] * rstd * lg[64 * j] + lb[64 * j];
        if (l + 1 < DEPTH) {
            const f32x4_t* m2 = (const f32x4_t*)(modv + (size_t)((l + 1) * NMR + mr) * 6144) + lane;
            u32x2_t* xo = (u32x2_t*)(xs_o + (size_t)t * D) + lane; u32x2_t* ho = (u32x2_t*)(hb_o + (size_t)t * D) + lane;
#pragma unroll
            for (int j = 0; j < 4; ++j) { xo[64 * j] = (u32x2_t){pk_bf16(v[j][0], v[j][1]), pk_bf16(v[j][2], v[j][3])}; const f32x4_t hv = v[j] * (m2[256 + 64 * j] + 1.f) + m2[64 * j]; ho[64 * j] = (u32x2_t){pk_bf16(hv[0], hv[1]), pk_bf16(hv[2], hv[3])}; }
        } else if (t < NX) {
            f32x4_t* op = (f32x4_t*)(out_o + (size_t)t * D) + lane;
#pragma unroll
            for (int j = 0; j < 4; ++j) op[64 * j] = v[j];
        }
    }
}
#endif

#ifndef CPU_TEST
struct PuItem { u32x4_t a[8][2]; u32x4_t hw[4]; };
DEVFN void pu_idx(int (&e)[8], const int* idx, int t, int r16) {
    const i32x4_t* ip = (const i32x4_t*)(idx + (size_t)t * 128 + r16 * 8); const i32x4_t v0 = ip[0], v1 = ip[1];
    e[0] = v0[0]; e[1] = v0[1]; e[2] = v0[2]; e[3] = v0[3]; e[4] = v1[0]; e[5] = v1[1]; e[6] = v1[2]; e[7] = v1[3];
}
DEVFN void pu_rows(PuItem& it, const int (&e)[8], const unsigned char* UP, const bf16_t* hrow) {
#pragma unroll
    for (int ti = 0; ti < 8; ++ti) { const u32x4_t* rp = (const u32x4_t*)(UP + (size_t)e[ti] * 128); it.a[ti][0] = rp[0]; it.a[ti][1] = rp[1]; }
#pragma unroll
    for (int q = 0; q < 4; ++q) it.hw[q] = ((const u32x4_t*)hrow)[q];
}
DEVFN void pu_compute(const PuItem& it, float* pout, int r16, int kg) {
    unsigned bh[8], bl[8];
#pragma unroll
    for (int q = 0; q < 4; ++q) { const u32x4_t hw = it.hw[q];
#pragma unroll
        for (int i = 0; i < 2; ++i) {
            const float f0 = __uint_as_float(hw[2 * i] << 16), f1 = __uint_as_float(hw[2 * i] & 0xffff0000u), f2 = __uint_as_float(hw[2 * i + 1] << 16), f3 = __uint_as_float(hw[2 * i + 1] & 0xffff0000u);
            int wh = __builtin_amdgcn_cvt_pk_fp8_f32(f0, f1, 0, false); wh = __builtin_amdgcn_cvt_pk_fp8_f32(f2, f3, wh, true);
            const f32x2_t d01 = __builtin_amdgcn_cvt_pk_f32_fp8(wh, false), d23 = __builtin_amdgcn_cvt_pk_f32_fp8(wh, true);
            int wl = __builtin_amdgcn_cvt_pk_fp8_f32((f0 - d01[0]) * 16.f, (f1 - d01[1]) * 16.f, 0, false); wl = __builtin_amdgcn_cvt_pk_fp8_f32((f2 - d23[0]) * 16.f, (f3 - d23[1]) * 16.f, wl, true);
            bh[2 * q + i] = (unsigned)wh; bl[2 * q + i] = (unsigned)wl; } }
    f32x4_t dh[8], dl[8];
#pragma unroll
    for (int ti = 0; ti < 8; ++ti) {
        dh[ti] = (f32x4_t){0.f, 0.f, 0.f, 0.f}; dl[ti] = dh[ti];
#pragma unroll
        for (int s_ = 0; s_ < 4; ++s_) {
            const long av = (long)(((unsigned long long)it.a[ti][s_ >> 1][2 * (s_ & 1) + 1] << 32) | it.a[ti][s_ >> 1][2 * (s_ & 1)]);
            const long bhv = (long)(((unsigned long long)bh[2 * s_ + 1] << 32) | bh[2 * s_]), blv = (long)(((unsigned long long)bl[2 * s_ + 1] << 32) | bl[2 * s_]);
            dh[ti] = __builtin_amdgcn_mfma_f32_16x16x32_fp8_fp8(av, bhv, dh[ti], 0, 0, 0);
            dl[ti] = __builtin_amdgcn_mfma_f32_16x16x32_fp8_fp8(av, blv, dl[ti], 0, 0, 0);
        }
    }
    f32x4_t o = dh[0] + dl[0] * 0.0625f;
#pragma unroll
    for (int c = 1; c < 8; ++c) { const f32x4_t v = dh[c] + dl[c] * 0.0625f; o = (r16 == c) ? v : o; }
    if (r16 < 8) *(f32x4_t*)(pout + r16 * 16 + 4 * kg) = o;
}
DEVFN void ph_peer_u_mfma(const Params& p, int l, int M, int tid, int bid, int G) {
    const int lane = tid & 63, wv = __builtin_amdgcn_readfirstlane(tid >> 6), r16 = lane & 15, kg = lane >> 4, x = bid & 7;
    const unsigned char* UP = WSP(const unsigned char, WS_UV8) + (size_t)(l * 2) * PEER_N * 1024 + (size_t)x * PEER_N * 128 + kg * 32;
    const int* idx = WSP(const int, WS_IDX); const bf16_t* hb = WSP(const bf16_t, WS_HB) + x * 128 + kg * 32;
    float* part = WSP(float, WS_PART) + (size_t)x * NT * 128;
    const int nw = (G >> 3) * 8, t0 = (bid >> 3) * 8 + wv, last = M - 1;
    int eA[8], eB[8]; PuItem A, B;
    pu_idx(eA, idx, imin(t0, last), r16); pu_idx(eB, idx, imin(t0 + nw, last), r16);
    pu_rows(A, eA, UP, hb + (size_t)imin(t0, last) * D);
    for (int t = t0; t < M; t += 2 * nw) {
        pu_rows(B, eB, UP, hb + (size_t)imin(t + nw, last) * D);
        pu_idx(eA, idx, imin(t + 2 * nw, last), r16);
        pu_compute(A, part + (size_t)t * 128, r16, kg);
        pu_rows(A, eA, UP, hb + (size_t)imin(t + 2 * nw, last) * D);
        pu_idx(eB, idx, imin(t + 3 * nw, last), r16);
        if (t + nw < M) pu_compute(B, part + (size_t)(t + nw) * 128, r16, kg);
    }
}
#endif
#ifndef CPU_TEST
constexpr int AC_BUF = 18432, AC_V = 9216, AC_SCR = 2 * AC_BUF, AC_BYTES = AC_SCR + 8 * 4608;
template <bool MASKED, class F>
DEVFN void attc_sub(AttW& a, const bf16x8_t (&qf)[4], const LAS unsigned char* kb, const LAS unsigned char* vb, int sub, int lane, float c2, F bias2) {
    const int q31 = lane & 31, hi = lane >> 5;
    f32x16_t s = {};
#pragma unroll
    for (int ks = 0; ks < 4; ++ks) { const bf16x8_t kf = *(const LAS bf16x8_t*)(kb + (32 * sub + q31) * 144 + ks * 32 + hi * 16); s = __builtin_amdgcn_mfma_f32_32x32x16_bf16(kf, qf[ks], s, 0, 0, 0); }
    float mx = -1e30f;
#pragma unroll
    for (int r = 0; r < 16; ++r) { s[r] = MASKED ? s[r] * c2 + bias2(r) : s[r] * c2; mx = fmaxf(mx, s[r]); }
    { auto rr_ = __builtin_amdgcn_permlane32_swap(__float_as_uint(mx), __float_as_uint(mx), false, false); mx = fmaxf(__uint_as_float(rr_[0]), __uint_as_float(rr_[1])); }
    const float mnew = fmaxf(a.m, mx);
    if (!__all(mnew == a.m)) {
        const float alpha = __builtin_amdgcn_exp2f(a.m - mnew); a.m = mnew; a.l *= alpha;
#pragma unroll
        for (int r = 0; r < 16; ++r) { a.o0[r] *= alpha; a.o1[r] *= alpha; }
    }
    float ps = 0.f;
#pragma unroll
    for (int r = 0; r < 16; ++r) { s[r] = __builtin_amdgcn_exp2f(s[r] - mnew); ps += s[r]; }
    a.l += ps;
    const u32x4_t pw0 = (u32x4_t){pk_bf16(s[0], s[1]), pk_bf16(s[2], s[3]), pk_bf16(s[4], s[5]), pk_bf16(s[6], s[7])};
    const u32x4_t pw1 = (u32x4_t){pk_bf16(s[8], s[9]), pk_bf16(s[10], s[11]), pk_bf16(s[12], s[13]), pk_bf16(s[14], s[15])};
    const bf16x8_t pb0 = __builtin_bit_cast(bf16x8_t, pw0), pb1 = __builtin_bit_cast(bf16x8_t, pw1);
#pragma unroll
    for (int db = 0; db < 2; ++db) {
        const int swz = (4 * db + (q31 >> 3)) & 7, g0 = 8 * sub + hi;
        const LAS unsigned char* vr = vb + (32 * db + q31) * 144;
        const s16x4v a0 = *(const LAS s16x4v*)(vr + ((g0 ^ swz) << 3)), a1 = *(const LAS s16x4v*)(vr + (((g0 + 2) ^ swz) << 3)), b0 = *(const LAS s16x4v*)(vr + (((g0 + 4) ^ swz) << 3)), b1 = *(const LAS s16x4v*)(vr + (((g0 + 6) ^ swz) << 3));
        const bf16x8_t vf0 = (bf16x8_t){a0[0], a0[1], a0[2], a0[3], a1[0], a1[1], a1[2], a1[3]}, vf1 = (bf16x8_t){b0[0], b0[1], b0[2], b0[3], b1[0], b1[1], b1[2], b1[3]};
        if (db == 0) { a.o0 = __builtin_amdgcn_mfma_f32_32x32x16_bf16(vf0, pb0, a.o0, 0, 0, 0); a.o0 = __builtin_amdgcn_mfma_f32_32x32x16_bf16(vf1, pb1, a.o0, 0, 0, 0); }
        else { a.o1 = __builtin_amdgcn_mfma_f32_32x32x16_bf16(vf0, pb0, a.o1, 0, 0, 0); a.o1 = __builtin_amdgcn_mfma_f32_32x32x16_bf16(vf1, pb1, a.o1, 0, 0, 0); }
    }
}
template <bool MASKED, class F>
DEVFN void attc_win(AttW& a, const bf16x8_t (&qf)[4], const LAS unsigned char* kb, const LAS unsigned char* vb, int k0, int lane, float c2, F bias2) {
    const int q31 = lane & 31, hi = lane >> 5;
    f32x16_t s = {};
#pragma unroll
    for (int ks = 0; ks < 4; ++ks) { const bf16x8_t kf = *(const LAS bf16x8_t*)(kb + (k0 + q31) * 144 + ks * 32 + hi * 16); s = __builtin_amdgcn_mfma_f32_32x32x16_bf16(kf, qf[ks], s, 0, 0, 0); }
    float mx = -1e30f;
#pragma unroll
    for (int r = 0; r < 16; ++r) { s[r] = MASKED ? s[r] * c2 + bias2(r) : s[r] * c2; mx = fmaxf(mx, s[r]); }
    { auto rr_ = __builtin_amdgcn_permlane32_swap(__float_as_uint(mx), __float_as_uint(mx), false, false); mx = fmaxf(__uint_as_float(rr_[0]), __uint_as_float(rr_[1])); }
    const float mnew = fmaxf(a.m, mx);
    if (!__all(mnew == a.m)) {
        const float alpha = __builtin_amdgcn_exp2f(a.m - mnew); a.m = mnew; a.l *= alpha;
#pragma unroll
        for (int r = 0; r < 16; ++r) { a.o0[r] *= alpha; a.o1[r] *= alpha; }
    }
    float ps = 0.f;
#pragma unroll
    for (int r = 0; r < 16; ++r) { s[r] = __builtin_amdgcn_exp2f(s[r] - mnew); ps += s[r]; }
    a.l += ps;
    const u32x4_t pw0 = (u32x4_t){pk_bf16(s[0], s[1]), pk_bf16(s[2], s[3]), pk_bf16(s[4], s[5]), pk_bf16(s[6], s[7])};
    const u32x4_t pw1 = (u32x4_t){pk_bf16(s[8], s[9]), pk_bf16(s[10], s[11]), pk_bf16(s[12], s[13]), pk_bf16(s[14], s[15])};
    const bf16x8_t pb0 = __builtin_bit_cast(bf16x8_t, pw0), pb1 = __builtin_bit_cast(bf16x8_t, pw1);
#pragma unroll
    for (int db = 0; db < 2; ++db) {
        const int swz = (4 * db + (q31 >> 3)) & 7, g0 = (k0 >> 2) + hi;
        const LAS unsigned char* vr = vb + (32 * db + q31) * 144;
        const s16x4v a0 = *(const LAS s16x4v*)(vr + ((g0 ^ swz) << 3)), a1 = *(const LAS s16x4v*)(vr + (((g0 + 2) ^ swz) << 3)), b0 = *(const LAS s16x4v*)(vr + (((g0 + 4) ^ swz) << 3)), b1 = *(const LAS s16x4v*)(vr + (((g0 + 6) ^ swz) << 3));
        const bf16x8_t vf0 = (bf16x8_t){a0[0], a0[1], a0[2], a0[3], a1[0], a1[1], a1[2], a1[3]}, vf1 = (bf16x8_t){b0[0], b0[1], b0[2], b0[3], b1[0], b1[1], b1[2], b1[3]};
        if (db == 0) { a.o0 = __builtin_amdgcn_mfma_f32_32x32x16_bf16(vf0, pb0, a.o0, 0, 0, 0); a.o0 = __builtin_amdgcn_mfma_f32_32x32x16_bf16(vf1, pb1, a.o0, 0, 0, 0); }
        else { a.o1 = __builtin_amdgcn_mfma_f32_32x32x16_bf16(vf0, pb0, a.o1, 0, 0, 0); a.o1 = __builtin_amdgcn_mfma_f32_32x32x16_bf16(vf1, pb1, a.o1, 0, 0, 0); }
    }
}
DEVFN void attc_stage(LAS unsigned char* buf, const u32x4_t kreg, const u32x4_t vreg, int tid) {
    const int key = tid >> 3, piece = tid & 7;
    *(LAS u32x4_t*)(buf + key * 144 + piece * 16) = kreg;
    const int ko = (((key >> 2) ^ piece) << 3) + (key & 3) * 2;
#pragma unroll
    for (int e = 0; e < 4; ++e) { *(LAS bf16_t*)(buf + AC_V + (piece * 8 + 2 * e) * 144 + ko) = (bf16_t)(vreg[e] & 0xffffu); *(LAS bf16_t*)(buf + AC_V + (piece * 8 + 2 * e + 1) * 144 + ko) = (bf16_t)(vreg[e] >> 16); }
}
DEVFN void ph_swa_attn_wg(const Params& p, LAS unsigned char* lds, int tid, int bid, int G) {
    const bf16_t* Z = WSP(const bf16_t, WS_Z); bf16_t* att = WSP(bf16_t, WS_ATT); constexpr int LDZ = 1536;
    const int lane = tid & 63, wv = __builtin_amdgcn_readfirstlane(tid >> 6), q31 = lane & 31, hi = lane >> 5, key = tid >> 3, piece = tid & 7;
    constexpr int XB = SEQ / 64, CB = CL / 64, CT = CL / 64, NIT = NBAT * 4 * (XB + CB);
    const float c2 = 0.125f * LOG2E;
    for (int it = bid; it < NIT; it += G) {
        const int qb = it % (XB + CB), kvh = (it / (XB + CB)) & 3, b = it / ((XB + CB) * 4);
        const bool isx = qb < XB; const int q0 = isx ? qb * 64 : (qb - XB) * 64;
        const int hq = kvh * 4 + (wv & 3), qa = q0 + 32 * (wv >> 2);
        const size_t qtok0 = (isx ? (size_t)b * SEQ : (size_t)NX + b * CL) + qa;
        bf16x8_t qf[4]; attw_qload(qf, Z + (qtok0 + q31) * LDZ + hq * 64 + 8 * hi);
        AttW a; a.o0 = (f32x16_t){}; a.o1 = (f32x16_t){}; a.m = -1e30f; a.l = 0.f;
        const int lo = isx ? imax(0, q0 - 128) : 0, hiK = isx ? imin(SEQ - 64, q0 + 128) : -64;
        const int ntile = CT + (isx ? (hiK - lo) / 64 + 1 : 0);
        const size_t koff = 1024 + kvh * 64 + piece * 8, voff = 1280 + kvh * 64 + piece * 8;
        auto tile_tok = [&](int ti) -> size_t { return ti < CT ? (size_t)NX + b * CL + ti * 64 + key : (size_t)b * SEQ + lo + (ti - CT) * 64 + key; };
        u32x4_t kr, vr, kr2, vr2;
        { const size_t tk = tile_tok(0); kr = *(const u32x4_t*)(Z + tk * LDZ + koff); vr = *(const u32x4_t*)(Z + tk * LDZ + voff); }
        attc_stage(lds, kr, vr, tid);
        { const size_t tk = tile_tok(imin(1, ntile - 1)); kr = *(const u32x4_t*)(Z + tk * LDZ + koff); vr = *(const u32x4_t*)(Z + tk * LDZ + voff); }
        __syncthreads();
#pragma unroll 1
        for (int ti = 0; ti < ntile; ++ti) {
            const bool more = ti + 1 < ntile;
            { const size_t tk = tile_tok(imin(ti + 2, ntile - 1)); kr2 = *(const u32x4_t*)(Z + tk * LDZ + koff); vr2 = *(const u32x4_t*)(Z + tk * LDZ + voff); }
            const LAS unsigned char* kb = lds + (ti & 1) * AC_BUF; const LAS unsigned char* vb = kb + AC_V;
            if (ti < CT) {
                attc_sub<false>(a, qf, kb, vb, 0, lane, c2, [](int) { return 0.f; });
                attc_sub<false>(a, qf, kb, vb, 1, lane, c2, [](int) { return 0.f; });
            } else {
#pragma unroll
                for (int sub = 0; sub < 2; ++sub) {
                    const int ks = lo + (ti - CT) * 64 + 32 * sub;
                    if (ks + 31 >= qa - 128 && ks <= qa + 31 + 128) {
                        const int dk = ks - qa - q31 + 4 * hi;
                        if (ks + 31 - qa <= 128 && qa + 31 - ks <= 128) attc_sub<false>(a, qf, kb, vb, sub, lane, c2, [](int) { return 0.f; });
                        else attc_sub<true>(a, qf, kb, vb, sub, lane, c2, [dk](int r) { const int dd = dk + (r & 3) + 8 * (r >> 2); return (dd > 128 || dd < -128) ? -1e30f : 0.f; });
                    }
                }
            }
            if (more) attc_stage(lds + ((ti + 1) & 1) * AC_BUF, kr, vr, tid);
            kr = kr2; vr = vr2;
            __syncthreads();
        }
        const float sk2 = p.swa_sink[hq] * LOG2E, mf = fmaxf(a.m, sk2), al = __builtin_amdgcn_exp2f(a.m - mf);
        const float lt = (a.l + __shfl_xor(a.l, 32)) * al + __builtin_amdgcn_exp2f(sk2 - mf);
        attw_store(a, al / lt, lds + AC_SCR + wv * 4608, lane, att + qtok0 * D + hq * 64, D);
    }
}
DEVFN void ph_na_attn_wg(const Params& p, LAS unsigned char* lds, int tid, int bid, int G) {
    const bf16_t* Z = WSP(const bf16_t, WS_Z); bf16_t* att = WSP(bf16_t, WS_ATT); constexpr int LDZ = 3072;
    const int lane = tid & 63, wv = __builtin_amdgcn_readfirstlane(tid >> 6), q31 = lane & 31, hi = lane >> 5, key = tid >> 3, piece = tid & 7;
    constexpr int XG = NROWS / 4, CG = CL / 256, CT = CL / 64, NIT = NBAT * 16 * (XG + CG);
    const float c2 = 0.125f * LOG2E;
    for (int it = bid; it < NIT; it += G) {
        const int qg = it % (XG + CG), hq = (it / (XG + CG)) & 15, b = it / ((XG + CG) * 16);
        const bool isx = qg < XG;
        const int jb = wv & 3, rw = isx ? qg * 4 + 2 * (wv >> 2) : 0;
        const int r = rw + (q31 >> 4), c = 16 * jb + (q31 & 15);
        const size_t qtok = isx ? (size_t)b * SEQ + r * GW + c : (size_t)NX + b * CL + (qg - XG) * 256 + wv * 32 + q31;
        const size_t otok0 = isx ? (size_t)b * SEQ + rw * GW + 16 * jb : (size_t)NX + b * CL + (qg - XG) * 256 + wv * 32;
        bf16x8_t qf[4]; attw_qload(qf, Z + qtok * LDZ + hq * 64 + 8 * hi);
        AttW a; a.o0 = (f32x16_t){}; a.o1 = (f32x16_t){}; a.m = -1e30f; a.l = 0.f;
        const int rstart = iclamp(r - 4, 0, NROWS - 8), cstart = iclamp(c - 8, 0, GW - 16);
        const int wlo = iclamp(rw - 4, 0, NROWS - 8), whi = iclamp(rw + 1 - 4, 0, NROWS - 8) + 7;
        const int rmin = iclamp(qg * 4 - 4, 0, NROWS - 8), rmax = iclamp(qg * 4 + 3 - 4, 0, NROWS - 8) + 7;
        const int ntile = CT + (isx ? rmax - rmin + 1 : 0);
        const int k0 = iclamp(16 * jb - 8, 0, 32);
        const size_t koff = 1024 + hq * 64 + piece * 8, voff = 2048 + hq * 64 + piece * 8;
        auto tile_tok = [&](int ti) -> size_t { return ti < CT ? (size_t)NX + b * CL + ti * 64 + key : (size_t)b * SEQ + (rmin + ti - CT) * GW + key; };
        LAS float* rpl = (LAS float*)(lds + AC_BYTES);
        if (tid < 15 * 31) rpl[tid] = p.na_rpb[(size_t)hq * 15 * 31 + tid] * LOG2E;
        u32x4_t kr, vr, kr2, vr2;
        { const size_t tk = tile_tok(0); kr = *(const u32x4_t*)(Z + tk * LDZ + koff); vr = *(const u32x4_t*)(Z + tk * LDZ + voff); }
        attc_stage(lds, kr, vr, tid);
        { const size_t tk = tile_tok(imin(1, ntile - 1)); kr = *(const u32x4_t*)(Z + tk * LDZ + koff); vr = *(const u32x4_t*)(Z + tk * LDZ + voff); }
        __syncthreads();
#pragma unroll 1
        for (int ti = 0; ti < ntile; ++ti) {
            const bool more = ti + 1 < ntile;
            { const size_t tk = tile_tok(imin(ti + 2, ntile - 1)); kr2 = *(const u32x4_t*)(Z + tk * LDZ + koff); vr2 = *(const u32x4_t*)(Z + tk * LDZ + voff); }
            const LAS unsigned char* kb = lds + (ti & 1) * AC_BUF; const LAS unsigned char* vb = kb + AC_V;
            if (ti < CT) {
                attc_win<false>(a, qf, kb, vb, 0, lane, c2, [](int) { return 0.f; });
                attc_win<false>(a, qf, kb, vb, 32, lane, c2, [](int) { return 0.f; });
            } else {
                const int kr_ = rmin + ti - CT;
                if (kr_ >= wlo && kr_ <= whi) {
                    const bool rowok = kr_ >= rstart && kr_ < rstart + 8;
                    const LAS float* rp = rpl + iclamp(kr_ - r + 7, 0, 14) * 31 + 15 - c;
                    const int kc0 = k0 + 4 * hi;
                    attc_win<true>(a, qf, kb, vb, k0, lane, c2, [=](int rr) { const int kc = kc0 + (rr & 3) + 8 * (rr >> 2); const bool ok = rowok && kc >= cstart && kc < cstart + 16;
                        return ok ? rp[ok ? kc : c] : -1e30f; });
                }
            }
            if (more) attc_stage(lds + ((ti + 1) & 1) * AC_BUF, kr, vr, tid);
            kr = kr2; vr = vr2;
            __syncthreads();
        }
        const float lt = a.l + __shfl_xor(a.l, 32);
        attw_store(a, 1.f / lt, lds + AC_SCR + wv * 4608, lane, att + otok0 * D + hq * 64, D, isx ? GW - 16 : 0);
    }
}
#endif
#ifndef CPU_TEST
constexpr int G2_QS = 0, G2_KS = 8704, G2_KE = 17408, G2_VT = 27648, G2_D = 37888, G2_BUF = 38400;
struct HgRaw { unsigned short q[8], f[8], v[8]; };
DEVFN void hg_load(HgRaw& r, const bf16_t* Z, size_t row0, int step, int foff, int col) {
#pragma unroll
    for (int i = 0; i < 8; ++i) { const bf16_t* zr = Z + (size_t)((long)row0 + (long)i * step) * 5120 + col; r.q[i] = zr[0]; r.v[i] = zr[1024]; r.f[i] = zr[foff]; }
}
DEVFN void hg_prep(const HgRaw& r, LAS unsigned char* buf, int k, int tg, int lane) {
    float lf[8], cum[8]; float run = 0.f;
#pragma unroll
    for (int i = 0; i < 8; ++i) { lf[i] = (float)__builtin_bit_cast(_Float16, r.f[i]); run += lf[i]; cum[i] = run; }
    float p1, q2;
    { auto rr = __builtin_amdgcn_permlane16_swap(__float_as_uint(run), __float_as_uint(run), false, false); p1 = __uint_as_float((tg & 1) ? rr[0] : rr[1]); }
    const float ps = run + p1;
    { auto rr = __builtin_amdgcn_permlane32_swap(__float_as_uint(ps), __float_as_uint(ps), false, false); q2 = __uint_as_float((tg & 2) ? rr[0] : rr[1]); }
    const float off = ((tg & 1) ? p1 : 0.f) + ((tg & 2) ? q2 : 0.f), bend = ps + q2, eEnd = __expf(bend);
    unsigned kew[4], vtw[4];
#pragma unroll
    for (int i = 0; i < 8; ++i) {
        const float B = off + cum[i], eB = __expf(B), eN = __builtin_amdgcn_rcpf(eB), kk = 1.f - __expf(lf[i]);
        const int t = 8 * tg + i;
        const unsigned qs = pk_bf16(bf2f(r.q[i]) * eB, kk * eN);
        *(LAS bf16_t*)(buf + G2_QS + t * 272 + k * 2) = (bf16_t)(qs & 0xffffu);
        *(LAS bf16_t*)(buf + G2_KS + t * 272 + k * 2) = (bf16_t)(qs >> 16);
        const unsigned kv = pk_bf16(kk * eN * eEnd, 0.f) & 0xffffu, vt = r.v[i];
        if (i & 1) { kew[i >> 1] |= kv << 16; vtw[i >> 1] |= vt << 16; } else { kew[i >> 1] = kv; vtw[i >> 1] = vt; }
    }
    *(LAS u32x4_t*)(buf + G2_KE + k * 80 + tg * 16) = (u32x4_t){kew[0], kew[1], kew[2], kew[3]};
    *(LAS u32x4_t*)(buf + G2_VT + k * 80 + tg * 16) = (u32x4_t){vtw[0], vtw[1], vtw[2], vtw[3]};
    if (tg == 0) ((LAS float*)(buf + G2_D))[k] = eEnd;
}
DEVFN void ph_hgrn_scan2(const Params& p, LAS unsigned char* lds, int tid, int bid, int G) {
    if (bid >= NBAT * 16) { ph_cvt_uv_fp8(p, lds, tid, bid - NBAT * 16, G - NBAT * 16); return; }
    const int dir = bid & 1, h = (bid >> 1) & 7, b = bid >> 4;
    const bf16_t* Z = WSP(const bf16_t, WS_Z);
    bf16_t* od = WSP(bf16_t, WS_Y) + (dir ? (size_t)NT * D : 0);
    const int lane = tid & 63, w = __builtin_amdgcn_readfirstlane(tid >> 6), c16 = lane & 15, g = lane >> 4;
    const int pk = 16 * w + c16, ptg = g;
    constexpr int NCH = (CL + SEQ) / 32;
    const int foff = dir ? 3072 : 2048, step = dir ? -1 : 1;
    auto row0 = [&](int c) -> size_t { const int s = c * 32 + 8 * ptg; return s < CL ? (size_t)(NX + b * CL + (dir ? CL - 1 - s : s)) : (size_t)(b * SEQ + (dir ? SEQ - 1 - (s - CL) : s - CL)); };
    auto trow = [&](int s) -> size_t { return s < CL ? (size_t)(NX + b * CL + (dir ? CL - 1 - s : s)) : (size_t)(b * SEQ + (dir ? SEQ - 1 - (s - CL) : s - CL)); };
    f32x4v S[8];
#pragma unroll
    for (int i = 0; i < 8; ++i) S[i] = (f32x4v){0.f, 0.f, 0.f, 0.f};
    HgRaw raw;
    hg_load(raw, Z, row0(0), step, foff, h * 128 + pk);
    hg_prep(raw, lds, pk, ptg, lane);
    hg_load(raw, Z, row0(1), step, foff, h * 128 + pk);
    __syncthreads();
#pragma unroll 1
    for (int c = 0; c < NCH; ++c) {
        if (c + 1 < NCH) { hg_prep(raw, lds + ((c + 1) & 1) * G2_BUF, pk, ptg, lane); if (c + 2 < NCH) hg_load(raw, Z, row0(c + 2), step, foff, h * 128 + pk); }
        const LAS unsigned char* bf = lds + (c & 1) * G2_BUF;
        f32x4v X00 = {0.f, 0.f, 0.f, 0.f}, X01 = X00, X11 = X00;
#pragma unroll
        for (int ks = 0; ks < 4; ++ks) {
            const bf16x8_t a0 = *(const LAS bf16x8_t*)(bf + G2_KS + c16 * 272 + ks * 64 + g * 16), a1 = *(const LAS bf16x8_t*)(bf + G2_KS + (16 + c16) * 272 + ks * 64 + g * 16);
            const bf16x8_t b0 = *(const LAS bf16x8_t*)(bf + G2_QS + c16 * 272 + ks * 64 + g * 16), b1 = *(const LAS bf16x8_t*)(bf + G2_QS + (16 + c16) * 272 + ks * 64 + g * 16);
            X00 = __builtin_amdgcn_mfma_f32_16x16x32_bf16(a0, b0, X00, 0, 0, 0);
            X01 = __builtin_amdgcn_mfma_f32_16x16x32_bf16(a0, b1, X01, 0, 0, 0);
            X11 = __builtin_amdgcn_mfma_f32_16x16x32_bf16(a1, b1, X11, 0, 0, 0);
        }
#pragma unroll
        for (int r = 0; r < 4; ++r) { const bool keep = (4 * g + r) <= c16; X00[r] = keep ? X00[r] : 0.f; X11[r] = keep ? X11[r] : 0.f; }
        const u32x4_t p0w = (u32x4_t){pk_bf16(X00[0], X00[1]), pk_bf16(X00[2], X00[3]), 0u, 0u};
        const u32x4_t p1w = (u32x4_t){pk_bf16(X01[0], X01[1]), pk_bf16(X01[2], X01[3]), pk_bf16(X11[0], X11[1]), pk_bf16(X11[2], X11[3])};
        const int vrow = (16 * w + c16) * 80;
        const s16x4v vlo = *(const LAS s16x4v*)(bf + G2_VT + vrow + g * 8), vhi = *(const LAS s16x4v*)(bf + G2_VT + vrow + 32 + g * 8);
        const bf16x8_t vperm = (bf16x8_t){vlo[0], vlo[1], vlo[2], vlo[3], vhi[0], vhi[1], vhi[2], vhi[3]};
        f32x4v o0 = {0.f, 0.f, 0.f, 0.f}, o1 = o0;
        o0 = __builtin_amdgcn_mfma_f32_16x16x32_bf16(__builtin_bit_cast(bf16x8_t, p0w), vperm, o0, 0, 0, 0);
        o1 = __builtin_amdgcn_mfma_f32_16x16x32_bf16(__builtin_bit_cast(bf16x8_t, p1w), vperm, o1, 0, 0, 0);
#pragma unroll
        for (int ks = 0; ks < 4; ++ks) {
            const u32x4_t sw = (u32x4_t){pk_bf16(S[2 * ks][0], S[2 * ks][1]), pk_bf16(S[2 * ks][2], S[2 * ks][3]), pk_bf16(S[2 * ks + 1][0], S[2 * ks + 1][1]), pk_bf16(S[2 * ks + 1][2], S[2 * ks + 1][3])};
            const bf16x8_t sb = __builtin_bit_cast(bf16x8_t, sw);
            const s16x4v q0l = *(const LAS s16x4v*)(bf + G2_QS + c16 * 272 + ks * 64 + g * 8), q0h = *(const LAS s16x4v*)(bf + G2_QS + c16 * 272 + ks * 64 + 32 + g * 8);
            const s16x4v q1l = *(const LAS s16x4v*)(bf + G2_QS + (16 + c16) * 272 + ks * 64 + g * 8), q1h = *(const LAS s16x4v*)(bf + G2_QS + (16 + c16) * 272 + ks * 64 + 32 + g * 8);
            o0 = __builtin_amdgcn_mfma_f32_16x16x32_bf16((bf16x8_t){q0l[0], q0l[1], q0l[2], q0l[3], q0h[0], q0h[1], q0h[2], q0h[3]}, sb, o0, 0, 0, 0);
            o1 = __builtin_amdgcn_mfma_f32_16x16x32_bf16((bf16x8_t){q1l[0], q1l[1], q1l[2], q1l[3], q1h[0], q1h[1], q1h[2], q1h[3]}, sb, o1, 0, 0, 0);
        }
#pragma unroll
        for (int r = 0; r < 2; ++r) {
            od[trow(c * 32 + 4 * g + 2 * r) * D + h * 128 + 16 * w + c16] = f2bf(o0[2 * r]); od[trow(c * 32 + 4 * g + 2 * r + 1) * D + h * 128 + 16 * w + c16] = f2bf(o0[2 * r + 1]);
            od[trow(c * 32 + 16 + 4 * g + 2 * r) * D + h * 128 + 16 * w + c16] = f2bf(o1[2 * r]); od[trow(c * 32 + 16 + 4 * g + 2 * r + 1) * D + h * 128 + 16 * w + c16] = f2bf(o1[2 * r + 1]);
        }
        const bf16x8_t vb = *(const LAS bf16x8_t*)(bf + G2_VT + vrow + g * 16);
#pragma unroll
        for (int kt = 0; kt < 8; ++kt) {
            const f32x4v dv = *(const LAS f32x4v*)(bf + G2_D + (16 * kt + 4 * g) * 4);
            const bf16x8_t ka = *(const LAS bf16x8_t*)(bf + G2_KE + (16 * kt + c16) * 80 + g * 16);
            S[kt] = __builtin_amdgcn_mfma_f32_16x16x32_bf16(ka, vb, S[kt] * dv, 0, 0, 0);
        }
        __syncthreads();
    }
}
#endif
#define PEER_PHASES(l, M) \
    PH(GEMM_BF16(WS_HB, WS_WQ + (size_t)(l) * 2048 * D * 2, M, 2048, WS_QP, 2048)) \
    PEER_ROUTE(l, M) \
    PEER_EXPERTS(l, M)
#define PROGRAM \
    PH(PRO_A) \
    PH(H0) \
      \
    PH(GEMM_HGRN(WS_HB, WS_WIN0, NT, 5120, WS_Z, 5120)) \
    HGRN_SCAN \
    PH(HGRN_READOUT) \
    PH(GEMM_F32(WS_ATT, WS_WOUT + (size_t)0 * D * D * 2, NT, 1024, WS_Y, 1024)) \
    PH(LN1(0, NT)) \
    PEER_PHASES(0, NT) \
      \
    SWA_PROJ \
    PH(SWA_ATTN) \
    PH(GEMM_F32(WS_ATT, WS_WOUT + (size_t)1 * D * D * 2, NT, 1024, WS_Y, 1024)) \
    PH(LN1(1, NT)) \
    PEER_PHASES(1, NT) \
      \
    PH(GEMM_BF16(WS_HB, WS_WIN2, NT, 3072, WS_Z, 3072)) \
    PH(NA_ATTN) \
    PH(GEMM_F32(WS_ATT, WS_WOUT + (size_t)2 * D * D * 2, NT, 1024, WS_Y, 1024)) \
    PH(LN1(2, NT)) \
    PEER_PHASES(2, NT) \
      \
    PH(GEMM_BF16(WS_HB, WS_WIN3, NT, 1536, WS_Z, 1536)) \
    PH(GQA_PREP) \
    PH(GQA_ATTN) \
    PH(GEMM_F32(WS_ATT, WS_WOUT + (size_t)3 * D * D * 2, NX, 1024, WS_Y, 1024)) \
    PH(LN1(3, NX)) \
    PEER_PHASES(3, NX)
#ifdef CPU_TEST
#define PEER_EXPERTS(l, M) PH(ph_peer_act(p, l, M, gtid, gsize)) PH(ph_peer_out(p, l, M, gtid, gsize)) PH(ph_ln(p, l, 1, M, gtid, gsize))
#define PEER_ROUTE(l, M) PH(ph_peer_scores(p, l, M, gtid, gsize)) PH(ph_peer_combine(p, M, gtid, gsize))
#define PRO_A ph_pro_a(p, gtid, gsize)
#define H0 ph_h0(p, gtid, gsize)
#define HGRN_READOUT ph_hgrn_readout(p, gtid, gsize)
#define SWA_PROJ PH(GEMM_BF16(WS_HB, WS_WIN1, NT, 1536, WS_Z, 1536)) PH(ph_swa_rope(p, gtid, gsize))
#define GQA_PREP ph_gqa_prep(p, gtid, gsize)
#define LN1(l, M) ph_ln(p, l, 0, M, gtid, gsize)
#define HGRN_SCAN PH(ph_hgrn_gates(p, gtid, gsize)) PH(ph_hgrn_scan(p, gtid, gsize))
#define SWA_ATTN ph_swa_attn(p, gtid, gsize)
#define NA_ATTN ph_na_attn(p, gtid, gsize)
constexpr int NPHASES = 2 + 12 + 12 + 11 + 12;
#else
#define PEER_EXPERTS(l, M) PH(ph_peer_u(p, l, M, tid, bid, G)) PH(ph_peer_comb(p, l, M, gtid, gsize)) PH(ph_peer_v(p, lds, l, M, tid, bid, G)) PH(ph_ln2_gpu(p, l, M, tid, bid, G, rep_dry))
#define PEER_ROUTE(l, M) PH(ph_peer_route(p, l, M, lds, tid, bid, G))
#define PRO_A ph_pro_gpu(p, lds, tid, bid, G, gtid, gsize)
#define H0 ph_h0_gpu(p, gtid, gsize)
#define HGRN_READOUT ph_hgrn_readout_gpu(p, tid, bid, G)
#define SWA_PROJ PH(GEMM_SWA(WS_HB, WS_WIN1, NT, 1536, WS_Z, 1536))
#define GQA_PREP ph_gqa_prep_gpu(p, gtid, gsize)
#define LN1(l, M) ph_ln1_gpu(p, l, M, tid, bid, G, rep_dry)
#define HGRN_SCAN PH(ph_hgrn_scan2(p, lds, tid, bid, G))
#define SWA_ATTN ph_swa_attn_wg(p, lds, tid, bid, G)
#define NA_ATTN ph_na_attn_wg(p, lds, tid, bid, G)
constexpr int NPHASES = 2 + 11 + 10 + 10 + 11;
#endif
#ifndef CPU_TEST
constexpr int NTHREADS = 512;
constexpr int RING_BYTES = 131072, LDSCTL_OFF = RING_BYTES, LDS_BYTES = 147456;
#ifndef MK_REPEAT
#define MK_REPEAT 0
#endif
#ifndef MK_REP_K
#define MK_REP_K (-1)
#endif
#ifndef MK_REP_N
#define MK_REP_N 1
#endif
#ifndef MK_REP_MASK
#define MK_REP_MASK 0ull
#endif
#ifndef MK_PER_PHASE
#define MK_PER_PHASE 0
#endif
constexpr int CW_BAR = 4096;

__global__ void __launch_bounds__(NTHREADS, 2) mk_fwd(Params p) {
    extern __shared__ __attribute__((aligned(16))) unsigned char lds_raw[];
    LAS unsigned char* lds = (LAS unsigned char*)lds_raw;
    const int tid = threadIdx.x, bid = blockIdx.x, G = gridDim.x;
    for (int u = tid; u < (LDS_BYTES - LDSCTL_OFF) / 4; u += NTHREADS) ((LAS unsigned*)(lds + LDSCTL_OFF))[u] = 0u;
    __syncthreads();
    XcdBarrier bar; bar.bar = (unsigned*)(p.ws + WS_CTL) + CW_BAR; bar.x = 0; bar.st = nullptr;
    if (!MK_PER_PHASE) bar = xcd_barrier_post((unsigned*)(p.ws + WS_CTL) + CW_BAR, (volatile LAS unsigned*)(lds + LDSCTL_OFF));
    const size_t gsize = (size_t)G * NTHREADS;
    const int lo = p.ph_lo, hi = p.ph_hi;
    int kk = 0;
#define GEMM_BF16(Aoff, Boff, M_, N_, Ooff, ldc_) do { pg8::Gemm g{WSP(const bf16_t, Aoff), WSP(const bf16_t, Boff), M_, N_, D}; pg8::StaticOrder S; S.init(M_, N_, G, bid); \
        pg8::EpiBf16 E{WSP(bf16_t, Ooff), ldc_}; pg8::gemm_phase<pg8::EpiBf16, pg8::StaticOrder, true, true>(lds, g, S, E); } while (0)
#define GEMM_HGRN(Aoff, Boff, M_, N_, Ooff, ldc_) do { pg8::Gemm g{WSP(const bf16_t, Aoff), WSP(const bf16_t, Boff), M_, N_, D}; pg8::StaticOrder S; S.init(M_, N_, G, bid); \
        pg8::EpiHgrn E{WSP(bf16_t, Ooff), ldc_, WSP(const float, WS_LBV)}; pg8::gemm_phase<pg8::EpiHgrn, pg8::StaticOrder, true, true>(lds, g, S, E); } while (0)
#define GEMM_SWA(Aoff, Boff, M_, N_, Ooff, ldc_) do { pg8::Gemm g{WSP(const bf16_t, Aoff), WSP(const bf16_t, Boff), M_, N_, D}; pg8::StaticOrder S; S.init(M_, N_, G, bid); \
        pg8::EpiSwa E{WSP(bf16_t, Ooff), ldc_, WSP(const float, WS_ROPE) + ROPE64_COS, WSP(const float, WS_ROPE) + ROPE64_SIN, NX, SEQ, GW}; pg8::gemm_phase<pg8::EpiSwa, pg8::StaticOrder, true, true>(lds, g, S, E); } while (0)
#define GEMM_F32(Aoff, Boff, M_, N_, Ooff, ldc_) GEMM_BF16(Aoff, Boff, M_, N_, Ooff, ldc_)
#define GQA_ATTN ph_gqa_attn_mfma(p, (char*)lds_raw, bid, G)
#define PH_ONCE(...) PH_ONCE_D(0, __VA_ARGS__)
#define PH_ONCE_D(dry_, ...) { constexpr int rep_dry = dry_; (void)rep_dry; int tid = threadIdx.x; asm volatile("" : "+v"(tid)); const size_t gtid = ((size_t)(tid >> 6) * G + bid) * 64 + (tid & 63); __VA_ARGS__; }
#define PH(stmt) { const int k_ = kk++; if (lo <= k_ && k_ < hi) { \
        if (MK_REPEAT && ((MK_REP_MASK >> k_) & 1ull)) { PH_ONCE_D(1, stmt) xcd_barrier(bar); }     \
        PH_ONCE(stmt) \
        if (k_ + 1 < hi) xcd_barrier(bar); } }
    PROGRAM
#if MK_REPEAT
    for (int xb_ = 0; xb_ < MK_REP_N - 1; ++xb_) xcd_barrier(bar);
#endif
#undef PH
#undef GEMM_BF16
#undef GEMM_F32
#undef GEMM_HGRN
#undef GEMM_SWA
}

extern "C" void kernel_launch(void* const* d_in, const int* in_sizes, int n_in, void* d_out, int out_size, void* d_ws, size_t ws_size, hipStream_t stream) {
    static int grid = 0;
    if (grid == 0) {
        if (n_in != 26 || out_size != NX * D || ws_size < WS_END2) { fprintf(stderr, "kernel_launch: unexpected shapes (n_in %d out %d ws %zu need %zu)\n", n_in, out_size, ws_size, (size_t)WS_END2); grid = -1; return; }
        int dev = 0, cus = 0, per_cu = 0;
        if (hipGetDevice(&dev) != hipSuccess || hipDeviceGetAttribute(&cus, hipDeviceAttributeMultiprocessorCount, dev) != hipSuccess) { grid = -1; return; }
        if (hipFuncSetAttribute((const void*)mk_fwd, hipFuncAttributeMaxDynamicSharedMemorySize, LDS_BYTES) != hipSuccess) { fprintf(stderr, "kernel_launch: hipFuncSetAttribute failed\n"); grid = -1; return; }
        if (hipOccupancyMaxActiveBlocksPerMultiprocessor(&per_cu, (const void*)mk_fwd, NTHREADS, LDS_BYTES) != hipSuccess || per_cu < 1) { fprintf(stderr, "kernel_launch: occupancy query says %d\n", per_cu); grid = -1; return; }
        (void)hipGetLastError();
        grid = cus;
    }
    if (grid < 0) return;
    if (hipMemsetAsync((char*)d_ws + WS_CTL, 0, CTL_BYTES, stream) != hipSuccess) return;
    Params p{};
    const float** pp = (const float**)&p;
    for (int i = 0; i < 26; ++i) pp[i] = (const float*)d_in[i];
    p.out = (float*)d_out; p.ws = (unsigned char*)d_ws; p.rep_k = 0; p.rep_n = 0; p.rep_mask = 0;
#if MK_PER_PHASE
    for (int k = 0; k < NPHASES; ++k) { p.ph_lo = k; p.ph_hi = k + 1; hipLaunchKernelGGL(mk_fwd, dim3(grid), dim3(NTHREADS), LDS_BYTES, stream, p); }
#else
    p.ph_lo = 0; p.ph_hi = NPHASES;
    hipLaunchKernelGGL(mk_fwd, dim3(grid), dim3(NTHREADS), LDS_BYTES, stream, p);
#endif
}
#endif
```

```cpp
#ifdef CPU_TEST
#include <cmath>
#include <cstdio>
#include <cstdlib>
#include <cstring>
#include <cstddef>
#define DEVFN static inline
#else
#include <hip/hip_runtime.h>
#include <cstdio>
#define DEVFN __device__ __forceinline__
#endif

#ifndef CFG_BATCH
#define CFG_BATCH 8
#endif
#ifndef CFG_SEQ
#define CFG_SEQ 4096
#endif
#ifndef CFG_CTX
#define CFG_CTX 256
#endif
constexpr int D = 1024, NBAT = CFG_BATCH, SEQ = CFG_SEQ, CL = CFG_CTX;
constexpr int NX = NBAT * SEQ, NC = NBAT * CL, NT = NX + NC;
constexpr int GW = 64, NROWS = SEQ / GW;
constexpr int DEPTH = 4, NMR = NBAT + 1;
constexpr float ALPHA = 1.6817928305074290f;
constexpr float LN_EPS = 1e-5f, RMS_EPS = 1e-6f;
constexpr float LN_THETA = 9.210340371976184f;
constexpr int PEER_N = 16384;

typedef unsigned short bf16_t;
DEVFN float bf2f(bf16_t b) { const unsigned u = ((unsigned)b) << 16; return __builtin_bit_cast(float, u); }
DEVFN bf16_t f2bf(float f) { unsigned u = __builtin_bit_cast(unsigned, f); u += 0x7fffu + ((u >> 16) & 1u); return (bf16_t)(u >> 16); }
DEVFN float sigmoidf_(float x) { return 1.f / (1.f + expf(-x)); }
DEVFN float siluf_(float x) { return x / (1.f + expf(-x)); }
DEVFN float geluf_(float x) { return 0.5f * x * (1.f + tanhf(0.7978845608028654f * (x + 0.044715f * x * x * x))); }
DEVFN int imin(int a, int b) { return a < b ? a : b; }
DEVFN int imax(int a, int b) { return a > b ? a : b; }
DEVFN int iclamp(int v, int lo, int hi) { return v < lo ? lo : (v > hi ? hi : v); }

struct Params {
    const float *x, *c, *ctx, *c_ctx, *mod_w, *mod_b, *ln_g, *ln_b, *peer_wq, *peer_keys, *peer_u, *peer_v;
    const float *hgrn_w_in, *hgrn_lb, *hgrn_norm_g, *hgrn_w_out, *swa_w_in, *swa_sink, *swa_w_out;
    const float *na_w_in, *na_rpb, *na_w_out, *gqa_w_in, *gqa_q_norm, *gqa_k_norm, *gqa_w_out;
    float* out; unsigned char* ws; int ph_lo, ph_hi, rep_k, rep_n; unsigned long long rep_mask;
};

constexpr size_t al256(size_t x) { return (x + 255) & ~(size_t)255; }
constexpr size_t WS_CTL = 0, CTL_BYTES = 1u << 20;
constexpr size_t WS_MODV = WS_CTL + CTL_BYTES;
constexpr size_t WS_LBV = WS_MODV + al256((size_t)DEPTH * NMR * 6144 * 4);
constexpr size_t WS_WIN0 = WS_LBV + 4096;
constexpr size_t WS_WIN1 = WS_WIN0 + (size_t)5120 * 1024 * 2;
constexpr size_t WS_WIN2 = WS_WIN1 + (size_t)1536 * 1024 * 2;
constexpr size_t WS_WIN3 = WS_WIN2 + (size_t)3072 * 1024 * 2;
constexpr size_t WS_WOUT = WS_WIN3 + (size_t)1536 * 1024 * 2;
constexpr size_t WS_WQ = WS_WOUT + (size_t)4 * 1024 * 1024 * 2;
constexpr size_t WS_XS = WS_WQ + (size_t)4 * 2048 * 1024 * 2;
constexpr size_t WS_HB = WS_XS + (size_t)NT * 1024 * 4;
constexpr size_t WS_ATT = WS_HB + (size_t)NT * 1024 * 2;
constexpr size_t WS_Y = WS_ATT + (size_t)NT * 1024 * 2;
constexpr size_t WS_Z = WS_Y + (size_t)NT * 1024 * 4;
constexpr size_t WS_END = WS_Z + (size_t)NT * 5120 * 2;
constexpr size_t WS_QP = WS_Z;
constexpr size_t WS_IDX = WS_QP + (size_t)NT * 2048 * 2;
constexpr size_t WS_GATE = WS_IDX + (size_t)NT * 128 * 4;
constexpr size_t WS_WA = WS_GATE + (size_t)NT * 128 * 4;
constexpr size_t WS_PART = WS_WA + (size_t)NT * 128 * 4;
constexpr size_t WS_SV = WS_PART;
constexpr size_t WS_SI = WS_SV + (size_t)NT * 256 * 4;
static_assert(WS_PART + (size_t)8 * NT * 128 * 4 <= WS_END, "PEER aliases fit in Z");
constexpr size_t WS_UV8 = WS_END;
constexpr size_t WS_UVS = WS_UV8 + (size_t)8 * PEER_N * 1024;
constexpr size_t WS_KEYS = WS_UVS + (size_t)8 * PEER_N * 4;
constexpr size_t WS_ROPE = WS_KEYS + (size_t)4 * 16 * 128 * 128 * 2;
constexpr size_t ROPE64_COS = 0, ROPE64_SIN = 64 * 16, ROPE128_COS = 2 * 64 * 16, ROPE128_SIN = 2 * 64 * 16 + 64 * 32;
constexpr size_t WS_HQH = al256(WS_ROPE + (size_t)(2 * 64 * 16 + 2 * 64 * 32) * 4);
constexpr size_t WS_HQL = WS_HQH + (size_t)NT * 1024;
constexpr size_t WS_HQS = WS_HQL + (size_t)NT * 1024;
constexpr size_t WS_END2 = WS_HQS + (size_t)NT * 8 * 4;
#ifndef CPU_TEST
namespace pg8 {
#define PG8_LAS __attribute__((address_space(3)))
typedef short bf16x8 __attribute__((ext_vector_type(8)));
typedef float f32x4 __attribute__((ext_vector_type(4)));
typedef unsigned u32x4 __attribute__((ext_vector_type(4)));
constexpr int BM = 256, BK = 64, HALF = 128, HTB = HALF * BK * 2  , STAGE_BYTES = 8 * HTB, NXCD = 8, WGM = 8;

__host__ __device__ __forceinline__ int lds_byte(int r, int c) { const int st = (r >> 4) * 2 + (c >> 5), rr = r & 15, cc = c & 31, ob = rr * 64 + cc * 2; return st * 1024 + (ob ^ (((ob >> 9) & 1) << 5)); }
__host__ __device__ __forceinline__ void stage_rc(int b, int& R, int& C) { const int st = b / 1024, sb = b % 1024, swz = sb ^ (((sb >> 9) & 1) << 5); R = (st >> 1) * 16 + swz / 64; C = (st & 1) * 32 + (swz % 64) / 2; }
__host__ __device__ __forceinline__ int perm32(int rho) { const int n = rho >> 4, i = rho & 15; return 8 * (i >> 2) + 4 * n + (i & 3); }

struct Unit { int pm, pn; };
struct Gemm { const bf16_t* A; const bf16_t* Bt; int M, N, K; };

struct StaticOrder {
    int nM, nN, nwg, G, c;
    __host__ __device__ void init(int M, int N, int G_, int c_) { nM = M / BM; nN = N / BM; nwg = nM * nN; G = G_; c = c_; }
    __host__ __device__ bool next(int i, Unit& u) const {
        const long L = (long)i * G + c; if (L >= nwg) return false;
        int wgid = (int)L; { const int q = nwg / NXCD, r = nwg % NXCD, xcd = wgid % NXCD, off = wgid / NXCD; wgid = (xcd < r ? xcd * (q + 1) : r * (q + 1) + (xcd - r) * q) + off; }
        const int nig = WGM * nN, gid = wgid / nig, fm = gid * WGM, gsz = (nM - fm) < WGM ? (nM - fm) : WGM;
        u.pm = fm + ((wgid % nig) % gsz); u.pn = (wgid % nig) / gsz; return true;
    }
    __device__ __forceinline__ void a_ready(const Unit&) const {}
    __device__ __forceinline__ void done(const Unit&) const {}
};

__device__ __forceinline__ unsigned cvt_pk_bf16(float lo, float hi) { unsigned r; asm volatile("v_cvt_pk_bf16_f32 %0, %1, %2" : "=v"(r) : "v"(lo), "v"(hi)); return r; }
struct EpiF32 {
    static constexpr bool PERM = false, AFTER_DRAIN = false;
    float* C; int ldc;
    __device__ __forceinline__ void operator()(const f32x4 (&acc)[2][2][4][2], const Unit& u, int wr, int wc, int fr, int fq) const {
        const int row0 = u.pm * BM + wr * 64 + fr, col0 = u.pn * BM + wc * 32 + 4 * fq;
#pragma unroll
        for (int ai = 0; ai < 2; ++ai)
#pragma unroll
            for (int m = 0; m < 4; ++m) { float* rowp = C + (size_t)(row0 + ai * HALF + m * 16) * ldc + col0;
#pragma unroll
                for (int bj = 0; bj < 2; ++bj)
#pragma unroll
                    for (int n = 0; n < 2; ++n) *(f32x4*)(rowp + bj * HALF + n * 16) = acc[ai][bj][m][n]; }
    }
};
struct EpiBf16 {
    static constexpr bool PERM = true, AFTER_DRAIN = false;
    bf16_t* O; int ldc;
    __device__ __forceinline__ void operator()(const f32x4 (&acc)[2][2][4][2], const Unit& u, int wr, int wc, int fr, int fq) const {
        const int row0 = u.pm * BM + wr * 64 + fr, col0 = u.pn * BM + wc * 32 + 8 * fq;
#pragma unroll
        for (int ai = 0; ai < 2; ++ai)
#pragma unroll
            for (int m = 0; m < 4; ++m) { bf16_t* rowp = O + (size_t)(row0 + ai * HALF + m * 16) * ldc + col0;
#pragma unroll
                for (int bj = 0; bj < 2; ++bj) { const f32x4 v0 = acc[ai][bj][m][0], v1 = acc[ai][bj][m][1];
                    u32x4 w; w.x = cvt_pk_bf16(v0[0], v0[1]); w.y = cvt_pk_bf16(v0[2], v0[3]); w.z = cvt_pk_bf16(v1[0], v1[1]); w.w = cvt_pk_bf16(v1[2], v1[3]);
                    *(u32x4*)(rowp + bj * HALF) = w; } }
    }
};

struct EpiSwa {
    static constexpr bool PERM = true, AFTER_DRAIN = false;
    bf16_t* O; int ldc; const float* rope_cos; const float* rope_sin; int nx_rows, seq, gw;
    __device__ __forceinline__ void operator()(const f32x4 (&acc)[2][2][4][2], const Unit& u, int wr, int wc, int fr, int fq) const {
        const int row0 = u.pm * BM + wr * 64 + fr, col0 = u.pn * BM + wc * 32 + 8 * fq;
        const bool roped = u.pn < 5;
        const int axis = wc & 1, fi0 = 8 * (fq & 1); const bool second = (fq & 2) != 0;
#pragma unroll
        for (int ai = 0; ai < 2; ++ai)
#pragma unroll
            for (int m = 0; m < 4; ++m) {
                const int row = row0 + ai * HALF + m * 16;
                bf16_t* rowp = O + (size_t)row * ldc + col0;
                f32x4 c0 = {1.f, 1.f, 1.f, 1.f}, c1 = c0, s0 = {0.f, 0.f, 0.f, 0.f}, s1 = s0;
                if (roped && row < nx_rows) { const int sp = row % seq, pos = axis == 0 ? sp / gw : sp % gw;
                    c0 = *(const f32x4*)(rope_cos + pos * 16 + fi0); c1 = *(const f32x4*)(rope_cos + pos * 16 + fi0 + 4); s0 = *(const f32x4*)(rope_sin + pos * 16 + fi0); s1 = *(const f32x4*)(rope_sin + pos * 16 + fi0 + 4);
                    if (!second) { s0 = -s0; s1 = -s1; } }
#pragma unroll
                for (int bj = 0; bj < 2; ++bj) { f32x4 v0 = acc[ai][bj][m][0], v1 = acc[ai][bj][m][1];
                    f32x4 p0, p1;
#pragma unroll
                    for (int j = 0; j < 4; ++j) {
                        auto r0 = __builtin_amdgcn_permlane32_swap(__float_as_uint(v0[j]), __float_as_uint(v0[j]), false, false); p0[j] = __uint_as_float(second ? r0[0] : r0[1]);
                        auto r1 = __builtin_amdgcn_permlane32_swap(__float_as_uint(v1[j]), __float_as_uint(v1[j]), false, false); p1[j] = __uint_as_float(second ? r1[0] : r1[1]); }
                    v0 = v0 * c0 + p0 * s0; v1 = v1 * c1 + p1 * s1;
                    u32x4 w; w.x = cvt_pk_bf16(v0[0], v0[1]); w.y = cvt_pk_bf16(v0[2], v0[3]); w.z = cvt_pk_bf16(v1[0], v1[1]); w.w = cvt_pk_bf16(v1[2], v1[3]);
                    *(u32x4*)(rowp + bj * HALF) = w; }
            }
    }
};
typedef _Float16 f16x2 __attribute__((ext_vector_type(2)));
typedef float f32x2e __attribute__((ext_vector_type(2)));
struct EpiHgrn {
    static constexpr bool PERM = true, AFTER_DRAIN = false;
    bf16_t* O; int ldc; const float* lbv;
    __device__ __forceinline__ void operator()(const f32x4 (&acc)[2][2][4][2], const Unit& u, int wr, int wc, int fr, int fq) const {
        const int row0 = u.pm * BM + wr * 64 + fr, col0 = u.pn * BM + wc * 32 + 8 * fq, kind = u.pn >> 2;
#pragma unroll
        for (int bj = 0; bj < 2; ++bj) {
            float lb[8];
            if (kind == 2 || kind == 3) { const f32x4 l0 = *(const f32x4*)(lbv + ((col0 + bj * HALF) & 1023)), l1 = *(const f32x4*)(lbv + ((col0 + bj * HALF) & 1023) + 4);
#pragma unroll
                for (int j = 0; j < 4; ++j) { lb[j] = l0[j]; lb[4 + j] = l1[j]; } }
#pragma unroll
            for (int ai = 0; ai < 2; ++ai)
#pragma unroll
                for (int m = 0; m < 4; ++m) {
                    bf16_t* rowp = O + (size_t)(row0 + ai * HALF + m * 16) * ldc + col0 + bj * HALF;
                    float v[8];
#pragma unroll
                    for (int j = 0; j < 4; ++j) { v[j] = acc[ai][bj][m][0][j]; v[4 + j] = acc[ai][bj][m][1][j]; }
                    u32x4 w;
                    if (kind == 2 || kind == 3) {
#pragma unroll
                        for (int j = 0; j < 4; ++j) { const float f0 = lb[2 * j] + (1.f - lb[2 * j]) * __builtin_amdgcn_rcpf(1.f + __expf(-v[2 * j])), f1 = lb[2 * j + 1] + (1.f - lb[2 * j + 1]) * __builtin_amdgcn_rcpf(1.f + __expf(-v[2 * j + 1]));
                            const f32x2e lf = {__logf(f0), __logf(f1)}; w[j] = __builtin_bit_cast(unsigned, __builtin_convertvector(lf, f16x2)); }
                    } else {
                        if (kind == 0) {
#pragma unroll
                            for (int j = 0; j < 8; ++j) v[j] = v[j] * __builtin_amdgcn_rcpf(1.f + __expf(-v[j]));
                        }
                        w.x = cvt_pk_bf16(v[0], v[1]); w.y = cvt_pk_bf16(v[2], v[3]); w.z = cvt_pk_bf16(v[4], v[5]); w.w = cvt_pk_bf16(v[6], v[7]);
                    }
                    *(u32x4*)rowp = w;
                }
        }
    }
};

template <class Epi, class Sched, bool ALIGN_EPI = false, bool SP2 = false>
__device__ __forceinline__ void gemm_phase(PG8_LAS unsigned char* lds, const Gemm g, const Sched& S, const Epi& E) {
    const int tid = threadIdx.x, wid = __builtin_amdgcn_readfirstlane(tid >> 6), lane = tid & 63, wr = wid >> 2, wc = wid & 3, fr = lane & 15, fq = lane >> 4;
    const int K = g.K, nt = K / BK;
    unsigned voffA[2], voffB[2];
#pragma unroll
    for (int i = 0; i < 2; ++i) { int R, C; stage_rc(tid * 16 + i * 8192, R, C); const int Rb = Epi::PERM ? ((R & ~31) + perm32(R & 31)) : R;
        voffA[i] = (unsigned)(R * K + C) * 2u; voffB[i] = (unsigned)(Rb * K + C) * 2u; }
    const size_t kstep = (size_t)(BK * 2);
    const size_t hstep = (size_t)HALF * K * 2;
    const size_t tstep = 2 * hstep;
    const unsigned ldsw = (unsigned)wid * 1024u;
    const int aoff = lds_byte(wr * 64 + fr, fq * 8), boff = lds_byte(wc * 32 + fr, fq * 8);
#define PG8_SA(b, h) (((b) * 2 + (h)) * HTB)
#define PG8_SB(b, h) ((4 + (b) * 2 + (h)) * HTB)
#define PG8_STAGE(bufoff, gbase, voff) do { _Pragma("unroll") for (int _i = 0; _i < 2; ++_i) \
        __builtin_amdgcn_global_load_lds((const unsigned*)((const char*)(gbase) + (voff)[_i]), (PG8_LAS unsigned*)(lds + (bufoff) + ldsw + _i * 8192), 16, 0, 0); } while (0)
#define PG8_LDA(dst, b, h) do { _Pragma("unroll") for (int m = 0; m < 4; ++m) _Pragma("unroll") for (int k = 0; k < 2; ++k) dst[m][k] = *(const PG8_LAS bf16x8*)(lds + PG8_SA(b, h) + aoff + m * 2048 + k * 1024); } while (0)
#define PG8_LDB(dst, b, h) do { _Pragma("unroll") for (int n = 0; n < 2; ++n) _Pragma("unroll") for (int k = 0; k < 2; ++k) dst[n][k] = *(const PG8_LAS bf16x8*)(lds + PG8_SB(b, h) + boff + n * 2048 + k * 1024); } while (0)
#define PG8_MMA(ai, bj, At, Bt) do { __builtin_amdgcn_s_setprio(1); _Pragma("unroll") for (int m = 0; m < 4; ++m) _Pragma("unroll") for (int n = 0; n < 2; ++n) _Pragma("unroll") for (int k = 0; k < 2; ++k) \
        acc[ai][bj][m][n] = __builtin_amdgcn_mfma_f32_16x16x32_bf16(Bt[n][k], At[m][k], acc[ai][bj][m][n], 0, 0, 0); __builtin_amdgcn_s_setprio(0); } while (0)
#define PG8_WAIT_V(n) asm volatile("s_waitcnt vmcnt(" #n ")" ::: "memory")
#define PG8_WAIT_L(n) asm volatile("s_waitcnt lgkmcnt(" #n ")" ::: "memory")
#define PG8_BAR __builtin_amdgcn_s_barrier()
#define PG8_SCHED __builtin_amdgcn_sched_barrier(0)
    Unit cur, nxt; int ui = 0;
    if (!S.next(0, cur)) return;
    f32x4 acc[2][2][4][2];
#pragma unroll
    for (int a = 0; a < 2; ++a)
#pragma unroll
        for (int b = 0; b < 2; ++b)
#pragma unroll
            for (int m = 0; m < 4; ++m)
#pragma unroll
                for (int n = 0; n < 2; ++n) acc[a][b][m][n] = (f32x4){0.f, 0.f, 0.f, 0.f};
    bf16x8 At[4][2], B0[2][2], B1[2][2];
    const char* cA = (const char*)g.A + (size_t)cur.pm * tstep; const char* cB = (const char*)g.Bt + (size_t)cur.pn * tstep;
    S.a_ready(cur);
    if constexpr (SP2) {
        PG8_STAGE(PG8_SB(0, 0), cB, voffB); PG8_STAGE(PG8_SB(0, 1), cB + hstep, voffB); PG8_STAGE(PG8_SA(0, 0), cA, voffA); PG8_STAGE(PG8_SA(0, 1), cA + hstep, voffA);
        if (wr == 1) PG8_BAR;
        PG8_WAIT_V(2); PG8_BAR;
        PG8_STAGE(PG8_SB(1, 0), cB + kstep, voffB); PG8_STAGE(PG8_SA(1, 0), cA + kstep, voffA); PG8_STAGE(PG8_SB(1, 1), cB + hstep + kstep, voffB);
        PG8_WAIT_V(6); PG8_BAR;
    } else {
        PG8_STAGE(PG8_SB(0, 0), cB, voffB); PG8_STAGE(PG8_SA(0, 0), cA, voffA); PG8_STAGE(PG8_SB(0, 1), cB + hstep, voffB); PG8_STAGE(PG8_SA(0, 1), cA + hstep, voffA);
        if (wr == 1) PG8_BAR;
        PG8_WAIT_V(4); PG8_BAR;
        PG8_STAGE(PG8_SB(1, 0), cB + kstep, voffB); PG8_STAGE(PG8_SA(1, 0), cA + kstep, voffA); PG8_STAGE(PG8_SB(1, 1), cB + hstep + kstep, voffB);
        PG8_WAIT_V(6); PG8_BAR;
    }
    for (;;) {
        const bool has_next = S.next(ui + 1, nxt);
        const char* nA = has_next ? (const char*)g.A + (size_t)nxt.pm * tstep : cA; const char* nB = has_next ? (const char*)g.Bt + (size_t)nxt.pn * tstep : cB;
        for (int t = 0; t < nt; t += 2) {
            const bool last = (t == nt - 2);
            const char* a1 = cA + (size_t)(t + 1) * kstep;
            const char* a2 = last ? nA : cA + (size_t)(t + 2) * kstep; const char* b2 = last ? nB : cB + (size_t)(t + 2) * kstep;
            const char* a3 = a2 + kstep; const char* b3 = b2 + kstep;
            if (last && has_next) S.a_ready(nxt);
            if constexpr (SP2) {
            PG8_LDB(B0, 0, 0); PG8_LDB(B1, 0, 1); PG8_SCHED; PG8_LDA(At, 0, 0); PG8_STAGE(PG8_SA(1, 1), a1 + hstep, voffA);
            PG8_WAIT_V(8); PG8_WAIT_L(0); PG8_BAR; PG8_MMA(0, 0, At, B0); PG8_MMA(0, 1, At, B1); PG8_BAR; PG8_SCHED;
            PG8_LDA(At, 0, 1); PG8_STAGE(PG8_SB(0, 0), b2, voffB); PG8_STAGE(PG8_SB(0, 1), b2 + hstep, voffB); PG8_STAGE(PG8_SA(0, 0), a2, voffA);
            PG8_WAIT_V(8); PG8_WAIT_L(0); PG8_BAR; PG8_MMA(1, 0, At, B0); PG8_MMA(1, 1, At, B1); PG8_BAR; PG8_SCHED;
            PG8_LDB(B0, 1, 0); PG8_LDB(B1, 1, 1); PG8_SCHED; PG8_LDA(At, 1, 0); PG8_STAGE(PG8_SA(0, 1), a2 + hstep, voffA);
            PG8_WAIT_V(8); PG8_WAIT_L(0); PG8_BAR; PG8_MMA(0, 0, At, B0); PG8_MMA(0, 1, At, B1); PG8_BAR; PG8_SCHED;
            PG8_LDA(At, 1, 1); PG8_STAGE(PG8_SB(1, 0), b3, voffB); PG8_STAGE(PG8_SB(1, 1), b3 + hstep, voffB); PG8_STAGE(PG8_SA(1, 0), a3, voffA);
            PG8_WAIT_V(8); PG8_WAIT_L(0); PG8_BAR; PG8_MMA(1, 0, At, B0); PG8_MMA(1, 1, At, B1); PG8_BAR; PG8_SCHED;
            } else {
            PG8_LDB(B0, 0, 0); PG8_SCHED; PG8_LDA(At, 0, 0); PG8_STAGE(PG8_SA(1, 1), a1 + hstep, voffA);
            PG8_WAIT_L(8); PG8_BAR; PG8_WAIT_L(0); PG8_MMA(0, 0, At, B0); PG8_BAR; PG8_SCHED;
            PG8_LDB(B1, 0, 1); PG8_STAGE(PG8_SB(0, 0), b2, voffB);
            PG8_BAR; PG8_WAIT_L(0); PG8_MMA(0, 1, At, B1); PG8_BAR;
            PG8_LDA(At, 0, 1); PG8_STAGE(PG8_SA(0, 0), a2, voffA);
            PG8_BAR; PG8_WAIT_L(0); PG8_MMA(1, 0, At, B0); PG8_BAR; PG8_SCHED;
            PG8_STAGE(PG8_SB(0, 1), b2 + hstep, voffB);
            PG8_WAIT_V(6); PG8_BAR; PG8_MMA(1, 1, At, B1); PG8_BAR;
            PG8_LDB(B0, 1, 0); PG8_SCHED; PG8_LDA(At, 1, 0); PG8_STAGE(PG8_SA(0, 1), a2 + hstep, voffA);
            PG8_WAIT_L(8); PG8_BAR; PG8_WAIT_L(0); PG8_MMA(0, 0, At, B0); PG8_BAR; PG8_SCHED;
            PG8_LDB(B1, 1, 1); PG8_STAGE(PG8_SB(1, 0), b3, voffB);
            PG8_BAR; PG8_WAIT_L(0); PG8_MMA(0, 1, At, B1); PG8_BAR;
            PG8_LDA(At, 1, 1); PG8_STAGE(PG8_SA(1, 0), a3, voffA);
            PG8_BAR; PG8_WAIT_L(0); PG8_MMA(1, 0, At, B0); PG8_BAR; PG8_SCHED;
            PG8_STAGE(PG8_SB(1, 1), b3 + hstep, voffB);
            PG8_WAIT_V(6); PG8_BAR; PG8_MMA(1, 1, At, B1); PG8_BAR;
            }
        }
        if constexpr (ALIGN_EPI) { if (wr == 0) PG8_BAR; }
        if constexpr (!Epi::AFTER_DRAIN) { E(acc, cur, wr, wc, fr, fq); S.done(cur); }
        if (!has_next) break;
#pragma unroll
        for (int a = 0; a < 2; ++a)
#pragma unroll
            for (int b = 0; b < 2; ++b)
#pragma unroll
                for (int m = 0; m < 4; ++m)
#pragma unroll
                    for (int n = 0; n < 2; ++n) acc[a][b][m][n] = (f32x4){0.f, 0.f, 0.f, 0.f};
        cur = nxt; cA = nA; cB = nB; ++ui;
        if constexpr (ALIGN_EPI) { if (wr == 1) PG8_BAR; }
    }
    PG8_WAIT_V(0);
    if constexpr (!ALIGN_EPI) { if (wr == 0) PG8_BAR; }
    PG8_BAR;
    if constexpr (Epi::AFTER_DRAIN) { E.fused(acc, cur, wr, wc, fr, fq, lds, wid, lane); S.done(cur); }
#undef PG8_SA
#undef PG8_SB
#undef PG8_STAGE
#undef PG8_LDA
#undef PG8_LDB
#undef PG8_MMA
#undef PG8_WAIT_V
#undef PG8_WAIT_L
#undef PG8_BAR
#undef PG8_SCHED
}
}

#include <cstdio>
#include <ctime>
#include <cstdlib>
#include <cstring>
#include <cmath>
#include <vector>
#include <algorithm>
#define CK(x) do { hipError_t e_ = (x); if (e_ != hipSuccess) { fprintf(stderr, "HIP %s:%d %s\n", __FILE__, __LINE__, hipGetErrorString(e_)); exit(2); } } while (0)
typedef unsigned short u16;

#endif
#ifndef CPU_TEST
#define XB_TMO      128
#define XB_XCNT(j)  (256  + 64 * (j))
#define XB_XSUB(j)  (1280 + 64 * (j))
#define XB_XGEN(j)  (2304 + 64 * (j))
#define XB_TOP      3328
#define XB_TOPGEN   3392
#define XCD_BAR_WORDS 3456
#define XB_SPIN_CAP (1u << 22)
#define LAS __attribute__((address_space(3)))

__device__ __forceinline__ unsigned xb_ld(unsigned* p)              { return __hip_atomic_load(p, __ATOMIC_RELAXED, __HIP_MEMORY_SCOPE_AGENT); }
__device__ __forceinline__ unsigned xb_add(unsigned* p, unsigned v) { return __hip_atomic_fetch_add(p, v, __ATOMIC_RELAXED, __HIP_MEMORY_SCOPE_AGENT); }
__device__ __forceinline__ unsigned xb_xcc_id() { return (unsigned)__builtin_amdgcn_s_getreg((3 << 11) | 20) & 0xFu; }
#define XB_SPIN(cond, bar) do { unsigned _sp = 0; while (cond) { __builtin_amdgcn_s_sleep(1); \
    if ((++_sp & 255u) == 0u) { if (xb_ld(&(bar)[XB_TMO])) break; if (_sp > XB_SPIN_CAP) { atomicAdd(&(bar)[XB_TMO], 1u); break; } } } } while (0)

struct XcdBarrier {
    unsigned* bar; unsigned x;
    volatile LAS unsigned* st;
};

__device__ __forceinline__ XcdBarrier xcd_barrier_post(unsigned* bar, volatile LAS unsigned* st) {
    XcdBarrier b; b.bar = bar; b.x = xb_xcc_id(); b.st = st;
    if (threadIdx.x == 0) (void)xb_add(&bar[XB_XCNT(b.x)], 1u);
    return b;
}
__device__ __forceinline__ void xcd_barrier_complete(unsigned* bar, unsigned x, unsigned& nloc, unsigned& nx) {
    const unsigned G = gridDim.x * gridDim.y * gridDim.z;
    unsigned sum, cnt, mine, sp = 0u;
    for (;;) {
        sum = 0u; cnt = 0u; mine = 0u;
#pragma unroll
        for (unsigned j = 0; j < 16; ++j) { const unsigned c = xb_ld(&bar[XB_XCNT(j)]); sum += c; cnt += (c > 0u) ? 1u : 0u; mine = (j == x) ? c : mine; }
        if (sum == G) break;
        __builtin_amdgcn_s_sleep(1);
        if ((++sp & 255u) == 0u) { if (xb_ld(&bar[XB_TMO])) break; if (sp > XB_SPIN_CAP) { atomicAdd(&bar[XB_TMO], 1u); break; } }
    }
    nloc = mine > 0u ? mine : 1u; nx = cnt > 0u ? cnt : 1u;
}

__device__ __forceinline__ void xcd_barrier(const XcdBarrier& b) {
    asm volatile("s_waitcnt vmcnt(0)" ::: "memory");
    __syncthreads();
    if (threadIdx.x == 0) {
        unsigned* bar = b.bar;
        __builtin_amdgcn_s_waitcnt(0);
        unsigned nloc = b.st[0], nx = b.st[1];
        if (nloc == 0u) { xcd_barrier_complete(bar, b.x, nloc, nx); b.st[0] = nloc; b.st[1] = nx; }
        const unsigned old = xb_add(&bar[XB_XSUB(b.x)], 1u);
        const unsigned gen = old / nloc;
        if (old + 1u == (gen + 1u) * nloc) {
            __builtin_amdgcn_fence(__ATOMIC_RELEASE, "agent");
            asm volatile("s_waitcnt vmcnt(0)" ::: "memory");
            const unsigned og = xb_add(&bar[XB_TOP], 1u);
            const unsigned tg = og / nx;
            if (og + 1u == (tg + 1u) * nx) xb_add(&bar[XB_TOPGEN], 1u);
            else XB_SPIN(xb_ld(&bar[XB_TOPGEN]) == tg, bar);
            __builtin_amdgcn_fence(__ATOMIC_ACQUIRE, "agent");
            xb_add(&bar[XB_XGEN(b.x)], 1u);
            asm volatile("s_waitcnt vmcnt(0)" ::: "memory");
        } else {
            XB_SPIN(xb_ld(&bar[XB_XGEN(b.x)]) == gen, bar);
            __builtin_amdgcn_fence(__ATOMIC_ACQUIRE, "agent");
            asm volatile("s_waitcnt vmcnt(0)" ::: "memory");
        }
    }
    __syncthreads();
}

#endif
#ifndef CPU_TEST
namespace att128 {
using bf16 = bf16_t;
constexpr int   D = 128, NW = 8, QBLK = 32, KVBLK = 64;
constexpr float SCALE = 0.088388347648318440f;
constexpr float THR = 8.f;
constexpr int SDEPTH = 2;
constexpr int LDQ = 1536, LDK = 1536, LDO = 1024;
constexpr size_t SHM_V = KVBLK * D * 2, SHM_K = KVBLK * D * 2, SHM_ATTN = 2 * SHM_V + 2 * SHM_K + NW * 64 * 4;
using bf16x8 = __attribute__((ext_vector_type(8))) short;
using s16x4  = __attribute__((ext_vector_type(4))) short;
using f32x16 = __attribute__((ext_vector_type(16))) float;
using f32x8  = __attribute__((ext_vector_type(8))) float;
using u32x4  = __attribute__((ext_vector_type(4))) unsigned;
#define KSWZ(row, colB) ((row) * 256 + ((colB) ^ (((row) & 7) << 4)))
#define SBAR() __builtin_amdgcn_sched_barrier(0)
__device__ __forceinline__ int crow(int r, int hi) { return (r & 3) + 8 * (r >> 2) + 4 * hi; }
__device__ __forceinline__ unsigned cvtpk(float lo, float hi) {
  unsigned r; asm volatile("v_cvt_pk_bf16_f32 %0, %1, %2" : "=v"(r) : "v"(lo), "v"(hi)); return r;
}
template <typename TIn> struct Stage;
template <> struct Stage<bf16>  { using T = bf16x8;
  __device__ static __forceinline__ T ld8(const bf16* p) { return *reinterpret_cast<const bf16x8*>(p); }
  __device__ static __forceinline__ bf16x8 tobf(T x) { return x; } };
template <> struct Stage<float> { using T = f32x8;
  __device__ static __forceinline__ T ld8(const float* p) { return *reinterpret_cast<const f32x8*>(p); }
  __device__ static __forceinline__ bf16x8 tobf(T x) {
    u32x4 w = {cvtpk(x[0], x[1]), cvtpk(x[2], x[3]), cvtpk(x[4], x[5]), cvtpk(x[6], x[7])}; return *reinterpret_cast<bf16x8*>(&w); } };

__device__ __forceinline__ void partialSM(f32x16& p0, f32x16& p1, float& m_reg, float& mn, float& alpha) {
  constexpr float C = SCALE * 1.4426950408889634f;
  float pmax = p0[0]; for (int r = 1; r < 16; ++r) pmax = fmaxf(pmax, p0[r]); for (int r = 0; r < 16; ++r) pmax = fmaxf(pmax, p1[r]);
  { auto rr = __builtin_amdgcn_permlane32_swap(__float_as_uint(pmax), __float_as_uint(pmax), false, false);
    pmax = fmaxf(__uint_as_float(rr[0]), __uint_as_float(rr[1])); }
  if (__builtin_expect(__all(pmax - m_reg <= THR / SCALE), 1)) { mn = m_reg; alpha = 1.f; }
  else { mn = fmaxf(m_reg, pmax); alpha = __builtin_amdgcn_exp2f((m_reg - mn) * C); m_reg = mn; }
  float mnC = -mn * C;
  for (int r = 0; r < 16; ++r) p0[r] = fmaf(p0[r], C, mnC); for (int r = 0; r < 16; ++r) p1[r] = fmaf(p1[r], C, mnC);
  for (int r = 0; r < 16; ++r) p0[r] = __builtin_amdgcn_exp2f(p0[r]);
}
__device__ __forceinline__ void finishSM(f32x16& p0, f32x16& p1, float alpha, float& l_reg, bf16x8& pa0, bf16x8& pa1, bf16x8& pa2, bf16x8& pa3) {
  for (int r = 0; r < 16; ++r) p1[r] = __builtin_amdgcn_exp2f(p1[r]);
  float ps = 0; for (int r = 0; r < 16; ++r) ps += p0[r]; for (int r = 0; r < 16; ++r) ps += p1[r];
  { auto rr = __builtin_amdgcn_permlane32_swap(__float_as_uint(ps), __float_as_uint(ps), false, false);
    ps = __uint_as_float(rr[0]) + __uint_as_float(rr[1]); }
  l_reg = l_reg * alpha + ps;
#define PK4(P, BASE, OUT) do { unsigned a0 = cvtpk(P[BASE + 0], P[BASE + 1]), a1 = cvtpk(P[BASE + 2], P[BASE + 3]);   \
    unsigned b0 = cvtpk(P[BASE + 4], P[BASE + 5]), b1 = cvtpk(P[BASE + 6], P[BASE + 7]);                              \
    auto r0 = __builtin_amdgcn_permlane32_swap(a0, b0, false, false); auto r1 = __builtin_amdgcn_permlane32_swap(a1, b1, false, false); \
    u32x4 w = {r0[0], r1[0], r0[1], r1[1]}; OUT = *reinterpret_cast<bf16x8*>(&w); } while (0)
  PK4(p0, 0, pa0); PK4(p0, 8, pa1); PK4(p1, 0, pa2); PK4(p1, 8, pa3);
#undef PK4
}
__device__ __forceinline__ void qkt(f32x16& p0, f32x16& p1, const bf16* Ks, const bf16x8* qr, int r32, int hi) {
  p0 = f32x16{}; p1 = f32x16{};
  for (int d0 = 0; d0 < 8; ++d0) { int cb = (d0 * 16 + hi * 8) * 2;
    bf16x8 b0 = *reinterpret_cast<const bf16x8*>((const char*)Ks + KSWZ(r32, cb));
    bf16x8 b1 = *reinterpret_cast<const bf16x8*>((const char*)Ks + KSWZ(32 + r32, cb));
    p0 = __builtin_amdgcn_mfma_f32_32x32x16_bf16(b0, qr[d0], p0, 0, 0, 0);
    p1 = __builtin_amdgcn_mfma_f32_32x32x16_bf16(b1, qr[d0], p1, 0, 0, 0); }
}
__device__ __forceinline__ int v_st(int k, int c) { const int kk = (k & ~0xC) | ((k & 4) << 1) | ((k & 8) >> 1); return ((kk >> 3) * 4 + (c >> 5)) * 512 + ((kk & 7) * 32 + (c & 31)) * 2; }
__device__ __forceinline__ int v_rd_base(int lane) { return ((lane & 3) << 3) | (((lane >> 2) & 3) << 6) | (((lane >> 4) & 1) << 5) | (((lane >> 5) & 1) << 8); }
constexpr int v_rd_off(int d0, int ks, int half) { return d0 * 512 + ks * 4096 + half * 2048; }
template <int OFF> __device__ __forceinline__ s16x4 tr_read(int vb) {
  s16x4 r; asm volatile("ds_read_b64_tr_b16 %0, %1 offset:%2" : "=&v"(r) : "v"(vb), "i"(OFF) : "memory"); return r;
}
template <int D0> __device__ __forceinline__ void pv_one(f32x16& od, int vb, bf16x8 pa0, bf16x8 pa1, bf16x8 pa2, bf16x8 pa3) {
  const s16x4 l0 = tr_read<v_rd_off(D0, 0, 0)>(vb), h0 = tr_read<v_rd_off(D0, 0, 1)>(vb), l1 = tr_read<v_rd_off(D0, 1, 0)>(vb), h1 = tr_read<v_rd_off(D0, 1, 1)>(vb);
  const s16x4 l2 = tr_read<v_rd_off(D0, 2, 0)>(vb), h2 = tr_read<v_rd_off(D0, 2, 1)>(vb), l3 = tr_read<v_rd_off(D0, 3, 0)>(vb), h3 = tr_read<v_rd_off(D0, 3, 1)>(vb);
  asm volatile("s_waitcnt lgkmcnt(0)" ::: "memory"); SBAR();
#define PK(L, H) (bf16x8){L[0], L[1], L[2], L[3], H[0], H[1], H[2], H[3]}
  od = __builtin_amdgcn_mfma_f32_32x32x16_bf16(pa0, PK(l0, h0), od, 0, 0, 0);
  od = __builtin_amdgcn_mfma_f32_32x32x16_bf16(pa1, PK(l1, h1), od, 0, 0, 0);
  od = __builtin_amdgcn_mfma_f32_32x32x16_bf16(pa2, PK(l2, h2), od, 0, 0, 0);
  od = __builtin_amdgcn_mfma_f32_32x32x16_bf16(pa3, PK(l3, h3), od, 0, 0, 0);
#undef PK
}
__device__ __forceinline__ void pv_d0(f32x16* o, int vb, bf16x8 pa0, bf16x8 pa1, bf16x8 pa2, bf16x8 pa3) {
  pv_one<0>(o[0], vb, pa0, pa1, pa2, pa3); pv_one<1>(o[1], vb, pa0, pa1, pa2, pa3); pv_one<2>(o[2], vb, pa0, pa1, pa2, pa3); pv_one<3>(o[3], vb, pa0, pa1, pa2, pa3);
}

template <typename TQ>
__device__ __forceinline__ void attn_dense_body(const TQ* __restrict__ Qb, const bf16* __restrict__ Kh, const bf16* __restrict__ Vh, const bf16* __restrict__ Kc, const bf16* __restrict__ Vc,
                                                bf16* __restrict__ Ob, int seq, char* lds, const float* __restrict__ qn, const float* __restrict__ rcos, const float* __restrict__ rsin, int s0) {
  using St = Stage<bf16>; using SQ = Stage<TQ>;
  const int tid = threadIdx.x, wid = tid >> 6, lane = tid & 63, r32 = lane & 31, hi = lane >> 5;
  bf16* V_lds = (bf16*)lds; bf16* K_lds = (bf16*)(lds + 2 * SHM_V);
  float* ws = (float*)(lds + 2 * SHM_V + 2 * SHM_K) + wid * 64; float* li_l = ws; float* al_l = ws + 32;
  float m_reg = -1e30f, l_reg = 0; f32x16 o[4] = {}; bf16x8 qr[8];
  const TQ* Qw = Qb + (long)(wid * QBLK + r32) * LDQ + hi * 8;
#pragma unroll
  for (int d0 = 0; d0 < 8; ++d0) qr[d0] = SQ::tobf(SQ::ld8(Qw + d0 * 16));
  {
    float xf[8][8]; float ss = 0.f;
#pragma unroll
    for (int d0 = 0; d0 < 8; ++d0)
#pragma unroll
      for (int e = 0; e < 8; ++e) { xf[d0][e] = __uint_as_float((unsigned)(unsigned short)qr[d0][e] << 16); ss += xf[d0][e] * xf[d0][e]; }
    { auto rr = __builtin_amdgcn_permlane32_swap(__float_as_uint(ss), __float_as_uint(ss), false, false); ss = __uint_as_float(rr[0]) + __uint_as_float(rr[1]); }
    const float rn = 1.f / sqrtf(ss * (1.f / 128.f) + RMS_EPS);
#pragma unroll
    for (int d0 = 0; d0 < 8; ++d0) { const float* gq = qn + d0 * 16 + hi * 8;
#pragma unroll
      for (int e = 0; e < 8; ++e) xf[d0][e] = xf[d0][e] * rn * gq[e]; }
    const int sq = s0 + wid * QBLK + r32, pos0 = sq / GW, pos1 = sq % GW;
#pragma unroll
    for (int d0 = 0; d0 < 8; ++d0) if ((d0 & 2) == 0) {
      const int fi = (2 * (d0 & 1) + hi) * 8, pos = (d0 >> 2) ? pos1 : pos0;
      const float* cs = rcos + pos * 32 + fi; const float* sn = rsin + pos * 32 + fi;
      typedef __bf16 bf16x2h __attribute__((ext_vector_type(2))); typedef float f32x2h __attribute__((ext_vector_type(2)));
#pragma unroll
      for (int e = 0; e < 8; e += 2) {
        const float a0 = xf[d0][e], a1 = xf[d0][e + 1], b0 = xf[d0 + 2][e], b1 = xf[d0 + 2][e + 1];
        const f32x2h o1 = {a0 * cs[e] - b0 * sn[e], a1 * cs[e + 1] - b1 * sn[e + 1]}, o2 = {b0 * cs[e] + a0 * sn[e], b1 * cs[e + 1] + a1 * sn[e + 1]};
        const unsigned w1 = __builtin_bit_cast(unsigned, __builtin_convertvector(o1, bf16x2h)), w2 = __builtin_bit_cast(unsigned, __builtin_convertvector(o2, bf16x2h));
        qr[d0][e] = (short)(w1 & 0xffffu); qr[d0][e + 1] = (short)(w1 >> 16); qr[d0 + 2][e] = (short)(w2 & 0xffffu); qr[d0 + 2][e + 1] = (short)(w2 >> 16); }
    }
  }
  const int sr = tid >> 4, sc = (tid & 15) * 8, vst0 = v_st(sr, sc), vst1 = v_st(32 + sr, sc);
  const int vb0 = (int)(uintptr_t)V_lds + v_rd_base(lane);
  struct { typename St::T vs0, vs1, ks0, ks1; } sr_[SDEPTH];
#define SLOAD(i, k0) do { const int k0_ = (k0); const bf16* Vt_ = k0_ < SEQ ? Vh + (long)k0_ * LDK : Vc + (long)(k0_ - SEQ) * LDK; const bf16* Kt_ = k0_ < SEQ ? Kh + (long)k0_ * LDK : Kc + (long)(k0_ - SEQ) * LDK; \
    sr_[i].vs0 = St::ld8(&Vt_[(long)(sr) * LDK + sc]); sr_[i].vs1 = St::ld8(&Vt_[(long)(32 + sr) * LDK + sc]); \
    sr_[i].ks0 = St::ld8(&Kt_[(long)(sr) * LDK + sc]); sr_[i].ks1 = St::ld8(&Kt_[(long)(32 + sr) * LDK + sc]); } while (0)
#define SWRITE(b, i) do { *(bf16x8*)((char*)V_lds + (b) * SHM_V + vst0) = St::tobf(sr_[i].vs0);          \
    *(bf16x8*)((char*)V_lds + (b) * SHM_V + vst1) = St::tobf(sr_[i].vs1); int kc = sc * 2;               \
    *(bf16x8*)((char*)K_lds + (b) * SHM_K + KSWZ(sr, kc)) = St::tobf(sr_[i].ks0);                       \
    *(bf16x8*)((char*)K_lds + (b) * SHM_K + KSWZ(32 + sr, kc)) = St::tobf(sr_[i].ks1); } while (0)
#define SWAIT() do { if constexpr (SDEPTH == 2) asm volatile("s_waitcnt vmcnt(4)" ::: "memory"); else asm volatile("s_waitcnt vmcnt(0)" ::: "memory"); } while (0)
#define RESC(a) do { if (__any((a) < 1.f)) { if (hi == 0) al_l[r32] = (a); asm volatile("s_waitcnt lgkmcnt(0)" ::: "memory"); \
    for (int d = 0; d < 4; ++d) for (int r = 0; r < 16; ++r) o[d][r] *= al_l[crow(r, hi)]; } } while (0)
  f32x16 pA0, pA1, pB0, pB1; float mnA, mnB, alA, alB; bf16x8 pa0, pa1, pa2, pa3; const int NT = seq / KVBLK;
  constexpr int SE = 0, SO = SDEPTH - 1;
  SLOAD(SE, 0); asm volatile("s_waitcnt vmcnt(0)" ::: "memory"); SWRITE(0, SE); __syncthreads();
  qkt(pA0, pA1, K_lds, qr, r32, hi); partialSM(pA0, pA1, m_reg, mnA, alA);
  SLOAD(SO, KVBLK); if constexpr (SDEPTH == 2) { if (2 < NT) SLOAD(SE, 2 * KVBLK); }
  SWAIT(); SWRITE(1, SO); __syncthreads();
  for (int j = 1; j + 1 < NT; j += 2) {
    SBAR(); qkt(pB0, pB1, (bf16*)((char*)K_lds + SHM_K), qr, r32, hi);
    finishSM(pA0, pA1, alA, l_reg, pa0, pa1, pa2, pa3); SBAR();
    SLOAD(SO, (j + SDEPTH) * KVBLK); SBAR();
    pv_d0(o, vb0, pa0, pa1, pa2, pa3); partialSM(pB0, pB1, m_reg, mnB, alB);
    __syncthreads(); SWAIT(); SWRITE(0, SE);
    RESC(alB); __syncthreads();
    SBAR(); qkt(pA0, pA1, K_lds, qr, r32, hi);
    finishSM(pB0, pB1, alB, l_reg, pa0, pa1, pa2, pa3); SBAR();
    if (SDEPTH == 1 || j + 3 < NT) SLOAD(SE, (j + 1 + SDEPTH) * KVBLK); SBAR();
    pv_d0(o, vb0 + (int)SHM_V, pa0, pa1, pa2, pa3); partialSM(pA0, pA1, m_reg, mnA, alA);
    __syncthreads(); SWAIT(); SWRITE(1, SO);
    RESC(alA); __syncthreads();
  }
  SBAR(); qkt(pB0, pB1, (bf16*)((char*)K_lds + SHM_K), qr, r32, hi);
  finishSM(pA0, pA1, alA, l_reg, pa0, pa1, pa2, pa3); SBAR();
  pv_d0(o, vb0, pa0, pa1, pa2, pa3); partialSM(pB0, pB1, m_reg, mnB, alB);
  __syncthreads(); RESC(alB);
  finishSM(pB0, pB1, alB, l_reg, pa0, pa1, pa2, pa3); SBAR();
  pv_d0(o, vb0 + (int)SHM_V, pa0, pa1, pa2, pa3);
  if (hi == 0) li_l[r32] = l_reg; asm volatile("s_waitcnt lgkmcnt(0)" ::: "memory");
  float rli[16];
#pragma unroll
  for (int r = 0; r < 16; ++r) rli[r] = __builtin_amdgcn_rcpf(li_l[crow(r, hi)]);
  bf16* Ow = Ob + (long)(wid * QBLK) * LDO;
#pragma unroll
  for (int r = 0; r < 16; ++r) { int orow = crow(r, hi);
    for (int d0 = 0; d0 < 4; ++d0) Ow[(long)orow * LDO + d0 * 32 + r32] = f2bf(o[d0][r] * rli[r]); }
#undef SLOAD
#undef SWRITE
#undef SWAIT
#undef RESC
}

}
#endif
#ifdef CPU_TEST
constexpr int RL = 1;
DEVFN float row_sum(float v) { return v; }
#else
constexpr int RL = 64;
DEVFN float dppf(float v, const int ctrl) { return ctrl == 0xB1 ? __int_as_float(__builtin_amdgcn_mov_dpp(__float_as_int(v), 0xB1, 0xf, 0xf, true)) : ctrl == 0x4E ? __int_as_float(__builtin_amdgcn_mov_dpp(__float_as_int(v), 0x4E, 0xf, 0xf, true))
    : ctrl == 0x141 ? __int_as_float(__builtin_amdgcn_mov_dpp(__float_as_int(v), 0x141, 0xf, 0xf, true)) : __int_as_float(__builtin_amdgcn_mov_dpp(__float_as_int(v), 0x140, 0xf, 0xf, true)); }
DEVFN int dpp_xor1(int v) { return __builtin_amdgcn_mov_dpp(v, 0xB1, 0xf, 0xf, true); }
DEVFN int dpp_xor2(int v) { return __builtin_amdgcn_mov_dpp(v, 0x4E, 0xf, 0xf, true); }
DEVFN int dpp_xor4(int v) { return __builtin_amdgcn_mov_dpp(__builtin_amdgcn_mov_dpp(v, 0x141, 0xf, 0xf, true), 0x1B, 0xf, 0xf, true); }
DEVFN int dpp_xor8(int v) { return __builtin_amdgcn_mov_dpp(v, 0x128, 0xf, 0xf, true); }
DEVFN float rdl(float v, const int l) { return __int_as_float(__builtin_amdgcn_readlane(__float_as_int(v), l)); }
DEVFN float row_sum(float v) {
    v += dppf(v, 0xB1); v += dppf(v, 0x4E); v += dppf(v, 0x141); v += dppf(v, 0x140);
    { auto rr = __builtin_amdgcn_permlane16_swap(__float_as_uint(v), __float_as_uint(v), false, false); v = __uint_as_float(rr[0]) + __uint_as_float(rr[1]); }
    { auto rr = __builtin_amdgcn_permlane32_swap(__float_as_uint(v), __float_as_uint(v), false, false); v = __uint_as_float(rr[0]) + __uint_as_float(rr[1]); }
    return v;
}
DEVFN float wave_maxf(float v) {
    v = fmaxf(v, dppf(v, 0xB1)); v = fmaxf(v, dppf(v, 0x4E)); v = fmaxf(v, dppf(v, 0x141)); v = fmaxf(v, dppf(v, 0x140));
    { auto rr = __builtin_amdgcn_permlane16_swap(__float_as_uint(v), __float_as_uint(v), false, false); v = fmaxf(__uint_as_float(rr[0]), __uint_as_float(rr[1])); }
    { auto rr = __builtin_amdgcn_permlane32_swap(__float_as_uint(v), __float_as_uint(v), false, false); v = fmaxf(__uint_as_float(rr[0]), __uint_as_float(rr[1])); }
    return v;
}
#endif
#define WSP(T, off) ((T*)(p.ws + (off)))
DEVFN int modrow(int t) { return t < NX ? t / SEQ : NBAT; }

DEVFN void tr_w(const float* W, int N, bf16_t* Wt, size_t gtid, size_t gsize) {
    for (size_t i = gtid; i < (size_t)N * D; i += gsize) { const int k = (int)(i / N), n = (int)(i % N); Wt[(size_t)n * D + k] = f2bf(W[i]); }
}
DEVFN void ph_pro_a(const Params& p, size_t gtid, size_t gsize) {
    float* modv = WSP(float, WS_MODV);
    for (size_t i = gtid; i < (size_t)DEPTH * NMR * 6144; i += gsize) {
        const int l = (int)(i / (NMR * 6144)), r = (int)((i / 6144) % NMR), c = (int)(i % 6144);
        const float* cv = r < NBAT ? p.c + (size_t)r * D : p.c_ctx;
        const float* w = p.mod_w + (size_t)l * D * 6144 + c;
        float s = 0.f;
        for (int k = 0; k < D; ++k) s += siluf_(cv[k]) * w[(size_t)k * 6144];
        modv[i] = s + p.mod_b[l * 6144 + c];
    }
    float* lbv = WSP(float, WS_LBV);
    for (size_t c = gtid; c < (size_t)D; c += gsize) {
        float m = -1e30f;
        for (int j = 0; j < DEPTH + 1; ++j) m = fmaxf(m, p.hgrn_lb[j * D + c]);
        float sum = 0.f;
        for (int j = 0; j < DEPTH + 1; ++j) sum += expf(p.hgrn_lb[j * D + c] - m);
        lbv[c] = expf(p.hgrn_lb[c] - m) / sum;
    }
    tr_w(p.hgrn_w_in, 5120, WSP(bf16_t, WS_WIN0), gtid, gsize);
    tr_w(p.swa_w_in, 1536, WSP(bf16_t, WS_WIN1), gtid, gsize);
    tr_w(p.na_w_in, 3072, WSP(bf16_t, WS_WIN2), gtid, gsize);
    tr_w(p.gqa_w_in, 1536, WSP(bf16_t, WS_WIN3), gtid, gsize);
    tr_w(p.hgrn_w_out, 1024, WSP(bf16_t, WS_WOUT) + (size_t)0 * D * D, gtid, gsize);
    tr_w(p.swa_w_out, 1024, WSP(bf16_t, WS_WOUT) + (size_t)1 * D * D, gtid, gsize);
    tr_w(p.na_w_out, 1024, WSP(bf16_t, WS_WOUT) + (size_t)2 * D * D, gtid, gsize);
    tr_w(p.gqa_w_out, 1024, WSP(bf16_t, WS_WOUT) + (size_t)3 * D * D, gtid, gsize);
    for (int l = 0; l < DEPTH; ++l) tr_w(p.peer_wq + (size_t)l * D * 2048, 2048, WSP(bf16_t, WS_WQ) + (size_t)l * 2048 * D, gtid, gsize);
    float* xs = WSP(float, WS_XS);
    for (size_t i = gtid; i < (size_t)NT * D; i += gsize) xs[i] = i < (size_t)NX * D ? p.x[i] : p.ctx[i - (size_t)NX * D];
}
DEVFN void ph_h0(const Params& p, size_t gtid, size_t gsize) {
    const float* xs = WSP(float, WS_XS); const float* modv = WSP(float, WS_MODV); bf16_t* hb = WSP(bf16_t, WS_HB);
    for (size_t i = gtid; i < (size_t)NT * D; i += gsize) {
        const int t = (int)(i / D), c = (int)(i % D);
        const float* m = modv + (size_t)(0 * NMR + modrow(t)) * 6144;
        hb[i] = f2bf(xs[i] * (1.f + m[D + c]) + m[c]);
    }
}
#ifdef CPU_TEST
DEVFN void cpu_gemm(const bf16_t* A, const bf16_t* Bt, int M, int N, int K, bf16_t* ob, float* of, int ldc, size_t gtid, size_t gsize) {
    for (size_t i = gtid; i < (size_t)M * N; i += gsize) {
        const int m = (int)(i / N), n = (int)(i % N); float s = 0.f;
        for (int k = 0; k < K; ++k) s += bf2f(A[(size_t)m * K + k]) * bf2f(Bt[(size_t)n * K + k]);
        if (ob) ob[(size_t)m * ldc + n] = f2bf(s); else of[(size_t)m * ldc + n] = s;
    }
}
#endif

DEVFN void ph_swa_rope(const Params& p, size_t gtid, size_t gsize) {
    bf16_t* Z = WSP(bf16_t, WS_Z); constexpr int LDZ = 1536;
    for (size_t i = gtid; i < (size_t)NX * 20 * 32; i += gsize) {
        const int pi = (int)(i % 32), hh = (int)((i / 32) % 20), t = (int)(i / (32 * 20));
        const int s = t % SEQ, a = pi >> 4, fi = pi & 15;
        const float pos = a == 0 ? (float)(s / GW) : (float)(s % GW);
        const float inv = expf(-(float)(2 * fi) / 32.f * LN_THETA);
        const float ang = pos * inv, cs = cosf(ang), sn = sinf(ang);
        bf16_t* zp = Z + (size_t)t * LDZ + hh * 64 + a * 32 + fi;
        const float x1 = bf2f(zp[0]), x2 = bf2f(zp[16]);
        zp[0] = f2bf(x1 * cs - x2 * sn); zp[16] = f2bf(x2 * cs + x1 * sn);
    }
}
DEVFN void ph_gqa_prep(const Params& p, size_t gtid, size_t gsize) {
    bf16_t* Z = WSP(bf16_t, WS_Z); constexpr int LDZ = 1536;
    for (size_t i = gtid; i < (size_t)NT * 10; i += gsize) {
        const int hh = (int)(i % 10), t = (int)(i / 10);
        bf16_t* zp = Z + (size_t)t * LDZ + hh * 128;
        const float* g = hh < 8 ? p.gqa_q_norm : p.gqa_k_norm;
        float ss = 0.f;
        for (int d = 0; d < 128; ++d) { const float v = bf2f(zp[d]); ss += v * v; }
        const float r = 1.f / sqrtf(ss * (1.f / 128.f) + RMS_EPS);
        if (t < NX) {
            const int s = t % SEQ;
            for (int a = 0; a < 2; ++a) {
                const float pos = a == 0 ? (float)(s / GW) : (float)(s % GW);
                for (int fi = 0; fi < 32; ++fi) {
                    const int d1 = a * 64 + fi, d2 = d1 + 32;
                    const float inv = expf(-(float)(2 * fi) / 64.f * LN_THETA);
                    const float ang = pos * inv, cs = cosf(ang), sn = sinf(ang);
                    const float x1 = bf2f(zp[d1]) * r * g[d1], x2 = bf2f(zp[d2]) * r * g[d2];
                    zp[d1] = f2bf(x1 * cs - x2 * sn); zp[d2] = f2bf(x2 * cs + x1 * sn);
                }
            }
        } else {
            for (int d = 0; d < 128; ++d) zp[d] = f2bf(bf2f(zp[d]) * r * g[d]);
        }
    }
}

template <int DH, int DCH>
DEVFN void att_key(const float (&q)[DH], float (&acc)[DCH], float& m, float& l, const bf16_t* kp, const bf16_t* vp, float scale, float bias) {
    float s = 0.f;
#pragma unroll
    for (int d = 0; d < DH; ++d) s += q[d] * bf2f(kp[d]);
    s = s * scale + bias;
    const float mn = fmaxf(m, s), a = expf(m - mn), pw = expf(s - mn);
    l = l * a + pw;
#pragma unroll
    for (int d = 0; d < DCH; ++d) acc[d] = acc[d] * a + pw * bf2f(vp[d]);
    m = mn;
}
DEVFN void ph_swa_attn(const Params& p, size_t gtid, size_t gsize) {
    const bf16_t* Z = WSP(bf16_t, WS_Z); bf16_t* att = WSP(bf16_t, WS_ATT); constexpr int LDZ = 1536;
    for (size_t i = gtid; i < (size_t)NT * 16; i += gsize) {
        const int hq = (int)(i % 16), t = (int)(i / 16), kvh = hq / 4;
        float q[64], acc[64]; float m = -1e30f, l = 0.f;
#pragma unroll
        for (int d = 0; d < 64; ++d) { q[d] = bf2f(Z[(size_t)t * LDZ + hq * 64 + d]); acc[d] = 0.f; }
        int b;
        if (t < NX) {
            b = t / SEQ; const int s = t % SEQ, lo = imax(0, s - 128), hi = imin(SEQ - 1, s + 128);
            for (int kp = lo; kp <= hi; ++kp) { const bf16_t* zr = Z + (size_t)(b * SEQ + kp) * LDZ; att_key<64, 64>(q, acc, m, l, zr + 1024 + kvh * 64, zr + 1280 + kvh * 64, 0.125f, 0.f); }
        } else b = (t - NX) / CL;
        for (int j = 0; j < CL; ++j) { const bf16_t* zr = Z + (size_t)(NX + b * CL + j) * LDZ; att_key<64, 64>(q, acc, m, l, zr + 1024 + kvh * 64, zr + 1280 + kvh * 64, 0.125f, 0.f); }
        const float sk = p.swa_sink[hq], mn = fmaxf(m, sk), a = expf(m - mn); l = l * a + expf(sk - mn);
        const float sc = a / l;
#pragma unroll
        for (int d = 0; d < 64; ++d) att[(size_t)t * D + hq * 64 + d] = f2bf(acc[d] * sc);
    }
}
DEVFN void ph_na_attn(const Params& p, size_t gtid, size_t gsize) {
    const bf16_t* Z = WSP(bf16_t, WS_Z); bf16_t* att = WSP(bf16_t, WS_ATT); constexpr int LDZ = 3072;
    for (size_t i = gtid; i < (size_t)NT * 16; i += gsize) {
        const int hq = (int)(i % 16), t = (int)(i / 16);
        float q[64], acc[64]; float m = -1e30f, l = 0.f;
#pragma unroll
        for (int d = 0; d < 64; ++d) { q[d] = bf2f(Z[(size_t)t * LDZ + hq * 64 + d]); acc[d] = 0.f; }
        int b;
        if (t < NX) {
            b = t / SEQ; const int s = t % SEQ, r = s / GW, c = s % GW;
            const int rstart = iclamp(r - 4, 0, NROWS - 8), cstart = iclamp(c - 8, 0, GW - 16);
            for (int ii = 0; ii < 8; ++ii)
                for (int jj = 0; jj < 16; ++jj) {
                    const int kr = rstart + ii, kc = cstart + jj;
                    const bf16_t* zr = Z + (size_t)(b * SEQ + kr * GW + kc) * LDZ;
                    const float bias = p.na_rpb[(hq * 15 + (kr - r + 7)) * 31 + (kc - c + 15)];
                    att_key<64, 64>(q, acc, m, l, zr + 1024 + hq * 64, zr + 2048 + hq * 64, 0.125f, bias);
                }
        } else b = (t - NX) / CL;
        for (int j = 0; j < CL; ++j) { const bf16_t* zr = Z + (size_t)(NX + b * CL + j) * LDZ; att_key<64, 64>(q, acc, m, l, zr + 1024 + hq * 64, zr + 2048 + hq * 64, 0.125f, 0.f); }
        const float sc = 1.f / l;
#pragma unroll
        for (int d = 0; d < 64; ++d) att[(size_t)t * D + hq * 64 + d] = f2bf(acc[d] * sc);
    }
}
DEVFN void ph_gqa_attn(const Params& p, size_t gtid, size_t gsize) {
    const bf16_t* Z = WSP(bf16_t, WS_Z); bf16_t* att = WSP(bf16_t, WS_ATT); constexpr int LDZ = 1536;
    for (size_t i = gtid; i < (size_t)NX * 32; i += gsize) {
        const int ch = (int)(i % 4), hq = (int)((i / 4) % 8), t = (int)(i / 32), kvh = hq / 4, b = t / SEQ;
        float q[128], acc[32]; float m = -1e30f, l = 0.f;
#pragma unroll
        for (int d = 0; d < 128; ++d) q[d] = bf2f(Z[(size_t)t * LDZ + hq * 128 + d]);
#pragma unroll
        for (int d = 0; d < 32; ++d) acc[d] = 0.f;
        for (int kp = 0; kp < SEQ; ++kp) { const bf16_t* zr = Z + (size_t)(b * SEQ + kp) * LDZ; att_key<128, 32>(q, acc, m, l, zr + 1024 + kvh * 128, zr + 1280 + kvh * 128 + ch * 32, 0.08838834764831845f, 0.f); }
        for (int j = 0; j < CL; ++j) { const bf16_t* zr = Z + (size_t)(NX + b * CL + j) * LDZ; att_key<128, 32>(q, acc, m, l, zr + 1024 + kvh * 128, zr + 1280 + kvh * 128 + ch * 32, 0.08838834764831845f, 0.f); }
        const float sc = 1.f / l;
#pragma unroll
        for (int d = 0; d < 32; ++d) att[(size_t)t * D + hq * 128 + ch * 32 + d] = f2bf(acc[d] * sc);
    }
}

DEVFN void ph_hgrn_gates(const Params& p, size_t gtid, size_t gsize) {
    bf16_t* Z = WSP(bf16_t, WS_Z); const float* lbv = WSP(float, WS_LBV); constexpr int LDZ = 5120;
    for (size_t i = gtid; i < (size_t)NT * D; i += gsize) {
        const size_t t = i / D; const int c = (int)(i % D);
        bf16_t* zr = Z + t * LDZ;
        zr[c] = f2bf(siluf_(bf2f(zr[c])));
        const float lb = lbv[c];
        zr[2048 + c] = f2bf((1.f - lb) * sigmoidf_(-bf2f(zr[2048 + c])));
        zr[3072 + c] = f2bf((1.f - lb) * sigmoidf_(-bf2f(zr[3072 + c])));
    }
}
DEVFN void ph_hgrn_scan(const Params& p, size_t gtid, size_t gsize) {
    const bf16_t* Z = WSP(bf16_t, WS_Z); constexpr int LDZ = 5120;
    bf16_t* of = WSP(bf16_t, WS_Y); bf16_t* ob = of + (size_t)NT * D;
    for (size_t i = gtid; i < (size_t)NBAT * 8 * 2 * 128; i += gsize) {
        const int j = (int)(i % 128), dir = (int)((i / 128) % 2), h = (int)((i / 256) % 8), b = (int)(i / 2048);
        float S[128];
#pragma unroll
        for (int k = 0; k < 128; ++k) S[k] = 0.f;
        bf16_t* od = dir ? ob : of;
        for (int step = 0; step < CL + SEQ; ++step) {
            int t;
            if (step < CL) t = NX + b * CL + (dir ? CL - 1 - step : step);
            else { const int s = step - CL; t = b * SEQ + (dir ? SEQ - 1 - s : s); }
            const bf16_t* zr = Z + (size_t)t * LDZ;
            const float vj = bf2f(zr[1024 + h * 128 + j]);
            const bf16_t* kr = zr + (dir ? 3072 : 2048) + h * 128; const bf16_t* qr = zr + h * 128;
            float o = 0.f;
#pragma unroll
            for (int k = 0; k < 128; ++k) {
                const float kk = bf2f(kr[k]);
                S[k] = (1.f - kk) * S[k] + kk * vj;
                o += bf2f(qr[k]) * S[k];
            }
            od[(size_t)t * D + h * 128 + j] = f2bf(o);
        }
    }
}
DEVFN void ph_hgrn_readout(const Params& p, size_t gtid, size_t gsize) {
    const bf16_t* Z = WSP(bf16_t, WS_Z); constexpr int LDZ = 5120;
    const bf16_t* of = WSP(bf16_t, WS_Y); const bf16_t* ob = of + (size_t)NT * D; bf16_t* att = WSP(bf16_t, WS_ATT);
    const int lane = (int)(gtid % RL);
    for (size_t it = gtid / RL; it < (size_t)NT * 8; it += gsize / RL) {
        const int h = (int)(it % 8), t = (int)(it / 8);
        const size_t base = (size_t)t * D + h * 128;
        float ss = 0.f;
        for (int k = lane; k < 128; k += RL) { const float o = bf2f(of[base + k]) + bf2f(ob[base + k]); ss += o * o; }
        ss = row_sum(ss);
        const float r = 1.f / sqrtf(ss * (1.f / 128.f) + RMS_EPS);
        for (int k = lane; k < 128; k += RL) {
            const float o = bf2f(of[base + k]) + bf2f(ob[base + k]);
            const float g = bf2f(Z[(size_t)t * LDZ + 4096 + h * 128 + k]);
            att[base + k] = f2bf(o * r * p.hgrn_norm_g[k] * siluf_(g));
        }
    }
}

DEVFN void ph_ln(const Params& p, int l, int which, int M, size_t gtid, size_t gsize) {
    float* xs = WSP(float, WS_XS); const float* Y = WSP(float, WS_Y); const float* modv = WSP(float, WS_MODV); bf16_t* hb = WSP(bf16_t, WS_HB);
    const int lane = (int)(gtid % RL);
    const float* g = p.ln_g + (size_t)(l * 2 + which) * D; const float* bb = p.ln_b + (size_t)(l * 2 + which) * D;
    for (size_t t = gtid / RL; t < (size_t)M; t += gsize / RL) {
        const float* m = modv + (size_t)(l * NMR + modrow((int)t)) * 6144; const float* gate = m + (which == 0 ? 2 * D : 5 * D);
        float* xr = xs + t * D; const float* yr = Y + t * D;
        float mu = 0.f;
        for (int c = lane; c < D; c += RL) mu += ALPHA * xr[c] + gate[c] * yr[c];
        mu = row_sum(mu) * (1.f / D);
        float var = 0.f;
        for (int c = lane; c < D; c += RL) { const float d = ALPHA * xr[c] + gate[c] * yr[c] - mu; var += d * d; }
        var = row_sum(var) * (1.f / D);
        const float rstd = 1.f / sqrtf(var + LN_EPS);
        const float* m2 = modv + (size_t)((l + 1 < DEPTH ? l + 1 : l) * NMR + modrow((int)t)) * 6144;
        for (int c = lane; c < D; c += RL) {
            const float v = (ALPHA * xr[c] + gate[c] * yr[c] - mu) * rstd * g[c] + bb[c];
            xr[c] = v;
            if (which == 0) hb[t * D + c] = f2bf(v * (1.f + m[4 * D + c]) + m[3 * D + c]);
            else if (l + 1 < DEPTH) hb[t * D + c] = f2bf(v * (1.f + m2[D + c]) + m2[c]);
            else if (t < (size_t)NX) p.out[t * D + c] = v;
        }
    }
}

DEVFN void ph_peer_scores(const Params& p, int l, int M, size_t gtid, size_t gsize) {
    const bf16_t* qp = WSP(bf16_t, WS_QP); float* sv = WSP(float, WS_SV); int* si = WSP(int, WS_SI);
    for (size_t i = gtid; i < (size_t)M * 16; i += gsize) {
        const int hp = (int)(i / M), t = (int)(i % M);
        const bf16_t* qr = qp + (size_t)t * 2048 + hp * 128;
        const float* kb = p.peer_keys + ((size_t)l * 16 + hp) * 128 * 128;
        float tv[16]; int ti[16];
#pragma unroll
        for (int j = 0; j < 16; ++j) { tv[j] = -3.0e38f; ti[j] = 0; }
        for (int n = 0; n < 128; ++n) {
            float s = 0.f;
            for (int d = 0; d < 128; ++d) s += bf2f(qr[d]) * kb[n * 128 + d];
            int ni = n;
#pragma unroll
            for (int j = 0; j < 16; ++j) if (s > tv[j]) { const float ts = tv[j]; tv[j] = s; s = ts; const int tn = ti[j]; ti[j] = ni; ni = tn; }
        }
#pragma unroll
        for (int j = 0; j < 16; ++j) { sv[((size_t)t * 16 + hp) * 16 + j] = tv[j]; si[((size_t)t * 16 + hp) * 16 + j] = ti[j]; }
    }
}
DEVFN void ph_peer_combine(const Params& p, int M, size_t gtid, size_t gsize) {
    const float* sv = WSP(float, WS_SV); const int* si = WSP(int, WS_SI); int* idx = WSP(int, WS_IDX); float* gate = WSP(float, WS_GATE);
    for (size_t i = gtid; i < (size_t)M * 8; i += gsize) {
        const int h = (int)(i % 8), t = (int)(i / 8);
        const float* s0 = sv + ((size_t)t * 16 + h * 2) * 16; const float* s1 = s0 + 16;
        const int* i0 = si + ((size_t)t * 16 + h * 2) * 16; const int* i1 = i0 + 16;
        float tv[16]; int ti[16];
#pragma unroll
        for (int j = 0; j < 16; ++j) { tv[j] = -3.0e38f; ti[j] = 0; }
        for (int a = 0; a < 16; ++a)
            for (int b = 0; b < 16; ++b) {
                float s = s0[a] + s1[b]; int ni = i0[a] * 128 + i1[b];
#pragma unroll
                for (int j = 0; j < 16; ++j) if (s > tv[j]) { const float ts = tv[j]; tv[j] = s; s = ts; const int tn = ti[j]; ti[j] = ni; ni = tn; }
            }
        float sum = 0.f;
#pragma unroll
        for (int j = 0; j < 16; ++j) sum += expf(tv[j] - tv[0]);
#pragma unroll
        for (int j = 0; j < 16; ++j) { idx[(size_t)t * 128 + h * 16 + j] = ti[j]; gate[(size_t)t * 128 + h * 16 + j] = expf(tv[j] - tv[0]) / sum; }
    }
}
DEVFN void ph_peer_act(const Params& p, int l, int M, size_t gtid, size_t gsize) {
    const int* idx = WSP(int, WS_IDX); const float* gate = WSP(float, WS_GATE); float* wa = WSP(float, WS_WA); const bf16_t* hb = WSP(bf16_t, WS_HB);
    const float* U = p.peer_u + (size_t)l * PEER_N * D;
    const int lane = (int)(gtid % RL);
    for (size_t it = gtid / RL; it < (size_t)M * 128; it += gsize / RL) {
        const size_t t = it / 128; const float* ur = U + (size_t)idx[it] * D; const bf16_t* hr = hb + t * D;
        float s = 0.f;
        for (int c = lane; c < D; c += RL) s += bf2f(hr[c]) * ur[c];
        s = row_sum(s);
        if (lane == 0) wa[it] = gate[it] * geluf_(s);
    }
}
DEVFN void ph_peer_out(const Params& p, int l, int M, size_t gtid, size_t gsize) {
    const int* idx = WSP(int, WS_IDX); const float* wa = WSP(float, WS_WA); float* y = WSP(float, WS_Y);
    const float* V = p.peer_v + (size_t)l * PEER_N * D;
    for (size_t i = gtid; i < (size_t)M * D; i += gsize) {
        const size_t t = i / D; const int d = (int)(i % D);
        float s = 0.f;
        for (int j = 0; j < 128; ++j) s += wa[t * 128 + j] * V[(size_t)idx[t * 128 + j] * D + d];
        y[i] = s;
    }
}
#ifndef CPU_TEST
DEVFN void ph_gqa_attn_mfma(const Params& p, char* lds, int bid, int G) {
    const bf16_t* Z = WSP(const bf16_t, WS_Z); bf16_t* att = WSP(bf16_t, WS_ATT);
    constexpr int NQB = SEQ / 256, LDZ = 1536;
    const bool xaff = (G & 7) == 0;
    for (int v = xaff ? (bid >> 3) : bid; v < (xaff ? NBAT * 8 * NQB / 8 : NBAT * 8 * NQB); v += xaff ? (G >> 3) : G) {
        const int u = xaff ? ((v / (4 * NQB)) * 8 + (bid & 7)) * (4 * NQB) + v % (4 * NQB) : v;
        const int qb = u % NQB, hq4 = (u / NQB) & 3, pair = u / (4 * NQB), b = pair >> 1, kvh = pair & 1, hq = kvh * 4 + hq4;
        const bf16_t* Qb = Z + (size_t)(b * SEQ + qb * 256) * LDZ + hq * 128;
        const bf16_t* Kh = Z + (size_t)(b * SEQ) * LDZ + 1024 + kvh * 128; const bf16_t* Vh = Kh + 256;
        const bf16_t* Kc = Z + (size_t)(NX + b * CL) * LDZ + 1024 + kvh * 128; const bf16_t* Vc = Kc + 256;
        att128::attn_dense_body<bf16_t>(Qb, Kh, Vh, Kc, Vc, att + (size_t)(b * SEQ + qb * 256) * D + hq * 128, SEQ + CL, lds, p.gqa_q_norm, WSP(const float, WS_ROPE) + ROPE128_COS, WSP(const float, WS_ROPE) + ROPE128_SIN, qb * 256);
        __syncthreads();
    }
}
#endif
#ifndef CPU_TEST
typedef float f32x2_t __attribute__((ext_vector_type(2)));
typedef unsigned u32x2_t __attribute__((ext_vector_type(2)));
typedef unsigned u32x4_t __attribute__((ext_vector_type(4)));
typedef float f32x4_t __attribute__((ext_vector_type(4)));
DEVFN float wave_max(float v) {
#pragma unroll
    for (int o = 1; o < 64; o <<= 1) v = fmaxf(v, __shfl_xor(v, o));
    return v;
}
DEVFN void ph_cvt_uv_fp8(const Params& p, LAS unsigned char* lds, int tid, int bid, int G) {
    const int lane = tid & 63, wv = __builtin_amdgcn_readfirstlane(tid >> 6);
    unsigned char* dst = WSP(unsigned char, WS_UV8); float* scl = WSP(float, WS_UVS);
    LAS unsigned* img = (LAS unsigned*)(lds + wv * 1024);
    for (int r = wv * G + bid; r < 8 * PEER_N; r += G * 8) {
        const int tb = r / PEER_N, l = tb >> 1, which = tb & 1, e = r % PEER_N;
        const f32x4_t* src = (const f32x4_t*)((which ? p.peer_v : p.peer_u) + ((size_t)l * PEER_N + e) * D) + lane;
        f32x4_t a[4];
#pragma unroll
        for (int j = 0; j < 4; ++j) a[j] = src[64 * j];
        if (which) {
            float ss = 0.f;
#pragma unroll
            for (int j = 0; j < 4; ++j) ss += (a[j].x * a[j].x + a[j].y * a[j].y) + (a[j].z * a[j].z + a[j].w * a[j].w);
            ss = row_sum(ss);
            const float rms = sqrtf(ss * (1.f / D)), sc = rms > 0.f ? 2.f / rms : 0.f;
#pragma unroll
            for (int j = 0; j < 4; ++j) {
                unsigned w = 0u;
                w = __builtin_amdgcn_cvt_scalef32_pk_fp4_f32(w, a[j].x * sc, a[j].y * sc, 1.0f, 0);
                w = __builtin_amdgcn_cvt_scalef32_pk_fp4_f32(w, a[j].z * sc, a[j].w * sc, 1.0f, 1);
                ((LAS unsigned short*)img)[64 * j + lane] = (unsigned short)w;
            }
            const u32x4_t o = *(const LAS u32x4_t*)((LAS unsigned char*)img + (lane & 31) * 16);
            if (lane < 32) *(u32x4_t*)(dst + (size_t)tb * PEER_N * 1024 + (size_t)(lane >> 3) * PEER_N * 128 + (size_t)e * 128 + (lane & 7) * 16) = o;
            if (lane == 0) scl[((size_t)l * PEER_N + e) * 2 + 1] = rms * 0.5f;
        } else {
            float ss = 0.f;
#pragma unroll
            for (int j = 0; j < 4; ++j) ss += (a[j].x * a[j].x + a[j].y * a[j].y) + (a[j].z * a[j].z + a[j].w * a[j].w);
            ss = row_sum(ss);
            const float step = sqrtf(ss * (1.f / D)) * (2.6f / 8.f), istep = step > 0.f ? 1.f / step : 0.f;
#pragma unroll
            for (int j = 0; j < 4; ++j) {
                unsigned w = 0u;
#pragma unroll
                for (int kk = 0; kk < 4; ++kk) { const int n = (int)fminf(fmaxf(floorf(a[j][kk] * istep), -8.f), 7.f); w |= ((unsigned)n & 15u) << (4 * kk); }
                ((LAS unsigned short*)img)[64 * j + lane] = (unsigned short)w;
            }
            const u32x4_t o = *(const LAS u32x4_t*)((LAS unsigned char*)img + (lane & 31) * 16);
            if (lane < 32) *(u32x4_t*)(dst + (size_t)tb * PEER_N * 1024 + (size_t)(lane >> 3) * PEER_N * 128 + (size_t)e * 128 + (lane & 7) * 16) = o;
            if (lane == 0) scl[((size_t)l * PEER_N + e) * 2] = step * 0.5f;
        }
    }
}
DEVFN float dot16_fp8(const u32x4_t r, const float (&h)[16]) {
    float s0 = 0.f, s1 = 0.f;
#pragma unroll
    for (int i = 0; i < 4; ++i) { const f32x2_t lo = __builtin_amdgcn_cvt_pk_f32_fp8((int)r[i], false), hi = __builtin_amdgcn_cvt_pk_f32_fp8((int)r[i], true);
        s0 = fmaf(lo.x, h[4 * i], s0); s1 = fmaf(lo.y, h[4 * i + 1], s1); s0 = fmaf(hi.x, h[4 * i + 2], s0); s1 = fmaf(hi.y, h[4 * i + 3], s1); }
    return s0 + s1;
}
DEVFN void fma16_fp8(float (&y)[16], const u32x4_t r, const float w) {
#pragma unroll
    for (int i = 0; i < 4; ++i) { const f32x2_t lo = __builtin_amdgcn_cvt_pk_f32_fp8((int)r[i], false), hi = __builtin_amdgcn_cvt_pk_f32_fp8((int)r[i], true);
        y[4 * i] = fmaf(w, lo.x, y[4 * i]); y[4 * i + 1] = fmaf(w, lo.y, y[4 * i + 1]); y[4 * i + 2] = fmaf(w, hi.x, y[4 * i + 2]); y[4 * i + 3] = fmaf(w, hi.y, y[4 * i + 3]); }
}
DEVFN float treduce64(float (&p)[64], int lane) {
#pragma unroll
    for (int i = 0; i < 32; ++i) { auto r = __builtin_amdgcn_permlane32_swap(__float_as_uint(p[i]), __float_as_uint(p[i + 32]), false, false); p[i] = __uint_as_float(r[0]) + __uint_as_float(r[1]); }
#pragma unroll
    for (int i = 0; i < 16; ++i) { auto r = __builtin_amdgcn_permlane16_swap(__float_as_uint(p[i]), __float_as_uint(p[i + 16]), false, false); p[i] = __uint_as_float(r[0]) + __uint_as_float(r[1]); }
#pragma unroll
    for (int i = 0; i < 8; ++i) { const bool up = (lane & 8) != 0; const float keep = up ? p[i + 8] : p[i], send = up ? p[i] : p[i + 8]; p[i] = keep + __shfl_xor(send, 8); }
#pragma unroll
    for (int i = 0; i < 4; ++i) { const bool up = (lane & 4) != 0; const float keep = up ? p[i + 4] : p[i], send = up ? p[i] : p[i + 4]; p[i] = keep + __shfl_xor(send, 4); }
#pragma unroll
    for (int i = 0; i < 2; ++i) { const bool up = (lane & 2) != 0; const float keep = up ? p[i + 2] : p[i], send = up ? p[i] : p[i + 2]; p[i] = keep + __shfl_xor(send, 2); }
    { const bool up = (lane & 1) != 0; const float keep = up ? p[1] : p[0], send = up ? p[0] : p[1]; p[0] = keep + __shfl_xor(send, 1); }
    return p[0];
}
DEVFN float treduce32(float (&p)[32], int lane) {
#pragma unroll
    for (int i = 0; i < 16; ++i) { auto r = __builtin_amdgcn_permlane16_swap(__float_as_uint(p[i]), __float_as_uint(p[i + 16]), false, false); p[i] = __uint_as_float(r[0]) + __uint_as_float(r[1]); }
#pragma unroll
    for (int i = 0; i < 8; ++i) { const bool up = (lane & 8) != 0; const float keep = up ? p[i + 8] : p[i], send = up ? p[i] : p[i + 8]; p[i] = keep + __shfl_xor(send, 8); }
#pragma unroll
    for (int i = 0; i < 4; ++i) { const bool up = (lane & 4) != 0; const float keep = up ? p[i + 4] : p[i], send = up ? p[i] : p[i + 4]; p[i] = keep + __shfl_xor(send, 4); }
#pragma unroll
    for (int i = 0; i < 2; ++i) { const bool up = (lane & 2) != 0; const float keep = up ? p[i + 2] : p[i], send = up ? p[i] : p[i + 2]; p[i] = keep + __shfl_xor(send, 2); }
    { const bool up = (lane & 1) != 0; const float keep = up ? p[1] : p[0], send = up ? p[0] : p[1]; p[0] = keep + __shfl_xor(send, 1); }
    return p[0] + __shfl_xor(p[0], 32);
}
DEVFN void ph_peer_experts(const Params& p, int l, int M, int tid, int bid, int G) {
    const int lane = tid & 63;
    const unsigned char* U8 = WSP(const unsigned char, WS_UV8) + (size_t)(l * 2) * PEER_N * 1024; const unsigned char* V8 = U8 + (size_t)PEER_N * 1024;
    const float* SU = WSP(const float, WS_UVS) + (size_t)(l * 2) * PEER_N; const float* SV = SU + PEER_N;
    const int* idx = WSP(const int, WS_IDX); const float* gate = WSP(const float, WS_GATE);
    float* xs = WSP(float, WS_XS); bf16_t* hb = WSP(bf16_t, WS_HB); const float* modv = WSP(const float, WS_MODV);
    const float* lg0 = p.ln_g + (size_t)(l * 2 + 1) * D + lane * 16; const float* lb0 = p.ln_b + (size_t)(l * 2 + 1) * D + lane * 16;
    for (int t = __builtin_amdgcn_readfirstlane(tid >> 6) * G + bid; t < M; t += G * 8) {
        const float* lg = lg0; const float* lb = lb0;
        asm volatile("" : "+v"(lg), "+v"(lb));
        float h[16];
        { const u32x4_t* hp = (const u32x4_t*)(hb + (size_t)t * D + lane * 16); const u32x4_t h0 = hp[0], h1 = hp[1];
#pragma unroll
          for (int i = 0; i < 4; ++i) { h[2 * i] = __uint_as_float(h0[i] << 16); h[2 * i + 1] = __uint_as_float(h0[i] & 0xffff0000u); h[8 + 2 * i] = __uint_as_float(h1[i] << 16); h[8 + 2 * i + 1] = __uint_as_float(h1[i] & 0xffff0000u); } }
        int eidx[2]; float wgt[2];
#pragma unroll
        for (int half = 0; half < 2; ++half) {
            const int myidx = idx[(size_t)t * 128 + half * 64 + lane]; const float mygate = gate[(size_t)t * 128 + half * 64 + lane];
            const float su = SU[myidx], sv = SV[myidx];
            float dsel = 0.f;
#pragma unroll
            for (int sh = 0; sh < 2; ++sh) {
                float part[32];
#pragma unroll
                for (int g = 0; g < 2; ++g) {
                    u32x4_t r[16];
                    int mi = myidx; asm volatile("" : "+v"(mi));
#pragma unroll
                    for (int j = 0; j < 16; ++j) { const int e = __builtin_amdgcn_readlane(mi, sh * 32 + g * 16 + j); r[j] = *((const u32x4_t*)(U8 + (size_t)e * 1024) + lane); }
                    __builtin_amdgcn_sched_barrier(0);
#pragma unroll
                    for (int j = 0; j < 16; ++j) { part[g * 16 + j] = dot16_fp8(r[j], h); if (j & 1) __builtin_amdgcn_sched_barrier(0); }
                }
                const float rs = treduce32(part, lane);
                dsel = ((lane >> 5) == sh) ? rs : dsel;
            }
            const float dot = dsel * su;
            const float u3 = 1.5957691216057308f * (dot + 0.044715f * dot * dot * dot);
            eidx[half] = myidx; wgt[half] = mygate * sv * dot / (1.f + __expf(-u3));
        }
        __builtin_amdgcn_sched_barrier(0);
        float y[16];
#pragma unroll
        for (int i = 0; i < 16; ++i) y[i] = 0.f;
#pragma unroll
        for (int half = 0; half < 2; ++half) {
#pragma unroll
            for (int g = 0; g < 4; ++g) {
                u32x4_t r[16];
                int mi = eidx[half]; asm volatile("" : "+v"(mi));
#pragma unroll
                for (int j = 0; j < 16; ++j) { const int e = __builtin_amdgcn_readlane(mi, g * 16 + j); r[j] = *((const u32x4_t*)(V8 + (size_t)e * 1024) + lane); }
                __builtin_amdgcn_sched_barrier(0);
#pragma unroll
                for (int j = 0; j < 16; ++j) { const float we = __uint_as_float(__builtin_amdgcn_readlane(__float_as_uint(wgt[half]), g * 16 + j)); fma16_fp8(y, r[j], we); if (j & 1) __builtin_amdgcn_sched_barrier(0); }
            }
        }
        const int mr = modrow(t);
        const float* m = modv + (size_t)(l * NMR + mr) * 6144 + lane * 16;
        float* xr = xs + (size_t)t * D + lane * 16;
        float v[16]; float s = 0.f;
#pragma unroll
        for (int i = 0; i < 4; ++i) { const f32x4_t xv = ((const f32x4_t*)xr)[i], gv = ((const f32x4_t*)(m + 5 * D))[i];
#pragma unroll
            for (int k = 0; k < 4; ++k) { v[4 * i + k] = ALPHA * xv[k] + gv[k] * y[4 * i + k]; s += v[4 * i + k]; } }
        const float mu = row_sum(s) * (1.f / D);
        float q = 0.f;
#pragma unroll
        for (int i = 0; i < 16; ++i) { v[i] -= mu; q += v[i] * v[i]; }
        const float rstd = 1.f / sqrtf(row_sum(q) * (1.f / D) + LN_EPS);
#pragma unroll
        for (int i = 0; i < 4; ++i) { const f32x4_t gg = ((const f32x4_t*)lg)[i], bb = ((const f32x4_t*)lb)[i];
#pragma unroll
            for (int k = 0; k < 4; ++k) v[4 * i + k] = v[4 * i + k] * rstd * gg[k] + bb[k]; }
#pragma unroll
        for (int i = 0; i < 4; ++i) ((f32x4_t*)xr)[i] = (f32x4_t){v[4 * i], v[4 * i + 1], v[4 * i + 2], v[4 * i + 3]};
        if (l + 1 < DEPTH) {
            const float* m2 = modv + (size_t)((l + 1) * NMR + mr) * 6144 + lane * 16;
            u32x4_t o0, o1;
#pragma unroll
            for (int i = 0; i < 4; ++i) { const f32x4_t sh = ((const f32x4_t*)m2)[i], sc = ((const f32x4_t*)(m2 + D))[i];
                const unsigned a = (unsigned)f2bf(v[4 * i] * (1.f + sc[0]) + sh[0]) | ((unsigned)f2bf(v[4 * i + 1] * (1.f + sc[1]) + sh[1]) << 16);
                const unsigned b = (unsigned)f2bf(v[4 * i + 2] * (1.f + sc[2]) + sh[2]) | ((unsigned)f2bf(v[4 * i + 3] * (1.f + sc[3]) + sh[3]) << 16);
                if (i < 2) { o0[2 * i] = a; o0[2 * i + 1] = b; } else { o1[2 * (i - 2)] = a; o1[2 * (i - 2) + 1] = b; } }
            u32x4_t* hp = (u32x4_t*)(hb + (size_t)t * D + lane * 16); hp[0] = o0; hp[1] = o1;
        } else if (t < NX) {
            float* op = p.out + (size_t)t * D + lane * 16;
#pragma unroll
            for (int i = 0; i < 4; ++i) ((f32x4_t*)op)[i] = (f32x4_t){v[4 * i], v[4 * i + 1], v[4 * i + 2], v[4 * i + 3]};
        }
    }
}
#endif
#ifndef CPU_TEST
typedef short bf16x8_t __attribute__((ext_vector_type(8)));
typedef float f32x16_t __attribute__((ext_vector_type(16)));
DEVFN void ph_cvt_keys(const Params& p, size_t gtid, size_t gsize) {
    bf16_t* kb = WSP(bf16_t, WS_KEYS);
    for (size_t i = gtid; i < (size_t)4 * 16 * 128 * 128; i += gsize) kb[i] = f2bf(p.peer_keys[i]);
}
DEVFN void ce1(float& a, float& b) { const float hi = fmaxf(a, b), lo = fminf(a, b); a = hi; b = lo; }
DEVFN void ce2(float& a, int& ia, float& b, int& ib) { const bool sw = b > a; const float ta = sw ? b : a, tb = sw ? a : b; const int ja = sw ? ib : ia, jb = sw ? ia : ib; a = ta; b = tb; ia = ja; ib = jb; }
DEVFN void bsort16(float (&v)[16]) {
#pragma unroll
    for (int k = 2; k <= 16; k <<= 1)
#pragma unroll
        for (int j = k >> 1; j > 0; j >>= 1)
#pragma unroll
            for (int i = 0; i < 16; ++i) { const int l = i ^ j; if (l > i) { if ((i & k) == 0) ce1(v[i], v[l]); else ce1(v[l], v[i]); } }
}
DEVFN void bmerge16(float (&a)[16], const float (&b)[16]) {
#pragma unroll
    for (int i = 0; i < 16; ++i) a[i] = fmaxf(a[i], b[15 - i]);
#pragma unroll
    for (int j = 8; j > 0; j >>= 1)
#pragma unroll
        for (int i = 0; i < 16; ++i) { const int l = i ^ j; if (l > i) ce1(a[i], a[l]); }
}
DEVFN void bsort16p(float (&v)[16], int (&x)[16]) {
#pragma unroll
    for (int k = 2; k <= 16; k <<= 1)
#pragma unroll
        for (int j = k >> 1; j > 0; j >>= 1)
#pragma unroll
            for (int i = 0; i < 16; ++i) { const int l = i ^ j; if (l > i) { if ((i & k) == 0) ce2(v[i], x[i], v[l], x[l]); else ce2(v[l], x[l], v[i], x[i]); } }
}
DEVFN void bmerge16p(float (&a)[16], int (&ia)[16], const float (&b)[16], const int (&ib)[16]) {
#pragma unroll
    for (int i = 0; i < 16; ++i) { const bool sw = b[15 - i] > a[i]; a[i] = sw ? b[15 - i] : a[i]; ia[i] = sw ? ib[15 - i] : ia[i]; }
#pragma unroll
    for (int j = 8; j > 0; j >>= 1)
#pragma unroll
        for (int i = 0; i < 16; ++i) { const int l = i ^ j; if (l > i) ce2(a[i], ia[i], a[l], ia[l]); }
}
DEVFN void peer_top16(float (&top)[16], const bf16_t* qrow  , const bf16_t* kb  , int hi) {
    bf16x8_t qf[8];
#pragma unroll
    for (int ks = 0; ks < 8; ++ks) qf[ks] = *(const bf16x8_t*)(qrow + ks * 16);
    float grp[2][16];
#pragma unroll
    for (int nb = 0; nb < 4; ++nb) {
        f32x16_t acc = {};
#pragma unroll
        for (int ks = 0; ks < 8; ++ks) { const bf16x8_t kf = *(const bf16x8_t*)(kb + (size_t)nb * 32 * 128 + ks * 16); acc = __builtin_amdgcn_mfma_f32_32x32x16_bf16(kf, qf[ks], acc, 0, 0, 0); }
        float v[16];
#pragma unroll
        for (int r = 0; r < 16; ++r) { const unsigned n = (unsigned)(nb * 32 + (r & 3) + 8 * (r >> 2) + 4 * hi); v[r] = __uint_as_float((__float_as_uint(acc[r]) & ~127u) | n); }
        bsort16(v);
        if (nb == 0) {
#pragma unroll
            for (int r = 0; r < 16; ++r) grp[0][r] = v[r];
        } else if (nb == 1) bmerge16(grp[0], v);
        else if (nb == 2) {
#pragma unroll
            for (int r = 0; r < 16; ++r) grp[1][r] = v[r];
        } else { bmerge16(grp[1], v); bmerge16(grp[0], grp[1]); }
        __builtin_amdgcn_sched_barrier(0);
    }
    float oth[16];
#pragma unroll
    for (int r = 0; r < 16; ++r) { auto rr_ = __builtin_amdgcn_permlane32_swap(__float_as_uint(grp[0][r]), __float_as_uint(grp[0][r]), false, false); oth[r] = __uint_as_float(hi ? rr_[0] : rr_[1]); }
    bmerge16(grp[0], oth);
#pragma unroll
    for (int r = 0; r < 16; ++r) top[r] = grp[0][r];
}
DEVFN void ph_peer_route(const Params& p, int l, int M, LAS unsigned char* lds, int tid, int bid, int G) {
    const int lane = tid & 63, hi = lane >> 5, tl = lane & 31;
    const bf16_t* qp = WSP(const bf16_t, WS_QP); const bf16_t* keys = WSP(const bf16_t, WS_KEYS) + (size_t)l * 16 * 128 * 128;
    int* idx = WSP(int, WS_IDX); float* gate = WSP(float, WS_GATE);
    LAS unsigned char* tabl = lds + (tid * 36);
#pragma unroll 1
    for (int item = __builtin_amdgcn_readfirstlane(tid >> 6) * G + bid; item < (M / 32) * 8; item += G * 8) {
        int tile = item >> 3, h = item & 7;
        asm volatile("" : "+s"(tile), "+s"(h));
        const int t = tile * 32 + tl;
        {
            float ta[16], tb[16];
            peer_top16(ta, qp + (size_t)t * 2048 + (h * 2) * 128 + 8 * hi, keys + ((size_t)(h * 2) * 128 + tl) * 128 + 8 * hi, hi);
            __builtin_amdgcn_sched_barrier(0);
            peer_top16(tb, qp + (size_t)t * 2048 + (h * 2 + 1) * 128 + 8 * hi, keys + ((size_t)(h * 2 + 1) * 128 + tl) * 128 + 8 * hi, hi);
#pragma unroll
            for (int j = 0; j < 4; ++j) {
                ((LAS unsigned*)tabl)[j] = (__float_as_uint(ta[4 * j]) & 127u) | ((__float_as_uint(ta[4 * j + 1]) & 127u) << 8) | ((__float_as_uint(ta[4 * j + 2]) & 127u) << 16) | ((__float_as_uint(ta[4 * j + 3]) & 127u) << 24);
                ((LAS unsigned*)tabl)[4 + j] = (__float_as_uint(tb[4 * j]) & 127u) | ((__float_as_uint(tb[4 * j + 1]) & 127u) << 8) | ((__float_as_uint(tb[4 * j + 2]) & 127u) << 16) | ((__float_as_uint(tb[4 * j + 3]) & 127u) << 24);
            }
            float cs[4][16]; int n = 0;
#pragma unroll
            for (int a = 0; a < 16; ++a)
#pragma unroll
                for (int b = 0; b < 16; ++b)
                    if ((a + 1) * (b + 1) <= 16) {
                        const float sm = __uint_as_float(__float_as_uint(ta[a]) & ~127u) + __uint_as_float(__float_as_uint(tb[b]) & ~127u);
                        cs[n >> 4][n & 15] = __uint_as_float((__float_as_uint(sm) & ~255u) | (unsigned)(a * 16 + b)); ++n;
                    }
#pragma unroll
            for (int k = 50; k < 64; ++k) cs[k >> 4][k & 15] = -3.0e38f;
            bsort16(cs[0]); bsort16(cs[1]); bsort16(cs[2]); bsort16(cs[3]);
            bmerge16(cs[0], cs[1]); bmerge16(cs[2], cs[3]); bmerge16(cs[0], cs[2]);
            float e[16], sum = 0.f; const float mx = __uint_as_float(__float_as_uint(cs[0][0]) & ~255u);
#pragma unroll
            for (int j = 0; j < 16; ++j) { e[j] = __expf(__uint_as_float(__float_as_uint(cs[0][j]) & ~255u) - mx); sum += e[j]; }
            const float rs = 1.f / sum;
            if (hi == 0) {
                unsigned id[16];
#pragma unroll
                for (int j = 0; j < 16; ++j) { const unsigned ab = __float_as_uint(cs[0][j]) & 255u; id[j] = (unsigned)tabl[ab >> 4] * 128u + (unsigned)tabl[16 + (ab & 15u)]; }
                u32x4_t* op = (u32x4_t*)(idx + (size_t)t * 128 + h * 16);
#pragma unroll
                for (int j = 0; j < 4; ++j) op[j] = (u32x4_t){id[4 * j], id[4 * j + 1], id[4 * j + 2], id[4 * j + 3]};
            } else {
                f32x4_t* op = (f32x4_t*)(gate + (size_t)t * 128 + h * 16);
#pragma unroll
                for (int j = 0; j < 4; ++j) op[j] = (f32x4_t){e[4 * j] * rs, e[4 * j + 1] * rs, e[4 * j + 2] * rs, e[4 * j + 3] * rs};
            }
        }
    }
}
#endif
#ifndef CPU_TEST
typedef float f32x4v __attribute__((ext_vector_type(4)));
typedef short s16x4v __attribute__((ext_vector_type(4)));
constexpr int GS_QS = 0, GS_KS = 8704, GS_KE = 17408, GS_VT = 27648, GS_D = 37888, GS_GS = 38400, GS_END = 40448;
typedef __bf16 bf16x2_hw __attribute__((ext_vector_type(2)));
DEVFN unsigned pk_bf16(float lo, float hi) { const f32x2_t f = {lo, hi}; return __builtin_bit_cast(unsigned, __builtin_convertvector(f, bf16x2_hw)); }
DEVFN void ph_hgrn_scan_mfma(const Params& p, LAS unsigned char* lds, int tid, int bid) {
    if (bid >= NBAT * 16) return;
    const int dir = bid & 1, h = (bid >> 1) & 7, b = bid >> 4;
    const bf16_t* Z = WSP(const bf16_t, WS_Z); const float* lbv = WSP(const float, WS_LBV); constexpr int LDZ = 5120;
    bf16_t* od = WSP(bf16_t, WS_Y) + (dir ? (size_t)NT * D : 0);
    const int lane = tid & 63, w = tid >> 6, c16 = lane & 15, g = lane >> 4;
    const int pk = tid & 127, ptg = tid >> 7;
    const float lb = lbv[h * 128 + pk];
    constexpr int NCH = (CL + SEQ) / 32;
    f32x4v S[8];
#pragma unroll
    for (int i = 0; i < 8; ++i) S[i] = (f32x4v){0.f, 0.f, 0.f, 0.f};
    auto trow = [&](int s) -> size_t { return s < CL ? (size_t)(NX + b * CL + (dir ? CL - 1 - s : s)) : (size_t)(b * SEQ + (dir ? SEQ - 1 - (s - CL) : s - CL)); };
    unsigned short rq[8], rf[8], rv[8];
#pragma unroll
    for (int i = 0; i < 8; ++i) { const bf16_t* zr = Z + trow(8 * ptg + i) * LDZ + h * 128 + pk; rq[i] = zr[0]; rv[i] = zr[1024]; rf[i] = zr[dir ? 3072 : 2048]; }
#pragma unroll 1
    for (int c = 0; c < NCH; ++c) {
        float qv[8], kk[8], cum[8], vv[8]; float run = 0.f;
#pragma unroll
        for (int i = 0; i < 8; ++i) {
            const float f = lb + (1.f - lb) / (1.f + __expf(-bf2f(rf[i])));
            run += __logf(f); cum[i] = run; kk[i] = 1.f - f;
            const float q = bf2f(rq[i]); qv[i] = q / (1.f + __expf(-q)); vv[i] = bf2f(rv[i]);
        }
        if (c + 1 < NCH) {
#pragma unroll
            for (int i = 0; i < 8; ++i) { const bf16_t* zr = Z + trow((c + 1) * 32 + 8 * ptg + i) * LDZ + h * 128 + pk; rq[i] = zr[0]; rv[i] = zr[1024]; rf[i] = zr[dir ? 3072 : 2048]; }
        }
        ((LAS float*)(lds + GS_GS))[ptg * 128 + pk] = run;
        __syncthreads();
        float off = 0.f, bend = 0.f;
#pragma unroll
        for (int j = 0; j < 4; ++j) { const float gsum = ((LAS float*)(lds + GS_GS))[j * 128 + pk]; off += j < ptg ? gsum : 0.f; bend += gsum; }
        unsigned kew[4], vtw[4];
#pragma unroll
        for (int i = 0; i < 8; ++i) {
            const float B = off + cum[i], eB = __expf(B), eN = __expf(-B), eE = __expf(bend - B);
            const int t = 8 * ptg + i;
            *(LAS bf16_t*)(lds + GS_QS + t * 272 + pk * 2) = f2bf(qv[i] * eB);
            *(LAS bf16_t*)(lds + GS_KS + t * 272 + pk * 2) = f2bf(kk[i] * eN);
            const unsigned ke = f2bf(kk[i] * eE), vt = f2bf(vv[i]);
            if (i & 1) { kew[i >> 1] |= ke << 16; vtw[i >> 1] |= vt << 16; } else { kew[i >> 1] = ke; vtw[i >> 1] = vt; }
        }
        *(LAS u32x4_t*)(lds + GS_KE + pk * 80 + ptg * 16) = (u32x4_t){kew[0], kew[1], kew[2], kew[3]};
        *(LAS u32x4_t*)(lds + GS_VT + pk * 80 + ptg * 16) = (u32x4_t){vtw[0], vtw[1], vtw[2], vtw[3]};
        if (ptg == 0) ((LAS float*)(lds + GS_D))[pk] = __expf(bend);
        __syncthreads();
        f32x4v X00 = {0.f, 0.f, 0.f, 0.f}, X01 = X00, X11 = X00;
#pragma unroll
        for (int ks = 0; ks < 4; ++ks) {
            const bf16x8_t a0 = *(const LAS bf16x8_t*)(lds + GS_KS + c16 * 272 + ks * 64 + g * 16), a1 = *(const LAS bf16x8_t*)(lds + GS_KS + (16 + c16) * 272 + ks * 64 + g * 16);
            const bf16x8_t b0 = *(const LAS bf16x8_t*)(lds + GS_QS + c16 * 272 + ks * 64 + g * 16), b1 = *(const LAS bf16x8_t*)(lds + GS_QS + (16 + c16) * 272 + ks * 64 + g * 16);
            X00 = __builtin_amdgcn_mfma_f32_16x16x32_bf16(a0, b0, X00, 0, 0, 0);
            X01 = __builtin_amdgcn_mfma_f32_16x16x32_bf16(a0, b1, X01, 0, 0, 0);
            X11 = __builtin_amdgcn_mfma_f32_16x16x32_bf16(a1, b1, X11, 0, 0, 0);
        }
#pragma unroll
        for (int r = 0; r < 4; ++r) { const bool keep = (4 * g + r) <= c16; X00[r] = keep ? X00[r] : 0.f; X11[r] = keep ? X11[r] : 0.f; }
        const u32x4_t p0w = (u32x4_t){pk_bf16(X00[0], X00[1]), pk_bf16(X00[2], X00[3]), 0u, 0u};
        const u32x4_t p1w = (u32x4_t){pk_bf16(X01[0], X01[1]), pk_bf16(X01[2], X01[3]), pk_bf16(X11[0], X11[1]), pk_bf16(X11[2], X11[3])};
        const int vrow = (16 * w + c16) * 80;
        const s16x4v vlo = *(const LAS s16x4v*)(lds + GS_VT + vrow + g * 8), vhi = *(const LAS s16x4v*)(lds + GS_VT + vrow + 32 + g * 8);
        const bf16x8_t vperm = (bf16x8_t){vlo[0], vlo[1], vlo[2], vlo[3], vhi[0], vhi[1], vhi[2], vhi[3]};
        f32x4v o0 = {0.f, 0.f, 0.f, 0.f}, o1 = o0;
        o0 = __builtin_amdgcn_mfma_f32_16x16x32_bf16(__builtin_bit_cast(bf16x8_t, p0w), vperm, o0, 0, 0, 0);
        o1 = __builtin_amdgcn_mfma_f32_16x16x32_bf16(__builtin_bit_cast(bf16x8_t, p1w), vperm, o1, 0, 0, 0);
#pragma unroll
        for (int ks = 0; ks < 4; ++ks) {
            const u32x4_t sw = (u32x4_t){pk_bf16(S[2 * ks][0], S[2 * ks][1]), pk_bf16(S[2 * ks][2], S[2 * ks][3]), pk_bf16(S[2 * ks + 1][0], S[2 * ks + 1][1]), pk_bf16(S[2 * ks + 1][2], S[2 * ks + 1][3])};
            const bf16x8_t sb = __builtin_bit_cast(bf16x8_t, sw);
            const s16x4v q0l = *(const LAS s16x4v*)(lds + GS_QS + c16 * 272 + ks * 64 + g * 8), q0h = *(const LAS s16x4v*)(lds + GS_QS + c16 * 272 + ks * 64 + 32 + g * 8);
            const s16x4v q1l = *(const LAS s16x4v*)(lds + GS_QS + (16 + c16) * 272 + ks * 64 + g * 8), q1h = *(const LAS s16x4v*)(lds + GS_QS + (16 + c16) * 272 + ks * 64 + 32 + g * 8);
            o0 = __builtin_amdgcn_mfma_f32_16x16x32_bf16((bf16x8_t){q0l[0], q0l[1], q0l[2], q0l[3], q0h[0], q0h[1], q0h[2], q0h[3]}, sb, o0, 0, 0, 0);
            o1 = __builtin_amdgcn_mfma_f32_16x16x32_bf16((bf16x8_t){q1l[0], q1l[1], q1l[2], q1l[3], q1h[0], q1h[1], q1h[2], q1h[3]}, sb, o1, 0, 0, 0);
        }
#pragma unroll
        for (int r = 0; r < 4; ++r) {
            od[trow(c * 32 + 4 * g + r) * D + h * 128 + 16 * w + c16] = f2bf(o0[r]);
            od[trow(c * 32 + 16 + 4 * g + r) * D + h * 128 + 16 * w + c16] = f2bf(o1[r]);
        }
        const bf16x8_t vb = *(const LAS bf16x8_t*)(lds + GS_VT + vrow + g * 16);
#pragma unroll
        for (int kt = 0; kt < 8; ++kt) {
            const f32x4v dv = *(const LAS f32x4v*)(lds + GS_D + (16 * kt + 4 * g) * 4);
            const bf16x8_t ka = *(const LAS bf16x8_t*)(lds + GS_KE + (16 * kt + c16) * 80 + g * 16);
            S[kt] = __builtin_amdgcn_mfma_f32_16x16x32_bf16(ka, vb, S[kt] * dv, 0, 0, 0);
        }
        __syncthreads();
    }
}
#endif
#ifndef CPU_TEST
constexpr int AW_K = 0, AW_V = 4608, AW_BYTES = 9728;
struct AttW { f32x16_t o0, o1; float m, l; };
DEVFN void attw_load(u32x4_t (&kreg)[4], u32x4_t (&vreg)[4], const bf16_t* kp, const bf16_t* vp) {
#pragma unroll
    for (int i = 0; i < 4; ++i) { kreg[i] = ((const u32x4_t*)kp)[i]; vreg[i] = ((const u32x4_t*)vp)[i]; }
}
template <class F>
DEVFN void attw_tile(AttW& a, const bf16x8_t (&qf)[4], const u32x4_t (&kreg)[4], const u32x4_t (&vreg)[4], LAS unsigned char* wl, int lane, float c2, F bias2) {
    const int krow = lane >> 1, dhalf = lane & 1, q31 = lane & 31, hi = lane >> 5;
#pragma unroll
    for (int i = 0; i < 4; ++i) *(LAS u32x4_t*)(wl + AW_K + krow * 144 + dhalf * 64 + i * 16) = kreg[i];
#pragma unroll
    for (int i = 0; i < 4; ++i)
#pragma unroll
        for (int e = 0; e < 4; ++e) { const int d = dhalf * 32 + i * 8 + e * 2;
            *(LAS bf16_t*)(wl + AW_V + d * 80 + krow * 2) = (bf16_t)(vreg[i][e] & 0xffffu); *(LAS bf16_t*)(wl + AW_V + (d + 1) * 80 + krow * 2) = (bf16_t)(vreg[i][e] >> 16); }
    f32x16_t s = {};
#pragma unroll
    for (int ks = 0; ks < 4; ++ks) { const bf16x8_t kf = *(const LAS bf16x8_t*)(wl + AW_K + q31 * 144 + ks * 32 + hi * 16); s = __builtin_amdgcn_mfma_f32_32x32x16_bf16(kf, qf[ks], s, 0, 0, 0); }
    float mx = -1e30f;
#pragma unroll
    for (int r = 0; r < 16; ++r) { s[r] = s[r] * c2 + bias2(r); mx = fmaxf(mx, s[r]); }
    { auto rr_ = __builtin_amdgcn_permlane32_swap(__float_as_uint(mx), __float_as_uint(mx), false, false); mx = fmaxf(__uint_as_float(rr_[0]), __uint_as_float(rr_[1])); }
    const float mnew = fmaxf(a.m, mx), alpha = __builtin_amdgcn_exp2f(a.m - mnew); a.m = mnew;
    float ps = 0.f;
#pragma unroll
    for (int r = 0; r < 16; ++r) { s[r] = __builtin_amdgcn_exp2f(s[r] - mnew); ps += s[r]; }
    a.l = a.l * alpha + ps;
#pragma unroll
    for (int r = 0; r < 16; ++r) { a.o0[r] *= alpha; a.o1[r] *= alpha; }
    const u32x4_t pw0 = (u32x4_t){pk_bf16(s[0], s[1]), pk_bf16(s[2], s[3]), pk_bf16(s[4], s[5]), pk_bf16(s[6], s[7])};
    const u32x4_t pw1 = (u32x4_t){pk_bf16(s[8], s[9]), pk_bf16(s[10], s[11]), pk_bf16(s[12], s[13]), pk_bf16(s[14], s[15])};
    const bf16x8_t pb0 = __builtin_bit_cast(bf16x8_t, pw0), pb1 = __builtin_bit_cast(bf16x8_t, pw1);
#pragma unroll
    for (int db = 0; db < 2; ++db) {
        const LAS unsigned char* vr = wl + AW_V + (32 * db + q31) * 80 + hi * 8;
        const s16x4v a0 = *(const LAS s16x4v*)(vr), a1 = *(const LAS s16x4v*)(vr + 16), b0 = *(const LAS s16x4v*)(vr + 32), b1 = *(const LAS s16x4v*)(vr + 48);
        const bf16x8_t vf0 = (bf16x8_t){a0[0], a0[1], a0[2], a0[3], a1[0], a1[1], a1[2], a1[3]}, vf1 = (bf16x8_t){b0[0], b0[1], b0[2], b0[3], b1[0], b1[1], b1[2], b1[3]};
        if (db == 0) { a.o0 = __builtin_amdgcn_mfma_f32_32x32x16_bf16(vf0, pb0, a.o0, 0, 0, 0); a.o0 = __builtin_amdgcn_mfma_f32_32x32x16_bf16(vf1, pb1, a.o0, 0, 0, 0); }
        else { a.o1 = __builtin_amdgcn_mfma_f32_32x32x16_bf16(vf0, pb0, a.o1, 0, 0, 0); a.o1 = __builtin_amdgcn_mfma_f32_32x32x16_bf16(vf1, pb1, a.o1, 0, 0, 0); }
    }
}
DEVFN void attw_store(const AttW& a, float sc, LAS unsigned char* wl, int lane, bf16_t* orow0, size_t ldo, int skip16 = 0) {
    const int q31 = lane & 31, hi = lane >> 5;
#pragma unroll
    for (int r = 0; r < 16; ++r) { const int d = (r & 3) + 8 * (r >> 2) + 4 * hi;
        *(LAS bf16_t*)(wl + q31 * 144 + d * 2) = f2bf(a.o0[r] * sc); *(LAS bf16_t*)(wl + q31 * 144 + (32 + d) * 2) = f2bf(a.o1[r] * sc); }
    const int qrow = lane >> 1, dhalf = lane & 1;
#pragma unroll
    for (int i = 0; i < 4; ++i) { const u32x4_t v = *(const LAS u32x4_t*)(wl + qrow * 144 + dhalf * 64 + i * 16); *(u32x4_t*)(orow0 + (size_t)(qrow + (qrow >> 4) * skip16) * ldo + dhalf * 32 + i * 8) = v; }
}
DEVFN void attw_qload(bf16x8_t (&qf)[4], const bf16_t* qrow  ) {
#pragma unroll
    for (int ks = 0; ks < 4; ++ks) qf[ks] = *(const bf16x8_t*)(qrow + ks * 16);
}
constexpr float LOG2E = 1.4426950408889634f;
DEVFN void ph_swa_attn_mfma(const Params& p, LAS unsigned char* lds, int tid, int bid, int G) {
    const bf16_t* Z = WSP(const bf16_t, WS_Z); bf16_t* att = WSP(bf16_t, WS_ATT); constexpr int LDZ = 1536;
    const int lane = tid & 63, wv = __builtin_amdgcn_readfirstlane(tid >> 6), q31 = lane & 31, hi = lane >> 5, krow = lane >> 1, dhalf = lane & 1;
    LAS unsigned char* wl = lds + wv * AW_BYTES;
    constexpr int XT = SEQ / 32, CT = CL / 32, NIT = NBAT * 4 * (XT + CT) * 4;
    const float c2 = 0.125f * LOG2E;
    for (int it = wv * G + bid; it < NIT; it += G * 8) {
        const int hg = it & 3, qt = (it >> 2) % (XT + CT), kvh = ((it >> 2) / (XT + CT)) & 3, b = (it >> 2) / ((XT + CT) * 4), hq = kvh * 4 + hg;
        const bool isx = qt < XT; const int q0 = isx ? qt * 32 : (qt - XT) * 32;
        const size_t qtok0 = isx ? (size_t)b * SEQ + q0 : (size_t)NX + b * CL + q0;
        bf16x8_t qf[4]; attw_qload(qf, Z + (qtok0 + q31) * LDZ + hq * 64 + 8 * hi);
        AttW a; a.o0 = (f32x16_t){}; a.o1 = (f32x16_t){}; a.m = -1e30f; a.l = 0.f;
        const int lo = isx ? imax(0, q0 - 128) : 0, hiK = isx ? imin(SEQ - 32, q0 + 128) : -32;
        const int nband = (hiK - lo) / 32 + 1, ntile = CT + (isx ? nband : 0);
        const size_t koff = 1024 + kvh * 64 + dhalf * 32, voff = 1280 + kvh * 64 + dhalf * 32;
        auto krow_tok = [&](int ti) -> size_t { return ti < CT ? (size_t)NX + b * CL + ti * 32 + krow : (size_t)b * SEQ + lo + (ti - CT) * 32 + krow; };
        u32x4_t kr[4], vr[4];
        { const size_t tk = krow_tok(0); attw_load(kr, vr, Z + tk * LDZ + koff, Z + tk * LDZ + voff); }
#pragma unroll 1
        for (int ti = 0; ti < ntile; ++ti) {
            u32x4_t kn[4], vn[4];
            { const size_t tk = krow_tok(ti + 1 < ntile ? ti + 1 : ti); attw_load(kn, vn, Z + tk * LDZ + koff, Z + tk * LDZ + voff); }
            if (ti < CT) attw_tile(a, qf, kr, vr, wl, lane, c2, [](int) { return 0.f; });
            else { const int dk = lo + (ti - CT) * 32 - q0 - q31 + 4 * hi;
                attw_tile(a, qf, kr, vr, wl, lane, c2, [dk](int r) { const int dd = dk + (r & 3) + 8 * (r >> 2); return (dd > 128 || dd < -128) ? -1e30f : 0.f; }); }
#pragma unroll
            for (int i = 0; i < 4; ++i) { kr[i] = kn[i]; vr[i] = vn[i]; }
        }
        const float sk2 = p.swa_sink[hq] * LOG2E, mf = fmaxf(a.m, sk2), al = __builtin_amdgcn_exp2f(a.m - mf);
        const float lt = (a.l + __shfl_xor(a.l, 32)) * al + __builtin_amdgcn_exp2f(sk2 - mf);
        attw_store(a, al / lt, wl, lane, att + qtok0 * D + hq * 64, D);
    }
}
DEVFN void ph_na_attn_mfma(const Params& p, LAS unsigned char* lds, int tid, int bid, int G) {
    const bf16_t* Z = WSP(const bf16_t, WS_Z); bf16_t* att = WSP(bf16_t, WS_ATT); constexpr int LDZ = 3072;
    const int lane = tid & 63, wv = __builtin_amdgcn_readfirstlane(tid >> 6), q31 = lane & 31, hi = lane >> 5, krow = lane >> 1, dhalf = lane & 1;
    LAS unsigned char* wl = lds + wv * AW_BYTES;
    constexpr int XT = SEQ / 32, CT = CL / 32, NIT = NBAT * 16 * (XT + CT);
    const float c2 = 0.125f * LOG2E;
    for (int it = wv * G + bid; it < NIT; it += G * 8) {
        const int qt = it % (XT + CT), hq = (it / (XT + CT)) & 15, b = it / ((XT + CT) * 16);
        const bool isx = qt < XT; const int q0 = isx ? qt * 32 : (qt - XT) * 32;
        const size_t qtok0 = isx ? (size_t)b * SEQ + q0 : (size_t)NX + b * CL + q0;
        bf16x8_t qf[4]; attw_qload(qf, Z + (qtok0 + q31) * LDZ + hq * 64 + 8 * hi);
        AttW a; a.o0 = (f32x16_t){}; a.o1 = (f32x16_t){}; a.m = -1e30f; a.l = 0.f;
        const int r = q0 / GW, c = (q0 % GW) + q31;
        const int rstart = iclamp(r - 4, 0, NROWS - 8), cstart = iclamp(c - 8, 0, GW - 16);
        const int ntile = CT + (isx ? 16 : 0);
        const size_t koff = 1024 + hq * 64 + dhalf * 32, voff = 2048 + hq * 64 + dhalf * 32;
        auto krow_tok = [&](int ti) -> size_t { return ti < CT ? (size_t)NX + b * CL + ti * 32 + krow : (size_t)b * SEQ + (rstart + ((ti - CT) >> 1)) * GW + ((ti - CT) & 1) * 32 + krow; };
        const float* rpb = p.na_rpb + (size_t)hq * 15 * 31;
        u32x4_t kr[4], vr[4];
        { const size_t tk = krow_tok(0); attw_load(kr, vr, Z + tk * LDZ + koff, Z + tk * LDZ + voff); }
#pragma unroll 1
        for (int ti = 0; ti < ntile; ++ti) {
            u32x4_t kn[4], vn[4];
            { const size_t tk = krow_tok(ti + 1 < ntile ? ti + 1 : ti); attw_load(kn, vn, Z + tk * LDZ + koff, Z + tk * LDZ + voff); }
            if (ti < CT) attw_tile(a, qf, kr, vr, wl, lane, c2, [](int) { return 0.f; });
            else { const int kr_ = rstart + ((ti - CT) >> 1), kc0 = ((ti - CT) & 1) * 32 + 4 * hi;
                const float* rp = rpb + (kr_ - r + 7) * 31 + 15 - c;
                attw_tile(a, qf, kr, vr, wl, lane, c2, [=](int rr) { const int kc = kc0 + (rr & 3) + 8 * (rr >> 2); const bool ok = kc >= cstart && kc < cstart + 16;
                    return ok ? rp[ok ? kc : c] * LOG2E : -1e30f; }); }
#pragma unroll
            for (int i = 0; i < 4; ++i) { kr[i] = kn[i]; vr[i] = vn[i]; }
        }
        const float lt = a.l + __shfl_xor(a.l, 32);
        attw_store(a, 1.f / lt, wl, lane, att + qtok0 * D + hq * 64, D);
    }
}
#endif
#ifndef CPU_TEST
DEVFN void tr_tile(const float* W, int N, bf16_t* WT, int item, LAS float* scr, int lane) {
    const int nblk = N / 32, kb = item / nblk, nb = item % nblk, k0 = 64 * kb, n0 = 32 * nb;
#pragma unroll 8
    for (int i = 0; i < 32; ++i) { const int kk = 2 * i + (lane >> 5); scr[kk * 33 + (lane & 31)] = W[(size_t)(k0 + kk) * N + n0 + (lane & 31)]; }
    const int c = lane & 7;
#pragma unroll
    for (int j = 0; j < 4; ++j) { const int n = (lane >> 3) + 8 * j; const LAS float* sp = scr + (8 * c) * 33 + n;
        u32x4_t o; o.x = pk_bf16(sp[0 * 33], sp[1 * 33]); o.y = pk_bf16(sp[2 * 33], sp[3 * 33]); o.z = pk_bf16(sp[4 * 33], sp[5 * 33]); o.w = pk_bf16(sp[6 * 33], sp[7 * 33]);
        *(u32x4_t*)(WT + (size_t)(n0 + n) * D + k0 + 8 * c) = o; }
}
DEVFN void ph_pro_gpu(const Params& p, LAS unsigned char* lds, int tid, int bid, int G, size_t gtid, size_t gsize) {
    const int lane = tid & 63, wv = __builtin_amdgcn_readfirstlane(tid >> 6);
    {
        LAS float* scr = (LAS float*)(lds + 61440 + wv * 8448);
        constexpr int I5120 = 16 * 160, I1536 = 16 * 48, I3072 = 16 * 96, I1024 = 16 * 32, I2048 = 16 * 64;
        constexpr int NITEMS = I5120 + 2 * I1536 + I3072 + 4 * I1024 + 4 * I2048;
        for (int it = wv * G + bid; it < NITEMS; it += G * 8) {
            int r = it;
            if (r < I5120) { tr_tile(p.hgrn_w_in, 5120, WSP(bf16_t, WS_WIN0), r, scr, lane); continue; } r -= I5120;
            if (r < I1536) { tr_tile(p.swa_w_in, 1536, WSP(bf16_t, WS_WIN1), r, scr, lane); continue; } r -= I1536;
            if (r < I3072) { tr_tile(p.na_w_in, 3072, WSP(bf16_t, WS_WIN2), r, scr, lane); continue; } r -= I3072;
            if (r < I1536) { tr_tile(p.gqa_w_in, 1536, WSP(bf16_t, WS_WIN3), r, scr, lane); continue; } r -= I1536;
            if (r < 4 * I1024) { const int m = r / I1024; const float* W = m == 0 ? p.hgrn_w_out : m == 1 ? p.swa_w_out : m == 2 ? p.na_w_out : p.gqa_w_out;
                tr_tile(W, 1024, WSP(bf16_t, WS_WOUT) + (size_t)m * D * D, r % I1024, scr, lane); continue; } r -= 4 * I1024;
            { const int m = r / I2048; tr_tile(p.peer_wq + (size_t)m * D * 2048, 2048, WSP(bf16_t, WS_WQ) + (size_t)m * 2048 * D, r % I2048, scr, lane); }
        }
    }
    {
        LAS float* sil = (LAS float*)lds;
        for (int i = tid; i < NMR * D; i += 512) { const int r = i / D, k = i % D; const float v = r < NBAT ? p.c[(size_t)r * D + k] : p.c_ctx[k]; sil[i] = v / (1.f + __expf(-v)); }
        __syncthreads();
        LAS float* red = (LAS float*)(lds + 40960);
        float* modv = WSP(float, WS_MODV);
        for (int item = bid; item < DEPTH * 48; item += G) {
            const int l = item / 48, cb = item % 48, ch = wv & 1, kq = wv >> 1, col = cb * 128 + ch * 64 + lane;
            const float* w = p.mod_w + (size_t)l * D * 6144 + (size_t)(kq * 256) * 6144 + col;
            float acc[NMR];
#pragma unroll
            for (int r = 0; r < NMR; ++r) acc[r] = 0.f;
#pragma unroll 4
            for (int k = 0; k < 256; ++k) { const float wv_ = w[(size_t)k * 6144];
#pragma unroll
                for (int r = 0; r < NMR; ++r) acc[r] = fmaf(sil[r * D + kq * 256 + k], wv_, acc[r]); }
#pragma unroll
            for (int r = 0; r < NMR; ++r) red[(wv * NMR + r) * 64 + lane] = acc[r];
            __syncthreads();
            if (kq == 0) {
#pragma unroll
                for (int r = 0; r < NMR; ++r) { float s = 0.f;
#pragma unroll
                    for (int q = 0; q < 4; ++q) s += red[((q * 2 + ch) * NMR + r) * 64 + lane];
                    modv[(size_t)(l * NMR + r) * 6144 + col] = s + p.mod_b[l * 6144 + col]; }
            }
            __syncthreads();
        }
    }
    float* lbv = WSP(float, WS_LBV);
    for (size_t c = gtid; c < (size_t)D; c += gsize) {
        float m = -1e30f;
        for (int j = 0; j < DEPTH + 1; ++j) m = fmaxf(m, p.hgrn_lb[j * D + c]);
        float sum = 0.f;
        for (int j = 0; j < DEPTH + 1; ++j) sum += expf(p.hgrn_lb[j * D + c] - m);
        lbv[c] = expf(p.hgrn_lb[c] - m) / sum;
    }
    float* rope = WSP(float, WS_ROPE);
    for (size_t i = gtid; i < (size_t)64 * 16; i += gsize) { const int pos = (int)(i / 16), fi = (int)(i % 16); const float ang = (float)pos * expf(-(float)(2 * fi) / 32.f * LN_THETA); rope[ROPE64_COS + i] = cosf(ang); rope[ROPE64_SIN + i] = sinf(ang); }
    for (size_t i = gtid; i < (size_t)64 * 32; i += gsize) { const int pos = (int)(i / 32), fi = (int)(i % 32); const float ang = (float)pos * expf(-(float)(2 * fi) / 64.f * LN_THETA); rope[ROPE128_COS + i] = cosf(ang); rope[ROPE128_SIN + i] = sinf(ang); }
    ph_cvt_keys(p, gtid, gsize);
}
DEVFN u32x4_t mod8(const f32x4_t a, const f32x4_t b, const float* shift, const float* scale) {
    const f32x4_t s0 = ((const f32x4_t*)shift)[0], s1 = ((const f32x4_t*)shift)[1], c0 = ((const f32x4_t*)scale)[0], c1 = ((const f32x4_t*)scale)[1];
    return (u32x4_t){pk_bf16(a[0] * (1.f + c0[0]) + s0[0], a[1] * (1.f + c0[1]) + s0[1]), pk_bf16(a[2] * (1.f + c0[2]) + s0[2], a[3] * (1.f + c0[3]) + s0[3]),
                     pk_bf16(b[0] * (1.f + c1[0]) + s1[0], b[1] * (1.f + c1[1]) + s1[1]), pk_bf16(b[2] * (1.f + c1[2]) + s1[2], b[3] * (1.f + c1[3]) + s1[3])};
}
DEVFN void ph_h0_gpu(const Params& p, size_t gtid, size_t gsize) {
    const float* xs = WSP(float, WS_XS); const float* modv = WSP(float, WS_MODV); bf16_t* hb = WSP(bf16_t, WS_HB);
    for (size_t i = gtid; i < (size_t)NT * D / 4; i += gsize) {
        const int t = (int)(i / (D / 4)), c = (int)(i % (D / 4)) * 4;
        const float* m = modv + (size_t)modrow(t) * 6144;
        const float* xin = t < NX ? p.x + (size_t)t * D : p.ctx + (size_t)(t - NX) * D;
        const f32x4_t a = *(const f32x4_t*)(xin + c), sh = *(const f32x4_t*)(m + c), sc = *(const f32x4_t*)(m + D + c);
        const f32x4_t hv = a * (sc + 1.f) + sh;
        *(u32x2_t*)(hb + (size_t)t * D + c) = (u32x2_t){pk_bf16(hv[0], hv[1]), pk_bf16(hv[2], hv[3])};
    }
}
DEVFN void unpack8(const u32x4_t w, float (&v)[8]) {
#pragma unroll
    for (int i = 0; i < 4; ++i) { v[2 * i] = __uint_as_float(w[i] << 16); v[2 * i + 1] = __uint_as_float(w[i] & 0xffff0000u); }
}
DEVFN u32x4_t pack8(const float (&v)[8]) { return (u32x4_t){pk_bf16(v[0], v[1]), pk_bf16(v[2], v[3]), pk_bf16(v[4], v[5]), pk_bf16(v[6], v[7])}; }
DEVFN void ph_swa_rope_gpu(const Params& p, size_t gtid, size_t gsize) {
    bf16_t* Z = WSP(bf16_t, WS_Z); const float* rope = WSP(const float, WS_ROPE); constexpr int LDZ = 1536;
    for (size_t i = gtid; i < (size_t)NX * 20 * 4; i += gsize) {
        const int gq = (int)(i & 1), a = (int)((i >> 1) & 1), hh = (int)((i >> 2) % 20), t = (int)(i / 80);
        const int s = t % SEQ, pos = a == 0 ? s / GW : s % GW;
        bf16_t* zp = Z + (size_t)t * LDZ + hh * 64 + a * 32 + gq * 8;
        float x1[8], x2[8], o1[8], o2[8];
        unpack8(*(const u32x4_t*)zp, x1); unpack8(*(const u32x4_t*)(zp + 16), x2);
        const float* cs = rope + ROPE64_COS + pos * 16 + gq * 8; const float* sn = rope + ROPE64_SIN + pos * 16 + gq * 8;
#pragma unroll
        for (int e = 0; e < 8; ++e) { o1[e] = x1[e] * cs[e] - x2[e] * sn[e]; o2[e] = x2[e] * cs[e] + x1[e] * sn[e]; }
        *(u32x4_t*)zp = pack8(o1); *(u32x4_t*)(zp + 16) = pack8(o2);
    }
}
DEVFN void ph_gqa_prep_gpu(const Params& p, size_t gtid, size_t gsize) {
    bf16_t* Z = WSP(bf16_t, WS_Z); const float* rope = WSP(const float, WS_ROPE); constexpr int LDZ = 1536;
    const size_t nitem = (size_t)NT * 2 * 16;
    for (size_t i = gtid; i < nitem; i += gsize) {
        const int j = (int)(i & 15), hh = 8 + (int)((i >> 4) & 1), t = (int)(i / 32);
        bf16_t* zp = Z + (size_t)t * LDZ + hh * 128 + j * 8;
        const float* g = (hh < 8 ? p.gqa_q_norm : p.gqa_k_norm) + j * 8;
        float x[8]; unpack8(*(const u32x4_t*)zp, x);
        float ss = 0.f;
#pragma unroll
        for (int e = 0; e < 8; ++e) ss += x[e] * x[e];
        ss += dppf(ss, 0xB1); ss += dppf(ss, 0x4E); ss += dppf(ss, 0x141); ss += dppf(ss, 0x140);
        const float r = 1.f / sqrtf(ss * (1.f / 128.f) + RMS_EPS);
#pragma unroll
        for (int e = 0; e < 8; ++e) x[e] = x[e] * r * g[e];
        float o[8];
        float y[8];
#pragma unroll
        for (int e = 0; e < 8; ++e) y[e] = __int_as_float(dpp_xor4(__float_as_int(x[e])));
        if (t < NX) {
            const int s = t % SEQ, a = j >> 3, pos = a == 0 ? s / GW : s % GW, fq = (j & 3) * 8; const bool second = (j & 4) != 0;
            const float* cs = rope + ROPE128_COS + pos * 32 + fq; const float* sn = rope + ROPE128_SIN + pos * 32 + fq;
#pragma unroll
            for (int e = 0; e < 8; ++e) o[e] = second ? x[e] * cs[e] + y[e] * sn[e] : x[e] * cs[e] - y[e] * sn[e];
        } else {
#pragma unroll
            for (int e = 0; e < 8; ++e) o[e] = x[e];
        }
        *(u32x4_t*)zp = pack8(o);
    }
}
DEVFN void ph_hgrn_readout_gpu(const Params& p, int tid, int bid, int G) {
    const bf16_t* Z = WSP(const bf16_t, WS_Z); constexpr int LDZ = 5120;
    const bf16_t* of = WSP(const bf16_t, WS_Y); const bf16_t* ob = of + (size_t)NT * D; bf16_t* att = WSP(bf16_t, WS_ATT);
    const int lane = tid & 63, wv = __builtin_amdgcn_readfirstlane(tid >> 6);
    const float* ng = p.hgrn_norm_g + (lane & 15) * 8;
    for (int t = wv * G + bid; t < NT; t += G * 8) {
#pragma unroll
        for (int j = 0; j < 2; ++j) {
            const size_t off = (size_t)t * D + 512 * j + lane * 8;
            float a[8], b[8], gz[8];
            unpack8(*(const u32x4_t*)(of + off), a); unpack8(*(const u32x4_t*)(ob + off), b); unpack8(*(const u32x4_t*)(Z + (size_t)t * LDZ + 4096 + 512 * j + lane * 8), gz);
            float ss = 0.f;
#pragma unroll
            for (int e = 0; e < 8; ++e) { a[e] += b[e]; ss += a[e] * a[e]; }
            ss += dppf(ss, 0xB1); ss += dppf(ss, 0x4E); ss += dppf(ss, 0x141); ss += dppf(ss, 0x140);
            const float r = 1.f / sqrtf(ss * (1.f / 128.f) + RMS_EPS);
            float o[8];
#pragma unroll
            for (int e = 0; e < 8; ++e) o[e] = a[e] * r * ng[e] * gz[e] / (1.f + __expf(-gz[e]));
            *(u32x4_t*)(att + off) = pack8(o);
        }
    }
}
DEVFN void ph_ln1_gpu(const Params& p, int l, int M, int tid, int bid, int G, int dry = 0) {
    bf16_t* xs = WSP(bf16_t, WS_XS); const bf16_t* Yb = WSP(const bf16_t, WS_Y); const float* modv = WSP(const float, WS_MODV); bf16_t* hb = WSP(bf16_t, WS_HB);
    const int lane = tid & 63, wv = __builtin_amdgcn_readfirstlane(tid >> 6);
    bf16_t* xs_o = dry ? WSP(bf16_t, WS_Z) : xs; bf16_t* hb_o = dry ? WSP(bf16_t, WS_Z + (size_t)NT * 4096) : hb;
    unsigned char* hqh_o = dry ? WSP(unsigned char, WS_Z + (size_t)NT * 6144) : WSP(unsigned char, WS_HQH); unsigned char* hql_o = dry ? WSP(unsigned char, WS_Z + (size_t)NT * 7168) : WSP(unsigned char, WS_HQL);
    float* hqs_o = dry ? WSP(float, WS_Z + (size_t)NT * 8192) : WSP(float, WS_HQS);
    const f32x4_t* lg0 = (const f32x4_t*)(p.ln_g + (size_t)(l * 2) * D) + lane; const f32x4_t* lb0 = (const f32x4_t*)(p.ln_b + (size_t)(l * 2) * D) + lane;
    const int t0 = wv * G + bid, tstep = G * 8;
    f32x4_t nxf[4]; u32x2_t nxb[4], ny[4];
#define LN1_LOAD(tt) { const int tt_ = (tt); const u32x2_t* yp = (const u32x2_t*)(Yb + (size_t)tt_ * D) + lane; \
        if (l == 0) { const f32x4_t* xp = (const f32x4_t*)(tt_ < NX ? p.x + (size_t)tt_ * D : p.ctx + (size_t)(tt_ - NX) * D) + lane; _Pragma("unroll") for (int j = 0; j < 4; ++j) nxf[j] = xp[64 * j]; } \
        else { const u32x2_t* xp = (const u32x2_t*)(xs + (size_t)tt_ * D) + lane; _Pragma("unroll") for (int j = 0; j < 4; ++j) nxb[j] = xp[64 * j]; } \
        _Pragma("unroll") for (int j = 0; j < 4; ++j) ny[j] = yp[64 * j]; }
    LN1_LOAD(imin(t0, M - 1))
    for (int t = t0; t < M; t += tstep) {
        const f32x4_t* lg = lg0; const f32x4_t* lb = lb0; asm volatile("" : "+v"(lg), "+v"(lb));
        const f32x4_t* m = (const f32x4_t*)(modv + (size_t)(l * NMR + modrow(t)) * 6144) + lane;
        f32x4_t cx[4]; u32x2_t cy[4];
#pragma unroll
        for (int j = 0; j < 4; ++j) { cy[j] = ny[j];
            cx[j] = l == 0 ? nxf[j] : (f32x4_t){__uint_as_float(nxb[j][0] << 16), __uint_as_float(nxb[j][0] & 0xffff0000u), __uint_as_float(nxb[j][1] << 16), __uint_as_float(nxb[j][1] & 0xffff0000u)}; }
        LN1_LOAD(imin(t + tstep, M - 1))
        f32x4_t v[4]; float s = 0.f;
#pragma unroll
        for (int j = 0; j < 4; ++j) { const f32x4_t gv = m[2 * 256 + 64 * j];
            const f32x4_t yv = {__uint_as_float(cy[j][0] << 16), __uint_as_float(cy[j][0] & 0xffff0000u), __uint_as_float(cy[j][1] << 16), __uint_as_float(cy[j][1] & 0xffff0000u)};
            v[j] = cx[j] * ALPHA + gv * yv; s += (v[j][0] + v[j][1]) + (v[j][2] + v[j][3]); }
        const float mu = row_sum(s) * (1.f / D);
        float q = 0.f;
#pragma unroll
        for (int j = 0; j < 4; ++j) { v[j] = v[j] - mu; q += (v[j][0] * v[j][0] + v[j][1] * v[j][1]) + (v[j][2] * v[j][2] + v[j][3] * v[j][3]); }
        const float rstd = 1.f / sqrtf(row_sum(q) * (1.f / D) + LN_EPS);
        f32x4_t tk[4]; float am[4];
#pragma unroll
        for (int j = 0; j < 4; ++j) { v[j] = v[j] * rstd * lg[64 * j] + lb[64 * j];
            tk[j] = v[j] * (m[4 * 256 + 64 * j] + 1.f) + m[3 * 256 + 64 * j];
            am[j] = fmaxf(fmaxf(fabsf(tk[j][0]), fabsf(tk[j][1])), fmaxf(fabsf(tk[j][2]), fabsf(tk[j][3]))); }
        u32x2_t* xo = (u32x2_t*)(xs_o + (size_t)t * D) + lane; u32x2_t* ho = (u32x2_t*)(hb_o + (size_t)t * D) + lane;
#pragma unroll
        for (int j = 0; j < 4; ++j) { xo[64 * j] = (u32x2_t){pk_bf16(v[j][0], v[j][1]), pk_bf16(v[j][2], v[j][3])}; ho[64 * j] = (u32x2_t){pk_bf16(tk[j][0], tk[j][1]), pk_bf16(tk[j][2], tk[j][3])}; }
#pragma unroll
        for (int j = 0; j < 4; ++j) am[j] = wave_maxf(am[j]);
        unsigned short* qho = (unsigned short*)(hqh_o + (size_t)t * 512) + lane; unsigned short* qlo = (unsigned short*)(hql_o + (size_t)t * 512) + lane;
#pragma unroll
        for (int j = 0; j < 4; ++j) { const float qs = am[j] > 0.f ? 119.f / am[j] : 0.f; unsigned wh = 0u, wl = 0u;
#pragma unroll
            for (int kk = 0; kk < 4; ++kk) { const int qi = (int)rintf(tk[j][kk] * qs); wh |= ((unsigned)((qi + 8) >> 4) & 15u) << (4 * kk); wl |= ((unsigned)qi & 15u) << (4 * kk); }
            qho[64 * j] = (unsigned short)wh; qlo[64 * j] = (unsigned short)wl;
            if (lane == 0) hqs_o[(size_t)t * 4 + j] = am[j] * (1.f / 119.f); }
    }
}
#endif
#ifndef CPU_TEST
typedef int i32x4_t __attribute__((ext_vector_type(4)));
DEVFN void pk_dot16(f32x2_t& acc, const u32x4_t r, const f32x2_t (&h2)[8]) {
#pragma unroll
    for (int i = 0; i < 4; ++i) { const f32x2_t lo = __builtin_amdgcn_cvt_pk_f32_fp8((int)r[i], false), hi = __builtin_amdgcn_cvt_pk_f32_fp8((int)r[i], true);
        acc = __builtin_elementwise_fma(lo, h2[2 * i], acc); acc = __builtin_elementwise_fma(hi, h2[2 * i + 1], acc); }
}
DEVFN void pk_fma16(f32x2_t (&y2)[8], const u32x4_t r, const float w) {
    const f32x2_t w2 = {w, w};
#pragma unroll
    for (int i = 0; i < 4; ++i) { const f32x2_t lo = __builtin_amdgcn_cvt_pk_f32_fp8((int)r[i], false), hi = __builtin_amdgcn_cvt_pk_f32_fp8((int)r[i], true);
        y2[2 * i] = __builtin_elementwise_fma(lo, w2, y2[2 * i]); y2[2 * i + 1] = __builtin_elementwise_fma(hi, w2, y2[2 * i + 1]); }
}
struct PvItem { u32x4_t r[16]; f32x4_t w[4]; };
DEVFN void pv_idx(int (&e)[16], const int* idx, int t, int g) {
    const i32x4_t* ip = (const i32x4_t*)(idx + (size_t)t * 128 + g * 16);
#pragma unroll
    for (int i = 0; i < 4; ++i) { const i32x4_t v = ip[i]; e[4 * i] = v[0]; e[4 * i + 1] = v[1]; e[4 * i + 2] = v[2]; e[4 * i + 3] = v[3]; }
}
struct PuvItem { u32x4_t r[16]; u32x4_t h0, h1; float hs; };
DEVFN void puv_rows(PuvItem& it, const int (&e)[16], const unsigned char* UP, const unsigned lo16, const unsigned char* qh, const unsigned char* ql, const float* hs) {
#pragma unroll
    for (int j = 0; j < 16; ++j) it.r[j] = *(const u32x4_t*)(UP + (((unsigned)e[j] << 7) | lo16));
    it.h0 = *(const u32x4_t*)qh; it.h1 = *(const u32x4_t*)ql; it.hs = *hs;
}
DEVFN void puv_compute(const PuvItem& it, bf16_t* pout, int k) {
    int qh = 0, ql = 0;
#pragma unroll
    for (int i = 0; i < 4; ++i) { qh = __builtin_amdgcn_sdot8((int)it.h0[i], 0x11111111, qh, false); ql = __builtin_amdgcn_sdot8((int)it.h1[i], 0x11111111, ql, false); }
    const int qsum = qh * 16 + ql;
    int d[16];
#pragma unroll
    for (int j = 0; j < 16; ++j) { int ah = 0, al = 0;
#pragma unroll
        for (int i = 0; i < 4; ++i) { ah = __builtin_amdgcn_sdot8((int)it.r[j][i], (int)it.h0[i], ah, false); al = __builtin_amdgcn_sdot8((int)it.r[j][i], (int)it.h1[i], al, false); }
        d[j] = ah * 32 + al * 2 + qsum; }
    int d8[8];
#pragma unroll
    for (int i = 0; i < 8; ++i) { const bool up = (k & 4) != 0; const int keep = up ? d[8 + i] : d[i], send = up ? d[i] : d[8 + i]; d8[i] = keep + dpp_xor4(send); }
    int d4[4];
#pragma unroll
    for (int i = 0; i < 4; ++i) { const bool up = (k & 2) != 0; const int keep = up ? d8[4 + i] : d8[i], send = up ? d8[i] : d8[4 + i]; d4[i] = keep + dpp_xor2(send); }
    int d2[2];
#pragma unroll
    for (int i = 0; i < 2; ++i) { const bool up = (k & 1) != 0; const int keep = up ? d4[2 + i] : d4[i], send = up ? d4[i] : d4[2 + i]; d2[i] = keep + dpp_xor1(send); }
    *(unsigned*)(pout + ((k >> 2) & 1) * 8 + ((k >> 1) & 1) * 4 + (k & 1) * 2) = pk_bf16((float)d2[0] * it.hs, (float)d2[1] * it.hs);
}
DEVFN void ph_peer_u(const Params& p, int l, int M, int tid, int bid, int G) {
    const int lane = tid & 63, wv = __builtin_amdgcn_readfirstlane(tid >> 6), g = lane >> 3, k = lane & 7, x = bid & 3;
    const unsigned char* UP = WSP(const unsigned char, WS_UV8) + (size_t)(l * 2) * PEER_N * 1024 + (size_t)x * PEER_N * 128; const unsigned lo16 = (unsigned)k * 16u;
    const int* idx = WSP(const int, WS_IDX);
    const unsigned char* qh = WSP(const unsigned char, WS_HQH) + x * 128 + k * 16; const unsigned char* ql = WSP(const unsigned char, WS_HQL) + x * 128 + k * 16; const float* hs = WSP(const float, WS_HQS) + x;
    bf16_t* part = WSP(bf16_t, WS_PART) + (size_t)x * NT * 128 + g * 16;
    const int nw = (G >> 2) * 8, t0 = (bid >> 2) * 8 + wv, last = M - 1;
    int eA[16], eB[16]; PuvItem A, B;
    pv_idx(eA, idx, imin(t0, last), g); pv_idx(eB, idx, imin(t0 + nw, last), g);
    { const size_t tt = imin(t0, last); puv_rows(A, eA, UP, lo16, qh + tt * 512, ql + tt * 512, hs + tt * 4); }
    for (int t = t0; t < M; t += 2 * nw) {
        { const size_t tt = imin(t + nw, last); puv_rows(B, eB, UP, lo16, qh + tt * 512, ql + tt * 512, hs + tt * 4); }
        pv_idx(eA, idx, imin(t + 2 * nw, last), g);
        puv_compute(A, part + (size_t)t * 128, k);
        { const size_t tt = imin(t + 2 * nw, last); puv_rows(A, eA, UP, lo16, qh + tt * 512, ql + tt * 512, hs + tt * 4); }
        pv_idx(eB, idx, imin(t + 3 * nw, last), g);
        if (t + nw < M) puv_compute(B, part + (size_t)(t + nw) * 128, k);
    }
}
DEVFN void ph_peer_comb(const Params& p, int l, int M, size_t gtid, size_t gsize) {
    const int* idx = WSP(const int, WS_IDX); const float* gate = WSP(const float, WS_GATE); const bf16_t* part = WSP(const bf16_t, WS_PART);
    unsigned char* whi = WSP(unsigned char, WS_WA); float* wsc = (float*)(whi + (size_t)NT * 256);
    const f32x2_t* SUV = WSP(const f32x2_t, WS_UVS) + (size_t)l * PEER_N;
    for (size_t i4 = gtid; i4 < (size_t)M * 32; i4 += gsize) {
        const size_t i = i4 * 4;
        f32x4_t s = {0.f, 0.f, 0.f, 0.f};
#pragma unroll
        for (int x = 0; x < 4; ++x) { const u32x2_t w = *(const u32x2_t*)(part + (size_t)x * NT * 128 + i);
            s += (f32x4_t){__uint_as_float(w[0] << 16), __uint_as_float(w[0] & 0xffff0000u), __uint_as_float(w[1] << 16), __uint_as_float(w[1] & 0xffff0000u)}; }
        const i32x4_t e = *(const i32x4_t*)(idx + i); const f32x4_t g = *(const f32x4_t*)(gate + i);
        f32x4_t o;
#pragma unroll
        for (int k = 0; k < 4; ++k) { const f32x2_t sc = SUV[e[k]]; const float dot = s[k] * sc[0]; const float u3 = 1.5957691216057308f * (dot + 0.044715f * dot * dot * dot); o[k] = g[k] * sc[1] * dot / (1.f + __expf(-u3)); }
        float am = fmaxf(fmaxf(fabsf(o[0]), fabsf(o[1])), fmaxf(fabsf(o[2]), fabsf(o[3])));
        am = fmaxf(am, dppf(am, 0xB1)); am = fmaxf(am, dppf(am, 0x4E)); am = fmaxf(am, dppf(am, 0x141)); am = fmaxf(am, dppf(am, 0x140));
        { auto rr = __builtin_amdgcn_permlane16_swap(__float_as_uint(am), __float_as_uint(am), false, false); am = fmaxf(__uint_as_float(rr[0]), __uint_as_float(rr[1])); }
        const float ws = am > 0.f ? 6.f / am : 0.f;
        const size_t t = i >> 7; const int pos = (int)(i & 127), gq = pos >> 4, j0 = pos & 15, ge = gq & 1;
        float rr[4];
#pragma unroll
        for (int k = 0; k < 4; ++k) rr[k] = o[k] * ws;
#pragma unroll
        for (int d = 0; d < 3; ++d) {
            unsigned mine = 0u;
#pragma unroll
            for (int k = 0; k < 4; ++k) {
                const unsigned wd = __builtin_amdgcn_cvt_scalef32_pk_fp4_f32(0u, rr[k], 0.f, 1.0f, 0) & 0xffu;
                const f32x2_t dec = __builtin_amdgcn_cvt_scalef32_pk_f32_fp4(wd, 1.0f, 0);
                mine |= ((wd | (wd >> 4)) & 15u) << (4 * k);
                rr[k] = (rr[k] - (dec[0] + dec[1])) * 4.f; }
            const unsigned oth = (unsigned)dpp_xor4((int)mine);
            const unsigned lo4 = ge ? oth : mine, hi4 = ge ? mine : oth;
            unsigned W = 0u;
#pragma unroll
            for (int k = 0; k < 4; ++k) W |= (((lo4 >> (4 * k)) & 15u) | (((hi4 >> (4 * k)) & 15u) << 4)) << (8 * k);
            const int cc = gq >> 1;
            const unsigned o1 = (unsigned)dpp_xor8((int)W);
            W = __builtin_amdgcn_perm(o1, W, (cc & 1) ? 0x03070105u : 0x06020400u);
            unsigned o2; { auto rr = __builtin_amdgcn_permlane16_swap(W, W, false, false); o2 = (cc & 2) ? rr[0] : rr[1]; }
            W = __builtin_amdgcn_perm(o2, W, (cc & 2) ? 0x03020706u : 0x05040100u);
            if (ge == 0) *(unsigned*)(whi + ((size_t)d * NT + t) * 64 + 4 * (j0 + cc)) = W;
        }
        if ((i4 & 31) == 0) wsc[t] = am * (1.f / 6.f);
    }
}
typedef int i32x2_t __attribute__((ext_vector_type(2)));
typedef int i32x8_t __attribute__((ext_vector_type(8)));
struct PvRows { u32x4_t r[16]; i32x4_t w4; float ws; };
DEVFN void pv_rows(PvRows& it, const int (&e)[16], const unsigned char* VP, const unsigned lo16, const unsigned char* wbt, const float* wsp, const bool hasw) {
#pragma unroll
    for (int j = 0; j < 16; ++j) it.r[j] = *(const u32x4_t*)(VP + (((unsigned)e[j] << 7) | lo16));
    it.w4 = (i32x4_t){0, 0, 0, 0};
    if (hasw) it.w4 = *(const i32x4_t*)wbt;
    it.ws = *wsp;
}
DEVFN void pv_compute(const PvRows& it, LAS unsigned char* wrE, LAS unsigned char* wrO, LAS unsigned char* rowbase, const int fsh, bf16_t* yo, const bool st) {
    asm volatile("" ::: "memory");
#pragma unroll
    for (int j = 0; j < 16; ++j) *(LAS u32x4_t*)(((j & 1) ? wrO : wrE) + j * 1024) = it.r[j];
    asm volatile("" ::: "memory");
    const i32x8_t wf = {it.w4[0], it.w4[1], it.w4[2], it.w4[3], 0, 0, 0, 0};
    const float c0 = it.ws, c1 = it.ws * 0.25f, c2 = it.ws * 0.0625f;
    unsigned res[16];
#pragma unroll
    for (int hg = 0; hg < 2; ++hg) {
        i32x2_t ta0[8], ta1[8];
#pragma unroll
        for (int cc = 0; cc < 8; ++cc) { const int c = 8 * hg + cc, off = (((c >> 1) << 4) ^ fsh) + 8 * (c & 1);
            ta0[cc] = __builtin_amdgcn_ds_read_tr4_b64_v2i32((LAS i32x2_t*)(rowbase + off)); ta1[cc] = __builtin_amdgcn_ds_read_tr4_b64_v2i32((LAS i32x2_t*)(rowbase + 2048 + off)); }
        __builtin_amdgcn_sched_barrier(0);
        f32x4_t acc[8];
#pragma unroll
        for (int cc = 0; cc < 8; ++cc) { const i32x8_t tf = {ta0[cc][0], ta0[cc][1], ta1[cc][0], ta1[cc][1], 0, 0, 0, 0};
            acc[cc] = (f32x4_t){0.f, 0.f, 0.f, 0.f};
            acc[cc] = __builtin_amdgcn_mfma_scale_f32_16x16x128_f8f6f4(wf, tf, acc[cc], 4, 4, 0, 0, 0, 0); }
        __builtin_amdgcn_sched_barrier(0);
#pragma unroll
        for (int cc = 0; cc < 8; ++cc) {
            const float y = acc[cc][0] * c0 + acc[cc][1] * c1 + acc[cc][2] * c2;
            const float yn = __int_as_float(__builtin_amdgcn_mov_dpp(__float_as_int(y), 0xB1, 0xf, 0xf, true));
            res[8 * hg + cc] = pk_bf16(y, yn); }
    }
    if (st) {
#pragma unroll
        for (int c = 0; c < 16; ++c) *(unsigned*)(yo + c * 16) = res[c]; }
    asm volatile("" ::: "memory");
}
DEVFN void ph_peer_v(const Params& p, LAS unsigned char* lds, int l, int M, int tid, int bid, int G) {
    const int lane = tid & 63, wv = __builtin_amdgcn_readfirstlane(tid >> 6), g = lane >> 3, sl = lane & 7, x = bid & 3, n = lane & 15, q = lane >> 4;
    LAS unsigned char* img = lds + wv * 16384;
    const unsigned char* VPl = WSP(const unsigned char, WS_UV8) + (size_t)(l * 2 + 1) * PEER_N * 1024 + (size_t)x * PEER_N * 128; const unsigned lo16 = (unsigned)sl * 16u;
    const int* idx = WSP(const int, WS_IDX);
    const unsigned char* wb = WSP(const unsigned char, WS_WA) + (size_t)(n & 3) * NT * 64 + 16 * q; const float* wsc = (const float*)(WSP(const unsigned char, WS_WA) + (size_t)NT * 256);
    const bool hasw = n < 3, st = q == 0 && (n & 1) == 0;
    bf16_t* Y = WSP(bf16_t, WS_Y) + x * 256 + n;
    LAS unsigned char* wrE = img + g * 128 + ((sl ^ (g >> 1)) << 4); LAS unsigned char* wrO = img + g * 128 + (((sl ^ (g >> 1)) << 4) ^ 64);
    const int R0 = 32 * q + n, fsh = ((R0 >> 1) & 7) << 4;
    LAS unsigned char* rowbase = img + R0 * 128;
    const int nw = (G >> 2) * 8, t0 = (bid >> 2) * 8 + wv, last = M - 1;
    int eA[16], eB[16]; PvRows A, B;
    pv_idx(eA, idx, imin(t0, last), g); pv_idx(eB, idx, imin(t0 + nw, last), g);
    { const size_t tt = imin(t0, last); pv_rows(A, eA, VPl, lo16, wb + tt * 64, wsc + tt, hasw); }
    for (int t = t0; t < M; t += 2 * nw) {
        { const size_t tt = imin(t + nw, last); pv_rows(B, eB, VPl, lo16, wb + tt * 64, wsc + tt, hasw); }
        pv_idx(eA, idx, imin(t + 2 * nw, last), g);
        pv_compute(A, wrE, wrO, rowbase, fsh, Y + (size_t)t * D, st);
        { const size_t tt = imin(t + 2 * nw, last); pv_rows(A, eA, VPl, lo16, wb + tt * 64, wsc + tt, hasw); }
        pv_idx(eB, idx, imin(t + 3 * nw, last), g);
        if (t + nw < M) pv_compute(B, wrE, wrO, rowbase, fsh, Y + (size_t)(t + nw) * D, st);
    }
}
DEVFN void ph_ln2_gpu(const Params& p, int l, int M, int tid, int bid, int G, int dry = 0) {
    bf16_t* xs = WSP(bf16_t, WS_XS); const bf16_t* Yb = WSP(const bf16_t, WS_Y); const float* modv = WSP(const float, WS_MODV); bf16_t* hb = WSP(bf16_t, WS_HB);
    const int lane = tid & 63, wv = __builtin_amdgcn_readfirstlane(tid >> 6);
    bf16_t* xs_o = dry ? WSP(bf16_t, WS_Z + (size_t)NT * 2048) : xs; bf16_t* hb_o = dry ? WSP(bf16_t, WS_Z + (size_t)NT * 4096) : hb; float* out_o = dry ? WSP(float, WS_Z) : p.out;
    const f32x4_t* lg0 = (const f32x4_t*)(p.ln_g + (size_t)(l * 2 + 1) * D) + lane; const f32x4_t* lb0 = (const f32x4_t*)(p.ln_b + (size_t)(l * 2 + 1) * D) + lane;
    const int t0 = wv * G + bid, tstep = G * 8;
    u32x2_t nx[4], ny[4];
    { const int tt = imin(t0, M - 1); const u32x2_t* xp = (const u32x2_t*)(xs + (size_t)tt * D) + lane; const u32x2_t* yp = (const u32x2_t*)(Yb + (size_t)tt * D) + lane;
#pragma unroll
      for (int j = 0; j < 4; ++j) { nx[j] = xp[64 * j]; ny[j] = yp[64 * j]; } }
    for (int t = t0; t < M; t += tstep) {
        const f32x4_t* lg = lg0; const f32x4_t* lb = lb0; asm volatile("" : "+v"(lg), "+v"(lb));
        const int mr = modrow(t);
        const f32x4_t* m = (const f32x4_t*)(modv + (size_t)(l * NMR + mr) * 6144) + lane;
        f32x4_t cx[4]; u32x2_t cy[4];
#pragma unroll
        for (int j = 0; j < 4; ++j) { cy[j] = ny[j]; cx[j] = (f32x4_t){__uint_as_float(nx[j][0] << 16), __uint_as_float(nx[j][0] & 0xffff0000u), __uint_as_float(nx[j][1] << 16), __uint_as_float(nx[j][1] & 0xffff0000u)}; }
        { const int tt = imin(t + tstep, M - 1); const u32x2_t* xp = (const u32x2_t*)(xs + (size_t)tt * D) + lane; const u32x2_t* yp = (const u32x2_t*)(Yb + (size_t)tt * D) + lane;
#pragma unroll
          for (int j = 0; j < 4; ++j) { nx[j] = xp[64 * j]; ny[j] = yp[64 * j]; } }
        f32x4_t v[4]; float s = 0.f;
#pragma unroll
        for (int j = 0; j < 4; ++j) { const f32x4_t gv = m[5 * 256 + 64 * j];
            const f32x4_t yv = {__uint_as_float(cy[j][0] << 16), __uint_as_float(cy[j][0] & 0xffff0000u), __uint_as_float(cy[j][1] << 16), __uint_as_float(cy[j][1] & 0xffff0000u)};
            v[j] = cx[j] * ALPHA + gv * yv; s += (v[j][0] + v[j][1]) + (v[j][2] + v[j][3]); }
        const float mu = row_sum(s) * (1.f / D);
        float q = 0.f;
#pragma unroll
        for (int j = 0; j < 4; ++j) { v[j] = v[j] - mu; q += (v[j][0] * v[j][0] + v[j][1] * v[j][1]) + (v[j][2] * v[j][2] + v[j][3] * v[j][3]); }
        const float rstd = 1.f / sqrtf(row_sum(q) * (1.f / D) + LN_EPS);
#pragma unroll
        for (int j = 0; j < 4; ++j) v[j] = v[j] * rstd * lg[64 * j] + lb[64 * j];
        if (l + 1 < DEPTH) {
            const f32x4_t* m2 = (const f32x4_t*)(modv + (size_t)((l + 1) * NMR + mr) * 6144) + lane;
            u32x2_t* xo = (u32x2_t*)(xs_o + (size_t)t * D) + lane; u32x2_t* ho = (u32x2_t*)(hb_o + (size_t)t * D) + lane;
#pragma unroll
            for (int j = 0; j < 4; ++j) { xo[64 * j] = (u32x2_t){pk_bf16(v[j][0], v[j][1]), pk_bf16(v[j][2], v[j][3])}; const f32x4_t hv = v[j] * (m2[256 + 64 * j] + 1.f) + m2[64 * j]; ho[64 * j] = (u32x2_t){pk_bf16(hv[0], hv[1]), pk_bf16(hv[2], hv[3])}; }
        } else if (t < NX) {
            f32x4_t* op = (f32x4_t*)(out_o + (size_t)t * D) + lane;
#pragma unroll
            for (int j = 0; j < 4; ++j) op[64 * j] = v[j];
        }
    }
}
#endif

#ifndef CPU_TEST
struct PuItem { u32x4_t a[8][2]; u32x4_t hw[4]; };
DEVFN void pu_idx(int (&e)[8], const int* idx, int t, int r16) {
    const i32x4_t* ip = (const i32x4_t*)(idx + (size_t)t * 128 + r16 * 8); const i32x4_t v0 = ip[0], v1 = ip[1];
    e[0] = v0[0]; e[1] = v0[1]; e[2] = v0[2]; e[3] = v0[3]; e[4] = v1[0]; e[5] = v1[1]; e[6] = v1[2]; e[7] = v1[3];
}
DEVFN void pu_rows(PuItem& it, const int (&e)[8], const unsigned char* UP, const bf16_t* hrow) {
#pragma unroll
    for (int ti = 0; ti < 8; ++ti) { const u32x4_t* rp = (const u32x4_t*)(UP + (size_t)e[ti] * 128); it.a[ti][0] = rp[0]; it.a[ti][1] = rp[1]; }
#pragma unroll
    for (int q = 0; q < 4; ++q) it.hw[q] = ((const u32x4_t*)hrow)[q];
}
DEVFN void pu_compute(const PuItem& it, float* pout, int r16, int kg) {
    unsigned bh[8], bl[8];
#pragma unroll
    for (int q = 0; q < 4; ++q) { const u32x4_t hw = it.hw[q];
#pragma unroll
        for (int i = 0; i < 2; ++i) {
            const float f0 = __uint_as_float(hw[2 * i] << 16), f1 = __uint_as_float(hw[2 * i] & 0xffff0000u), f2 = __uint_as_float(hw[2 * i + 1] << 16), f3 = __uint_as_float(hw[2 * i + 1] & 0xffff0000u);
            int wh = __builtin_amdgcn_cvt_pk_fp8_f32(f0, f1, 0, false); wh = __builtin_amdgcn_cvt_pk_fp8_f32(f2, f3, wh, true);
            const f32x2_t d01 = __builtin_amdgcn_cvt_pk_f32_fp8(wh, false), d23 = __builtin_amdgcn_cvt_pk_f32_fp8(wh, true);
            int wl = __builtin_amdgcn_cvt_pk_fp8_f32((f0 - d01[0]) * 16.f, (f1 - d01[1]) * 16.f, 0, false); wl = __builtin_amdgcn_cvt_pk_fp8_f32((f2 - d23[0]) * 16.f, (f3 - d23[1]) * 16.f, wl, true);
            bh[2 * q + i] = (unsigned)wh; bl[2 * q + i] = (unsigned)wl; } }
    f32x4_t dh[8], dl[8];
#pragma unroll
    for (int ti = 0; ti < 8; ++ti) {
        dh[ti] = (f32x4_t){0.f, 0.f, 0.f, 0.f}; dl[ti] = dh[ti];
#pragma unroll
        for (int s_ = 0; s_ < 4; ++s_) {
            const long av = (long)(((unsigned long long)it.a[ti][s_ >> 1][2 * (s_ & 1) + 1] << 32) | it.a[ti][s_ >> 1][2 * (s_ & 1)]);
            const long bhv = (long)(((unsigned long long)bh[2 * s_ + 1] << 32) | bh[2 * s_]), blv = (long)(((unsigned long long)bl[2 * s_ + 1] << 32) | bl[2 * s_]);
            dh[ti] = __builtin_amdgcn_mfma_f32_16x16x32_fp8_fp8(av, bhv, dh[ti], 0, 0, 0);
            dl[ti] = __builtin_amdgcn_mfma_f32_16x16x32_fp8_fp8(av, blv, dl[ti], 0, 0, 0);
        }
    }
    f32x4_t o = dh[0] + dl[0] * 0.0625f;
#pragma unroll
    for (int c = 1; c < 8; ++c) { const f32x4_t v = dh[c] + dl[c] * 0.0625f; o = (r16 == c) ? v : o; }
    if (r16 < 8) *(f32x4_t*)(pout + r16 * 16 + 4 * kg) = o;
}
DEVFN void ph_peer_u_mfma(const Params& p, int l, int M, int tid, int bid, int G) {
    const int lane = tid & 63, wv = __builtin_amdgcn_readfirstlane(tid >> 6), r16 = lane & 15, kg = lane >> 4, x = bid & 7;
    const unsigned char* UP = WSP(const unsigned char, WS_UV8) + (size_t)(l * 2) * PEER_N * 1024 + (size_t)x * PEER_N * 128 + kg * 32;
    const int* idx = WSP(const int, WS_IDX); const bf16_t* hb = WSP(const bf16_t, WS_HB) + x * 128 + kg * 32;
    float* part = WSP(float, WS_PART) + (size_t)x * NT * 128;
    const int nw = (G >> 3) * 8, t0 = (bid >> 3) * 8 + wv, last = M - 1;
    int eA[8], eB[8]; PuItem A, B;
    pu_idx(eA, idx, imin(t0, last), r16); pu_idx(eB, idx, imin(t0 + nw, last), r16);
    pu_rows(A, eA, UP, hb + (size_t)imin(t0, last) * D);
    for (int t = t0; t < M; t += 2 * nw) {
        pu_rows(B, eB, UP, hb + (size_t)imin(t + nw, last) * D);
        pu_idx(eA, idx, imin(t + 2 * nw, last), r16);
        pu_compute(A, part + (size_t)t * 128, r16, kg);
        pu_rows(A, eA, UP, hb + (size_t)imin(t + 2 * nw, last) * D);
        pu_idx(eB, idx, imin(t + 3 * nw, last), r16);
        if (t + nw < M) pu_compute(B, part + (size_t)(t + nw) * 128, r16, kg);
    }
}
#endif
#ifndef CPU_TEST
constexpr int AC_BUF = 18432, AC_V = 9216, AC_SCR = 2 * AC_BUF, AC_BYTES = AC_SCR + 8 * 4608;
template <bool MASKED, class F>
DEVFN void attc_sub(AttW& a, const bf16x8_t (&qf)[4], const LAS unsigned char* kb, const LAS unsigned char* vb, int sub, int lane, float c2, F bias2) {
    const int q31 = lane & 31, hi = lane >> 5;
    bf16x8_t vf[2][2];
#pragma unroll
    for (int db = 0; db < 2; ++db) {
        const int swz = (4 * db + (q31 >> 3)) & 7, g0 = 8 * sub + hi;
        const LAS unsigned char* vr = vb + (32 * db + q31) * 144;
        const s16x4v a0 = *(const LAS s16x4v*)(vr + ((g0 ^ swz) << 3)), a1 = *(const LAS s16x4v*)(vr + (((g0 + 2) ^ swz) << 3)), b0 = *(const LAS s16x4v*)(vr + (((g0 + 4) ^ swz) << 3)), b1 = *(const LAS s16x4v*)(vr + (((g0 + 6) ^ swz) << 3));
        vf[db][0] = (bf16x8_t){a0[0], a0[1], a0[2], a0[3], a1[0], a1[1], a1[2], a1[3]}; vf[db][1] = (bf16x8_t){b0[0], b0[1], b0[2], b0[3], b1[0], b1[1], b1[2], b1[3]};
    }
    f32x16_t s = {};
#pragma unroll
    for (int ks = 0; ks < 4; ++ks) { const bf16x8_t kf = *(const LAS bf16x8_t*)(kb + (32 * sub + q31) * 144 + ks * 32 + hi * 16); s = __builtin_amdgcn_mfma_f32_32x32x16_bf16(kf, qf[ks], s, 0, 0, 0); }
    float mx = -1e30f;
#pragma unroll
    for (int r = 0; r < 16; ++r) { s[r] = MASKED ? s[r] * c2 + bias2(r) : s[r] * c2; mx = fmaxf(mx, s[r]); }
    { auto rr_ = __builtin_amdgcn_permlane32_swap(__float_as_uint(mx), __float_as_uint(mx), false, false); mx = fmaxf(__uint_as_float(rr_[0]), __uint_as_float(rr_[1])); }
    const float mnew = fmaxf(a.m, mx);
    if (!__all(mnew == a.m)) {
        const float alpha = __builtin_amdgcn_exp2f(a.m - mnew); a.m = mnew; a.l *= alpha;
#pragma unroll
        for (int r = 0; r < 16; ++r) { a.o0[r] *= alpha; a.o1[r] *= alpha; }
    }
    float ps = 0.f;
#pragma unroll
    for (int r = 0; r < 16; ++r) { s[r] = __builtin_amdgcn_exp2f(s[r] - mnew); ps += s[r]; }
    a.l += ps;
    const u32x4_t pw0 = (u32x4_t){pk_bf16(s[0], s[1]), pk_bf16(s[2], s[3]), pk_bf16(s[4], s[5]), pk_bf16(s[6], s[7])};
    const u32x4_t pw1 = (u32x4_t){pk_bf16(s[8], s[9]), pk_bf16(s[10], s[11]), pk_bf16(s[12], s[13]), pk_bf16(s[14], s[15])};
    const bf16x8_t pb0 = __builtin_bit_cast(bf16x8_t, pw0), pb1 = __builtin_bit_cast(bf16x8_t, pw1);
    a.o0 = __builtin_amdgcn_mfma_f32_32x32x16_bf16(vf[0][0], pb0, a.o0, 0, 0, 0); a.o1 = __builtin_amdgcn_mfma_f32_32x32x16_bf16(vf[1][0], pb0, a.o1, 0, 0, 0);
    a.o0 = __builtin_amdgcn_mfma_f32_32x32x16_bf16(vf[0][1], pb1, a.o0, 0, 0, 0); a.o1 = __builtin_amdgcn_mfma_f32_32x32x16_bf16(vf[1][1], pb1, a.o1, 0, 0, 0);
}
template <bool MASKED, class F>
DEVFN void attc_win(AttW& a, const bf16x8_t (&qf)[4], const LAS unsigned char* kb, const LAS unsigned char* vb, int k0, int lane, float c2, F bias2) {
    const int q31 = lane & 31, hi = lane >> 5;
    float bias[16];
#pragma unroll
    for (int r = 0; r < 16; ++r) bias[r] = MASKED ? bias2(r) : 0.f;
    bf16x8_t vf[2][2];
#pragma unroll
    for (int db = 0; db < 2; ++db) {
        const int swz = (4 * db + (q31 >> 3)) & 7, g0 = (k0 >> 2) + hi;
        const LAS unsigned char* vr = vb + (32 * db + q31) * 144;
        const s16x4v a0 = *(const LAS s16x4v*)(vr + ((g0 ^ swz) << 3)), a1 = *(const LAS s16x4v*)(vr + (((g0 + 2) ^ swz) << 3)), b0 = *(const LAS s16x4v*)(vr + (((g0 + 4) ^ swz) << 3)), b1 = *(const LAS s16x4v*)(vr + (((g0 + 6) ^ swz) << 3));
        vf[db][0] = (bf16x8_t){a0[0], a0[1], a0[2], a0[3], a1[0], a1[1], a1[2], a1[3]}; vf[db][1] = (bf16x8_t){b0[0], b0[1], b0[2], b0[3], b1[0], b1[1], b1[2], b1[3]};
    }
    f32x16_t s = {};
#pragma unroll
    for (int ks = 0; ks < 4; ++ks) { const bf16x8_t kf = *(const LAS bf16x8_t*)(kb + (k0 + q31) * 144 + ks * 32 + hi * 16); s = __builtin_amdgcn_mfma_f32_32x32x16_bf16(kf, qf[ks], s, 0, 0, 0); }
    float mx = -1e30f;
#pragma unroll
    for (int r = 0; r < 16; ++r) { s[r] = MASKED ? s[r] * c2 + bias[r] : s[r] * c2; mx = fmaxf(mx, s[r]); }
    { auto rr_ = __builtin_amdgcn_permlane32_swap(__float_as_uint(mx), __float_as_uint(mx), false, false); mx = fmaxf(__uint_as_float(rr_[0]), __uint_as_float(rr_[1])); }
    const float mnew = fmaxf(a.m, mx);
    if (!__all(mnew == a.m)) {
        const float alpha = __builtin_amdgcn_exp2f(a.m - mnew); a.m = mnew; a.l *= alpha;
#pragma unroll
        for (int r = 0; r < 16; ++r) { a.o0[r] *= alpha; a.o1[r] *= alpha; }
    }
    float ps = 0.f;
#pragma unroll
    for (int r = 0; r < 16; ++r) { s[r] = __builtin_amdgcn_exp2f(s[r] - mnew); ps += s[r]; }
    a.l += ps;
    const u32x4_t pw0 = (u32x4_t){pk_bf16(s[0], s[1]), pk_bf16(s[2], s[3]), pk_bf16(s[4], s[5]), pk_bf16(s[6], s[7])};
    const u32x4_t pw1 = (u32x4_t){pk_bf16(s[8], s[9]), pk_bf16(s[10], s[11]), pk_bf16(s[12], s[13]), pk_bf16(s[14], s[15])};
    const bf16x8_t pb0 = __builtin_bit_cast(bf16x8_t, pw0), pb1 = __builtin_bit_cast(bf16x8_t, pw1);
    a.o0 = __builtin_amdgcn_mfma_f32_32x32x16_bf16(vf[0][0], pb0, a.o0, 0, 0, 0); a.o1 = __builtin_amdgcn_mfma_f32_32x32x16_bf16(vf[1][0], pb0, a.o1, 0, 0, 0);
    a.o0 = __builtin_amdgcn_mfma_f32_32x32x16_bf16(vf[0][1], pb1, a.o0, 0, 0, 0); a.o1 = __builtin_amdgcn_mfma_f32_32x32x16_bf16(vf[1][1], pb1, a.o1, 0, 0, 0);
}
DEVFN void attc_stage(LAS unsigned char* buf, const u32x4_t kreg, const u32x4_t vreg, int tid) {
    const int key = tid >> 3, piece = tid & 7;
    *(LAS u32x4_t*)(buf + key * 144 + piece * 16) = kreg;
    const int ko = (((key >> 2) ^ piece) << 3) + (key & 3) * 2;
#pragma unroll
    for (int e = 0; e < 4; ++e) { *(LAS bf16_t*)(buf + AC_V + (piece * 8 + 2 * e) * 144 + ko) = (bf16_t)(vreg[e] & 0xffffu); *(LAS bf16_t*)(buf + AC_V + (piece * 8 + 2 * e + 1) * 144 + ko) = (bf16_t)(vreg[e] >> 16); }
}
DEVFN void ph_swa_attn_wg(const Params& p, LAS unsigned char* lds, int tid, int bid, int G) {
    const bf16_t* Z = WSP(const bf16_t, WS_Z); bf16_t* att = WSP(bf16_t, WS_ATT); constexpr int LDZ = 1536;
    const int lane = tid & 63, wv = __builtin_amdgcn_readfirstlane(tid >> 6), q31 = lane & 31, hi = lane >> 5, key = tid >> 3, piece = tid & 7;
    constexpr int XB = SEQ / 64, CB = CL / 64, CT = CL / 64, NIT = NBAT * 4 * (XB + CB);
    const float c2 = 0.125f * LOG2E;
    for (int it = bid; it < NIT; it += G) {
        constexpr int NXI = NBAT * 4 * XB;
        const int jx = it < NXI ? it : it - NXI;
        const int ux = jx & 255, kx = jx >> 8, jw = ux >> 3, px = (ux & 7) * 4 + (jw >> 3);
        const int qb = it < NXI ? (jw & 7) + 8 * kx : XB + jx % CB, kvh = (it < NXI ? px : jx / CB) & 3, b = it < NXI ? px >> 2 : jx / (CB * 4);
        const bool isx = qb < XB; const int q0 = isx ? qb * 64 : (qb - XB) * 64;
        const int hq = kvh * 4 + (wv & 3), qa = q0 + 32 * (wv >> 2);
        const size_t qtok0 = (isx ? (size_t)b * SEQ : (size_t)NX + b * CL) + qa;
        bf16x8_t qf[4]; attw_qload(qf, Z + (qtok0 + q31) * LDZ + hq * 64 + 8 * hi);
        AttW a; a.o0 = (f32x16_t){}; a.o1 = (f32x16_t){}; a.m = -1e30f; a.l = 0.f;
        const int lo = isx ? imax(0, q0 - 128) : 0, hiK = isx ? imin(SEQ - 64, q0 + 128) : -64;
        const int ntile = CT + (isx ? (hiK - lo) / 64 + 1 : 0);
        const size_t koff = 1024 + kvh * 64 + piece * 8, voff = 1280 + kvh * 64 + piece * 8;
        auto tile_tok = [&](int ti) -> size_t { return ti < CT ? (size_t)NX + b * CL + ti * 64 + key : (size_t)b * SEQ + lo + (ti - CT) * 64 + key; };
        u32x4_t kr, vr, kr2, vr2;
        { const size_t tk = tile_tok(0); kr = *(const u32x4_t*)(Z + tk * LDZ + koff); vr = *(const u32x4_t*)(Z + tk * LDZ + voff); }
        attc_stage(lds, kr, vr, tid);
        { const size_t tk = tile_tok(imin(1, ntile - 1)); kr = *(const u32x4_t*)(Z + tk * LDZ + koff); vr = *(const u32x4_t*)(Z + tk * LDZ + voff); }
        __syncthreads();
#pragma unroll 1
        for (int ti = 0; ti < ntile; ++ti) {
            const bool more = ti + 1 < ntile;
            { const size_t tk = tile_tok(imin(ti + 2, ntile - 1)); kr2 = *(const u32x4_t*)(Z + tk * LDZ + koff); vr2 = *(const u32x4_t*)(Z + tk * LDZ + voff); }
            const LAS unsigned char* kb = lds + (ti & 1) * AC_BUF; const LAS unsigned char* vb = kb + AC_V;
            if (ti < CT) {
                attc_sub<false>(a, qf, kb, vb, 0, lane, c2, [](int) { return 0.f; });
                attc_sub<false>(a, qf, kb, vb, 1, lane, c2, [](int) { return 0.f; });
            } else {
#pragma unroll
                for (int sub = 0; sub < 2; ++sub) {
                    const int ks = lo + (ti - CT) * 64 + 32 * sub;
                    if (ks + 31 >= qa - 128 && ks <= qa + 31 + 128) {
                        const int dk = ks - qa - q31 + 4 * hi;
                        if (ks + 31 - qa <= 128 && qa + 31 - ks <= 128) attc_sub<false>(a, qf, kb, vb, sub, lane, c2, [](int) { return 0.f; });
                        else attc_sub<true>(a, qf, kb, vb, sub, lane, c2, [dk](int r) { const int dd = dk + (r & 3) + 8 * (r >> 2); return (dd > 128 || dd < -128) ? -1e30f : 0.f; });
                    }
                }
            }
            if (more) attc_stage(lds + ((ti + 1) & 1) * AC_BUF, kr, vr, tid);
            kr = kr2; vr = vr2;
            __syncthreads();
        }
        const float sk2 = p.swa_sink[hq] * LOG2E, mf = fmaxf(a.m, sk2), al = __builtin_amdgcn_exp2f(a.m - mf);
        const float lt = (a.l + __shfl_xor(a.l, 32)) * al + __builtin_amdgcn_exp2f(sk2 - mf);
        attw_store(a, al / lt, lds + AC_SCR + wv * 4608, lane, att + qtok0 * D + hq * 64, D);
    }
}
DEVFN void ph_na_attn_wg(const Params& p, LAS unsigned char* lds, int tid, int bid, int G) {
    const bf16_t* Z = WSP(const bf16_t, WS_Z); bf16_t* att = WSP(bf16_t, WS_ATT); constexpr int LDZ = 3072;
    const int lane = tid & 63, wv = __builtin_amdgcn_readfirstlane(tid >> 6), q31 = lane & 31, hi = lane >> 5, key = tid >> 3, piece = tid & 7;
    constexpr int XG = NROWS / 4, CG = CL / 256, CT = CL / 64, NIT = NBAT * 16 * (XG + CG);
    const float c2 = 0.125f * LOG2E;
    for (int it = bid; it < NIT; it += G) {
        constexpr int NXI = NBAT * 16 * XG;
        const int jx = it < NXI ? it : it - NXI;
        const int ux = jx & 255, kx = jx >> 8;
        const int qg = it < NXI ? (ux & 1) + 2 * kx : XG + jx % CG, hq = (it < NXI ? (ux >> 1) : jx / CG) & 15, b = it < NXI ? ux >> 5 : jx / (CG * 16);
        const bool isx = qg < XG;
        const int jb = wv & 3, rw = isx ? qg * 4 + 2 * (wv >> 2) : 0;
        const int r = rw + (q31 >> 4), c = 16 * jb + (q31 & 15);
        const size_t qtok = isx ? (size_t)b * SEQ + r * GW + c : (size_t)NX + b * CL + (qg - XG) * 256 + wv * 32 + q31;
        const size_t otok0 = isx ? (size_t)b * SEQ + rw * GW + 16 * jb : (size_t)NX + b * CL + (qg - XG) * 256 + wv * 32;
        bf16x8_t qf[4]; attw_qload(qf, Z + qtok * LDZ + hq * 64 + 8 * hi);
        AttW a; a.o0 = (f32x16_t){}; a.o1 = (f32x16_t){}; a.m = -1e30f; a.l = 0.f;
        const int rstart = iclamp(r - 4, 0, NROWS - 8), cstart = iclamp(c - 8, 0, GW - 16);
        const int wlo = iclamp(rw - 4, 0, NROWS - 8), whi = iclamp(rw + 1 - 4, 0, NROWS - 8) + 7;
        const int rmin = iclamp(qg * 4 - 4, 0, NROWS - 8), rmax = iclamp(qg * 4 + 3 - 4, 0, NROWS - 8) + 7;
        const int ntile = CT + (isx ? rmax - rmin + 1 : 0);
        const int k0 = iclamp(16 * jb - 8, 0, 32);
        const size_t koff = 1024 + hq * 64 + piece * 8, voff = 2048 + hq * 64 + piece * 8;
        auto tile_tok = [&](int ti) -> size_t { return ti < CT ? (size_t)NX + b * CL + ti * 64 + key : (size_t)b * SEQ + (rmin + ti - CT) * GW + key; };
        LAS float* rpl = (LAS float*)(lds + AC_BYTES);
        if (tid < 15 * 31) rpl[tid] = p.na_rpb[(size_t)hq * 15 * 31 + tid] * LOG2E;
        u32x4_t kr, vr, kr2, vr2;
        { const size_t tk = tile_tok(0); kr = *(const u32x4_t*)(Z + tk * LDZ + koff); vr = *(const u32x4_t*)(Z + tk * LDZ + voff); }
        attc_stage(lds, kr, vr, tid);
        { const size_t tk = tile_tok(imin(1, ntile - 1)); kr = *(const u32x4_t*)(Z + tk * LDZ + koff); vr = *(const u32x4_t*)(Z + tk * LDZ + voff); }
        __syncthreads();
#pragma unroll 1
        for (int ti = 0; ti < ntile; ++ti) {
            const bool more = ti + 1 < ntile;
            { const size_t tk = tile_tok(imin(ti + 2, ntile - 1)); kr2 = *(const u32x4_t*)(Z + tk * LDZ + koff); vr2 = *(const u32x4_t*)(Z + tk * LDZ + voff); }
            const LAS unsigned char* kb = lds + (ti & 1) * AC_BUF; const LAS unsigned char* vb = kb + AC_V;
            if (ti < CT) {
                attc_win<false>(a, qf, kb, vb, 0, lane, c2, [](int) { return 0.f; });
                attc_win<false>(a, qf, kb, vb, 32, lane, c2, [](int) { return 0.f; });
            } else {
                const int kr_ = rmin + ti - CT;
                if (kr_ >= wlo && kr_ <= whi) {
                    const bool rowok = kr_ >= rstart && kr_ < rstart + 8;
                    const LAS float* rp = rpl + iclamp(kr_ - r + 7, 0, 14) * 31 + 15 - c;
                    const int kc0 = k0 + 4 * hi;
                    attc_win<true>(a, qf, kb, vb, k0, lane, c2, [=](int rr) { const int kc = kc0 + (rr & 3) + 8 * (rr >> 2); const bool ok = rowok && kc >= cstart && kc < cstart + 16;
                        return ok ? rp[ok ? kc : c] : -1e30f; });
                }
            }
            if (more) attc_stage(lds + ((ti + 1) & 1) * AC_BUF, kr, vr, tid);
            kr = kr2; vr = vr2;
            __syncthreads();
        }
        const float lt = a.l + __shfl_xor(a.l, 32);
        attw_store(a, 1.f / lt, lds + AC_SCR + wv * 4608, lane, att + otok0 * D + hq * 64, D, isx ? GW - 16 : 0);
    }
}
#endif
#ifndef CPU_TEST
constexpr int G2_QS = 0, G2_KS = 8704, G2_KE = 17408, G2_VT = 27648, G2_D = 37888, G2_BUF = 38400;
struct HgRaw { unsigned short q[8], f[8], v[8]; };
DEVFN void hg_load(HgRaw& r, const bf16_t* Z, size_t row0, int step, int foff, int col) {
#pragma unroll
    for (int i = 0; i < 8; ++i) { const bf16_t* zr = Z + (size_t)((long)row0 + (long)i * step) * 5120 + col; r.q[i] = zr[0]; r.v[i] = zr[1024]; r.f[i] = zr[foff]; }
}
DEVFN void hg_prep(const HgRaw& r, LAS unsigned char* buf, int k, int tg, int lane) {
    float lf[8], cum[8]; float run = 0.f;
#pragma unroll
    for (int i = 0; i < 8; ++i) { lf[i] = (float)__builtin_bit_cast(_Float16, r.f[i]); run += lf[i]; cum[i] = run; }
    float p1, q2;
    { auto rr = __builtin_amdgcn_permlane16_swap(__float_as_uint(run), __float_as_uint(run), false, false); p1 = __uint_as_float((tg & 1) ? rr[0] : rr[1]); }
    const float ps = run + p1;
    { auto rr = __builtin_amdgcn_permlane32_swap(__float_as_uint(ps), __float_as_uint(ps), false, false); q2 = __uint_as_float((tg & 2) ? rr[0] : rr[1]); }
    const float off = ((tg & 1) ? p1 : 0.f) + ((tg & 2) ? q2 : 0.f), bend = ps + q2, eEnd = __expf(bend);
    unsigned kew[4], vtw[4];
#pragma unroll
    for (int i = 0; i < 8; ++i) {
        const float B = off + cum[i], eB = __expf(B), eN = __builtin_amdgcn_rcpf(eB), kk = 1.f - __expf(lf[i]);
        const int t = 8 * tg + i;
        const unsigned qs = pk_bf16(bf2f(r.q[i]) * eB, kk * eN);
        *(LAS bf16_t*)(buf + G2_QS + t * 272 + k * 2) = (bf16_t)(qs & 0xffffu);
        *(LAS bf16_t*)(buf + G2_KS + t * 272 + k * 2) = (bf16_t)(qs >> 16);
        const unsigned kv = pk_bf16(kk * eN * eEnd, 0.f) & 0xffffu, vt = r.v[i];
        if (i & 1) { kew[i >> 1] |= kv << 16; vtw[i >> 1] |= vt << 16; } else { kew[i >> 1] = kv; vtw[i >> 1] = vt; }
    }
    *(LAS u32x4_t*)(buf + G2_KE + k * 80 + tg * 16) = (u32x4_t){kew[0], kew[1], kew[2], kew[3]};
    *(LAS u32x4_t*)(buf + G2_VT + k * 80 + tg * 16) = (u32x4_t){vtw[0], vtw[1], vtw[2], vtw[3]};
    if (tg == 0) ((LAS float*)(buf + G2_D))[k] = eEnd;
}
DEVFN void ph_hgrn_scan2(const Params& p, LAS unsigned char* lds, int tid, int bid, int G) {
    if (bid >= NBAT * 16) { ph_cvt_uv_fp8(p, lds, tid, bid - NBAT * 16, G - NBAT * 16); return; }
    const int dir = bid & 1, h = (bid >> 1) & 7, b = bid >> 4;
    const bf16_t* Z = WSP(const bf16_t, WS_Z);
    bf16_t* od = WSP(bf16_t, WS_Y) + (dir ? (size_t)NT * D : 0);
    const int lane = tid & 63, w = __builtin_amdgcn_readfirstlane(tid >> 6), c16 = lane & 15, g = lane >> 4;
    const int pk = 16 * w + c16, ptg = g;
    constexpr int NCH = (CL + SEQ) / 32;
    const int foff = dir ? 3072 : 2048, step = dir ? -1 : 1;
    auto row0 = [&](int c) -> size_t { const int s = c * 32 + 8 * ptg; return s < CL ? (size_t)(NX + b * CL + (dir ? CL - 1 - s : s)) : (size_t)(b * SEQ + (dir ? SEQ - 1 - (s - CL) : s - CL)); };
    auto trow = [&](int s) -> size_t { return s < CL ? (size_t)(NX + b * CL + (dir ? CL - 1 - s : s)) : (size_t)(b * SEQ + (dir ? SEQ - 1 - (s - CL) : s - CL)); };
    f32x4v S[8];
#pragma unroll
    for (int i = 0; i < 8; ++i) S[i] = (f32x4v){0.f, 0.f, 0.f, 0.f};
    HgRaw raw;
    hg_load(raw, Z, row0(0), step, foff, h * 128 + pk);
    hg_prep(raw, lds, pk, ptg, lane);
    hg_load(raw, Z, row0(1), step, foff, h * 128 + pk);
    __syncthreads();
#pragma unroll 1
    for (int c = 0; c < NCH; ++c) {
        if (c + 1 < NCH) { hg_prep(raw, lds + ((c + 1) & 1) * G2_BUF, pk, ptg, lane); if (c + 2 < NCH) hg_load(raw, Z, row0(c + 2), step, foff, h * 128 + pk); }
        const LAS unsigned char* bf = lds + (c & 1) * G2_BUF;
        f32x4v X00 = {0.f, 0.f, 0.f, 0.f}, X01 = X00, X11 = X00;
#pragma unroll
        for (int ks = 0; ks < 4; ++ks) {
            const bf16x8_t a0 = *(const LAS bf16x8_t*)(bf + G2_KS + c16 * 272 + ks * 64 + g * 16), a1 = *(const LAS bf16x8_t*)(bf + G2_KS + (16 + c16) * 272 + ks * 64 + g * 16);
            const bf16x8_t b0 = *(const LAS bf16x8_t*)(bf + G2_QS + c16 * 272 + ks * 64 + g * 16), b1 = *(const LAS bf16x8_t*)(bf + G2_QS + (16 + c16) * 272 + ks * 64 + g * 16);
            X00 = __builtin_amdgcn_mfma_f32_16x16x32_bf16(a0, b0, X00, 0, 0, 0);
            X01 = __builtin_amdgcn_mfma_f32_16x16x32_bf16(a0, b1, X01, 0, 0, 0);
            X11 = __builtin_amdgcn_mfma_f32_16x16x32_bf16(a1, b1, X11, 0, 0, 0);
        }
#pragma unroll
        for (int r = 0; r < 4; ++r) { const bool keep = (4 * g + r) <= c16; X00[r] = keep ? X00[r] : 0.f; X11[r] = keep ? X11[r] : 0.f; }
        const u32x4_t p0w = (u32x4_t){pk_bf16(X00[0], X00[1]), pk_bf16(X00[2], X00[3]), 0u, 0u};
        const u32x4_t p1w = (u32x4_t){pk_bf16(X01[0], X01[1]), pk_bf16(X01[2], X01[3]), pk_bf16(X11[0], X11[1]), pk_bf16(X11[2], X11[3])};
        const int vrow = (16 * w + c16) * 80;
        const s16x4v vlo = *(const LAS s16x4v*)(bf + G2_VT + vrow + g * 8), vhi = *(const LAS s16x4v*)(bf + G2_VT + vrow + 32 + g * 8);
        const bf16x8_t vperm = (bf16x8_t){vlo[0], vlo[1], vlo[2], vlo[3], vhi[0], vhi[1], vhi[2], vhi[3]};
        f32x4v o0 = {0.f, 0.f, 0.f, 0.f}, o1 = o0;
        o0 = __builtin_amdgcn_mfma_f32_16x16x32_bf16(__builtin_bit_cast(bf16x8_t, p0w), vperm, o0, 0, 0, 0);
        o1 = __builtin_amdgcn_mfma_f32_16x16x32_bf16(__builtin_bit_cast(bf16x8_t, p1w), vperm, o1, 0, 0, 0);
#pragma unroll
        for (int ks = 0; ks < 4; ++ks) {
            const u32x4_t sw = (u32x4_t){pk_bf16(S[2 * ks][0], S[2 * ks][1]), pk_bf16(S[2 * ks][2], S[2 * ks][3]), pk_bf16(S[2 * ks + 1][0], S[2 * ks + 1][1]), pk_bf16(S[2 * ks + 1][2], S[2 * ks + 1][3])};
            const bf16x8_t sb = __builtin_bit_cast(bf16x8_t, sw);
            const s16x4v q0l = *(const LAS s16x4v*)(bf + G2_QS + c16 * 272 + ks * 64 + g * 8), q0h = *(const LAS s16x4v*)(bf + G2_QS + c16 * 272 + ks * 64 + 32 + g * 8);
            const s16x4v q1l = *(const LAS s16x4v*)(bf + G2_QS + (16 + c16) * 272 + ks * 64 + g * 8), q1h = *(const LAS s16x4v*)(bf + G2_QS + (16 + c16) * 272 + ks * 64 + 32 + g * 8);
            o0 = __builtin_amdgcn_mfma_f32_16x16x32_bf16((bf16x8_t){q0l[0], q0l[1], q0l[2], q0l[3], q0h[0], q0h[1], q0h[2], q0h[3]}, sb, o0, 0, 0, 0);
            o1 = __builtin_amdgcn_mfma_f32_16x16x32_bf16((bf16x8_t){q1l[0], q1l[1], q1l[2], q1l[3], q1h[0], q1h[1], q1h[2], q1h[3]}, sb, o1, 0, 0, 0);
        }
#pragma unroll
        for (int r = 0; r < 2; ++r) {
            od[trow(c * 32 + 4 * g + 2 * r) * D + h * 128 + 16 * w + c16] = f2bf(o0[2 * r]); od[trow(c * 32 + 4 * g + 2 * r + 1) * D + h * 128 + 16 * w + c16] = f2bf(o0[2 * r + 1]);
            od[trow(c * 32 + 16 + 4 * g + 2 * r) * D + h * 128 + 16 * w + c16] = f2bf(o1[2 * r]); od[trow(c * 32 + 16 + 4 * g + 2 * r + 1) * D + h * 128 + 16 * w + c16] = f2bf(o1[2 * r + 1]);
        }
        const bf16x8_t vb = *(const LAS bf16x8_t*)(bf + G2_VT + vrow + g * 16);
#pragma unroll
        for (int kt = 0; kt < 8; ++kt) {
            const f32x4v dv = *(const LAS f32x4v*)(bf + G2_D + (16 * kt + 4 * g) * 4);
            const bf16x8_t ka = *(const LAS bf16x8_t*)(bf + G2_KE + (16 * kt + c16) * 80 + g * 16);
            S[kt] = __builtin_amdgcn_mfma_f32_16x16x32_bf16(ka, vb, S[kt] * dv, 0, 0, 0);
        }
        __syncthreads();
    }
}
#endif
#define PEER_PHASES(l, M) \
    PH(GEMM_BF16(WS_HB, WS_WQ + (size_t)(l) * 2048 * D * 2, M, 2048, WS_QP, 2048)) \
    PEER_ROUTE(l, M) \
    PEER_EXPERTS(l, M)
#define PROGRAM \
    PH(PRO_A) \
    PH(H0) \
      \
    PH(GEMM_HGRN(WS_HB, WS_WIN0, NT, 5120, WS_Z, 5120)) \
    HGRN_SCAN \
    PH(HGRN_READOUT) \
    PH(GEMM_F32(WS_ATT, WS_WOUT + (size_t)0 * D * D * 2, NT, 1024, WS_Y, 1024)) \
    PH(LN1(0, NT)) \
    PEER_PHASES(0, NT) \
      \
    SWA_PROJ \
    PH(SWA_ATTN) \
    PH(GEMM_F32(WS_ATT, WS_WOUT + (size_t)1 * D * D * 2, NT, 1024, WS_Y, 1024)) \
    PH(LN1(1, NT)) \
    PEER_PHASES(1, NT) \
      \
    PH(GEMM_BF16(WS_HB, WS_WIN2, NT, 3072, WS_Z, 3072)) \
    PH(NA_ATTN) \
    PH(GEMM_F32(WS_ATT, WS_WOUT + (size_t)2 * D * D * 2, NT, 1024, WS_Y, 1024)) \
    PH(LN1(2, NT)) \
    PEER_PHASES(2, NT) \
      \
    PH(GEMM_BF16(WS_HB, WS_WIN3, NT, 1536, WS_Z, 1536)) \
    PH(GQA_PREP) \
    PH(GQA_ATTN) \
    PH(GEMM_F32(WS_ATT, WS_WOUT + (size_t)3 * D * D * 2, NX, 1024, WS_Y, 1024)) \
    PH(LN1(3, NX)) \
    PEER_PHASES(3, NX)
#ifdef CPU_TEST
#define PEER_EXPERTS(l, M) PH(ph_peer_act(p, l, M, gtid, gsize)) PH(ph_peer_out(p, l, M, gtid, gsize)) PH(ph_ln(p, l, 1, M, gtid, gsize))
#define PEER_ROUTE(l, M) PH(ph_peer_scores(p, l, M, gtid, gsize)) PH(ph_peer_combine(p, M, gtid, gsize))
#define PRO_A ph_pro_a(p, gtid, gsize)
#define H0 ph_h0(p, gtid, gsize)
#define HGRN_READOUT ph_hgrn_readout(p, gtid, gsize)
#define SWA_PROJ PH(GEMM_BF16(WS_HB, WS_WIN1, NT, 1536, WS_Z, 1536)) PH(ph_swa_rope(p, gtid, gsize))
#define GQA_PREP ph_gqa_prep(p, gtid, gsize)
#define LN1(l, M) ph_ln(p, l, 0, M, gtid, gsize)
#define HGRN_SCAN PH(ph_hgrn_gates(p, gtid, gsize)) PH(ph_hgrn_scan(p, gtid, gsize))
#define SWA_ATTN ph_swa_attn(p, gtid, gsize)
#define NA_ATTN ph_na_attn(p, gtid, gsize)
constexpr int NPHASES = 2 + 12 + 12 + 11 + 12;
#else
#define PEER_EXPERTS(l, M) PH(ph_peer_u(p, l, M, tid, bid, G)) PH(ph_peer_comb(p, l, M, gtid, gsize)) PH(ph_peer_v(p, lds, l, M, tid, bid, G)) PH(ph_ln2_gpu(p, l, M, tid, bid, G, rep_dry))
#define PEER_ROUTE(l, M) PH(ph_peer_route(p, l, M, lds, tid, bid, G))
#define PRO_A ph_pro_gpu(p, lds, tid, bid, G, gtid, gsize)
#define H0 ph_h0_gpu(p, gtid, gsize)
#define HGRN_READOUT ph_hgrn_readout_gpu(p, tid, bid, G)
#define SWA_PROJ PH(GEMM_SWA(WS_HB, WS_WIN1, NT, 1536, WS_Z, 1536))
#define GQA_PREP ph_gqa_prep_gpu(p, gtid, gsize)
#define LN1(l, M) ph_ln1_gpu(p, l, M, tid, bid, G, rep_dry)
#define HGRN_SCAN PH(ph_hgrn_scan2(p, lds, tid, bid, G))
#define SWA_ATTN ph_swa_attn_wg(p, lds, tid, bid, G)
#define NA_ATTN ph_na_attn_wg(p, lds, tid, bid, G)
constexpr int NPHASES = 2 + 11 + 10 + 10 + 11;
#endif
#ifndef CPU_TEST
constexpr int NTHREADS = 512;
constexpr int RING_BYTES = 131072, LDSCTL_OFF = RING_BYTES, LDS_BYTES = 147456;
#ifndef MK_REPEAT
#define MK_REPEAT 0
#endif
#ifndef MK_REP_K
#define MK_REP_K (-1)
#endif
#ifndef MK_REP_N
#define MK_REP_N 1
#endif
#ifndef MK_REP_MASK
#define MK_REP_MASK 0ull
#endif
#ifndef MK_PER_PHASE
#define MK_PER_PHASE 0
#endif
constexpr int CW_BAR = 4096;

__global__ void __launch_bounds__(NTHREADS, 2) mk_fwd(Params p) {
    extern __shared__ __attribute__((aligned(16))) unsigned char lds_raw[];
    LAS unsigned char* lds = (LAS unsigned char*)lds_raw;
    const int tid = threadIdx.x, bid = blockIdx.x, G = gridDim.x;
    for (int u = tid; u < (LDS_BYTES - LDSCTL_OFF) / 4; u += NTHREADS) ((LAS unsigned*)(lds + LDSCTL_OFF))[u] = 0u;
    __syncthreads();
    XcdBarrier bar; bar.bar = (unsigned*)(p.ws + WS_CTL) + CW_BAR; bar.x = 0; bar.st = nullptr;
    if (!MK_PER_PHASE) bar = xcd_barrier_post((unsigned*)(p.ws + WS_CTL) + CW_BAR, (volatile LAS unsigned*)(lds + LDSCTL_OFF));
    const size_t gsize = (size_t)G * NTHREADS;
    const int lo = p.ph_lo, hi = p.ph_hi;
    int kk = 0;
#define GEMM_BF16(Aoff, Boff, M_, N_, Ooff, ldc_) do { pg8::Gemm g{WSP(const bf16_t, Aoff), WSP(const bf16_t, Boff), M_, N_, D}; pg8::StaticOrder S; S.init(M_, N_, G, bid); \
        pg8::EpiBf16 E{WSP(bf16_t, Ooff), ldc_}; pg8::gemm_phase<pg8::EpiBf16, pg8::StaticOrder, true, true>(lds, g, S, E); } while (0)
#define GEMM_HGRN(Aoff, Boff, M_, N_, Ooff, ldc_) do { pg8::Gemm g{WSP(const bf16_t, Aoff), WSP(const bf16_t, Boff), M_, N_, D}; pg8::StaticOrder S; S.init(M_, N_, G, bid); \
        pg8::EpiHgrn E{WSP(bf16_t, Ooff), ldc_, WSP(const float, WS_LBV)}; pg8::gemm_phase<pg8::EpiHgrn, pg8::StaticOrder, true, true>(lds, g, S, E); } while (0)
#define GEMM_SWA(Aoff, Boff, M_, N_, Ooff, ldc_) do { pg8::Gemm g{WSP(const bf16_t, Aoff), WSP(const bf16_t, Boff), M_, N_, D}; pg8::StaticOrder S; S.init(M_, N_, G, bid); \
        pg8::EpiSwa E{WSP(bf16_t, Ooff), ldc_, WSP(const float, WS_ROPE) + ROPE64_COS, WSP(const float, WS_ROPE) + ROPE64_SIN, NX, SEQ, GW}; pg8::gemm_phase<pg8::EpiSwa, pg8::StaticOrder, true, true>(lds, g, S, E); } while (0)
#define GEMM_F32(Aoff, Boff, M_, N_, Ooff, ldc_) GEMM_BF16(Aoff, Boff, M_, N_, Ooff, ldc_)
#define GQA_ATTN ph_gqa_attn_mfma(p, (char*)lds_raw, bid, G)
#define PH_ONCE(...) PH_ONCE_D(0, __VA_ARGS__)
#define PH_ONCE_D(dry_, ...) { constexpr int rep_dry = dry_; (void)rep_dry; int tid = threadIdx.x; asm volatile("" : "+v"(tid)); const size_t gtid = ((size_t)(tid >> 6) * G + bid) * 64 + (tid & 63); __VA_ARGS__; }
#define PH(stmt) { const int k_ = kk++; if (lo <= k_ && k_ < hi) { \
        if (MK_REPEAT && ((MK_REP_MASK >> k_) & 1ull)) { PH_ONCE_D(1, stmt) xcd_barrier(bar); }     \
        PH_ONCE(stmt) \
        if (k_ + 1 < hi) xcd_barrier(bar); } }
    PROGRAM
#if MK_REPEAT
    for (int xb_ = 0; xb_ < MK_REP_N - 1; ++xb_) xcd_barrier(bar);
#endif
#undef PH
#undef GEMM_BF16
#undef GEMM_F32
#undef GEMM_HGRN
#undef GEMM_SWA
}

extern "C" void kernel_launch(void* const* d_in, const int* in_sizes, int n_in, void* d_out, int out_size, void* d_ws, size_t ws_size, hipStream_t stream) {
    static int grid = 0;
    if (grid == 0) {
        if (n_in != 26 || out_size != NX * D || ws_size < WS_END2) { fprintf(stderr, "kernel_launch: unexpected shapes (n_in %d out %d ws %zu need %zu)\n", n_in, out_size, ws_size, (size_t)WS_END2); grid = -1; return; }
        int dev = 0, cus = 0, per_cu = 0;
        if (hipGetDevice(&dev) != hipSuccess || hipDeviceGetAttribute(&cus, hipDeviceAttributeMultiprocessorCount, dev) != hipSuccess) { grid = -1; return; }
        if (hipFuncSetAttribute((const void*)mk_fwd, hipFuncAttributeMaxDynamicSharedMemorySize, LDS_BYTES) != hipSuccess) { fprintf(stderr, "kernel_launch: hipFuncSetAttribute failed\n"); grid = -1; return; }
        if (hipOccupancyMaxActiveBlocksPerMultiprocessor(&per_cu, (const void*)mk_fwd, NTHREADS, LDS_BYTES) != hipSuccess || per_cu < 1) { fprintf(stderr, "kernel_launch: occupancy query says %d\n", per_cu); grid = -1; return; }
        (void)hipGetLastError();
        grid = cus;
    }
    if (grid < 0) return;
    if (hipMemsetAsync((char*)d_ws + WS_CTL, 0, CTL_BYTES, stream) != hipSuccess) return;
    Params p{};
    const float** pp = (const float**)&p;
    for (int i = 0; i < 26; ++i) pp[i] = (const float*)d_in[i];
    p.out = (float*)d_out; p.ws = (unsigned char*)d_ws; p.rep_k = 0; p.rep_n = 0; p.rep_mask = 0;
#if MK_PER_PHASE
    for (int k = 0; k < NPHASES; ++k) { p.ph_lo = k; p.ph_hi = k + 1; hipLaunchKernelGGL(mk_fwd, dim3(grid), dim3(NTHREADS), LDS_BYTES, stream, p); }
#else
    p.ph_lo = 0; p.ph_hi = NPHASES;
    hipLaunchKernelGGL(mk_fwd, dim3(grid), dim3(NTHREADS), LDS_BYTES, stream, p);
#endif
}
#endif
```
